# Optimizing an MI355X kernel written in HIP

```python
import math
import jax
import jax.numpy as jnp
from jax import lax
import numpy as np

D_MODEL = 2048
BATCH = 4
SEQ = 2048
DEPTH = 1
DEC_BATCH = 128
DEC_SEQ = 8
PAST_LEN = 16384
PAGE_SIZE = 128

MIX_WIDTH = D_MODEL
GDN_WIDTH = MIX_WIDTH // 2
GDN_HEADS = 8
GDN_DK = GDN_WIDTH // GDN_HEADS
GDN_DV = GDN_DK
GDN_CONV = 4
GDN_CHUNK = 64
RWKV_WIDTH = MIX_WIDTH - GDN_WIDTH
RWKV_HEAD = 64
RWKV_HEADS = RWKV_WIDTH // RWKV_HEAD
RWKV_LORA_W = 64
RWKV_LORA_A = 64
RWKV_LORA_G = 128
RWKV_PROJ = 3 * RWKV_WIDTH + RWKV_LORA_W + RWKV_LORA_A + RWKV_LORA_G
D_FF = 5632
FFN_CONV = 3
RMS_EPS = 1e-6
L2_EPS = 1e-12
GN_EPS = 64e-5
OFF_GDN_Z = 3 * GDN_WIDTH
OFF_GDN_B = 4 * GDN_WIDTH
OFF_GDN_A = OFF_GDN_B + GDN_HEADS
OFF_RWKV = OFF_GDN_A + GDN_HEADS
IN_WIDTH = OFF_RWKV + RWKV_PROJ

kernel_name = 'hymba_gdn_rwkv7_convffn_step'


def rms_norm(x, g):
    xf = x.astype(jnp.float32)
    y = xf * lax.rsqrt(jnp.mean(xf * xf, axis=-1, keepdims=True) + RMS_EPS)
    return (y * g.astype(jnp.float32)).astype(x.dtype)


def l2_normalize(x):
    return x * lax.rsqrt(jnp.sum(x * x, axis=-1, keepdims=True) + L2_EPS)


def causal_dwconv(x, buf, w):
    width = w.shape[0]
    t = x.shape[1]
    xp = jnp.concatenate([buf.astype(x.dtype), x], axis=1)
    w = w.astype(x.dtype)
    y = xp[:, width - 1:] * w[width - 1]
    for i in range(width - 1):
        y = y + xp[:, i:i + t] * w[i]
    return y, xp[:, t:]


def chunk_gated_delta(q, k, v, beta, g, s0):
    b, t, h, dk = q.shape
    dv = v.shape[-1]
    c = min(GDN_CHUNK, t)
    n = -(-t // c)
    pad = n * c - t

    def blocks(z):
        z = jnp.pad(z, [(0, 0), (0, pad)] + [(0, 0)] * (z.ndim - 2))
        z = z.reshape((b, n, c) + z.shape[2:])
        return jnp.moveaxis(z, 3, 2)

    qc, kc, vc, bc, gc = (blocks(z) for z in (q, k, v, beta, g))
    G = jnp.cumsum(gc, axis=-1)
    idx = jnp.arange(c)
    causal = idx[:, None] >= idx[None, :]
    strict = idx[:, None] > idx[None, :]
    diff = G[..., :, None] - G[..., None, :]
    decay = jnp.where(causal, jnp.exp(jnp.where(causal, diff, 0.0)), 0.0)
    kkt = jnp.einsum('bnhid,bnhjd->bnhij', kc, kc)
    lower = jnp.where(strict, bc[..., :, None] * kkt * decay, 0.0) + jnp.eye(c, dtype=q.dtype)
    gamma = jnp.exp(G)
    rhs = jnp.concatenate([(bc * gamma)[..., None] * kc, bc[..., None] * vc], axis=-1)
    sol = lax.linalg.triangular_solve(lower, rhs, left_side=True, lower=True, unit_diagonal=True)
    w_c, u0_c = sol[..., :dk], sol[..., dk:]
    qk = jnp.einsum('bnhid,bnhjd->bnhij', qc, kc) * decay
    qg = qc * gamma[..., None]
    kt = kc * jnp.exp(G[..., -1:] - G)[..., None]
    gl = jnp.exp(G[..., -1])

    def step(s, inp):
        w_, u0_, qk_, qg_, kt_, gl_ = inp
        u = u0_ - jnp.einsum('bhcd,bhdv->bhcv', w_, s)
        o = jnp.einsum('bhcd,bhdv->bhcv', qg_, s) + jnp.einsum('bhij,bhjv->bhiv', qk_, u)
        s = gl_[..., None, None] * s + jnp.einsum('bhcd,bhcv->bhdv', kt_, u)
        return s, o

    xs = tuple(jnp.moveaxis(z, 1, 0) for z in (w_c, u0_c, qk, qg, kt, gl))
    s, o = lax.scan(step, s0, xs)
    o = jnp.transpose(o, (1, 0, 3, 2, 4)).reshape(b, n * c, h, dv)[:, :t]
    return o, s


def gdn_mixer(p_qkv, p_z, p_beta, p_a, conv_buf, s0, conv_w, a_log, dt_bias, norm_g):
    f32 = jnp.float32
    b, t, _ = p_qkv.shape
    qkv, conv_new = causal_dwconv(p_qkv, conv_buf, conv_w)
    qkv = jax.nn.silu(qkv.astype(f32)).reshape(b, t, 3, GDN_HEADS, GDN_DK)
    q = l2_normalize(qkv[:, :, 0]) * (GDN_DK ** -0.5)
    k = l2_normalize(qkv[:, :, 1])
    v = qkv[:, :, 2]
    beta = jax.nn.sigmoid(p_beta.astype(f32))
    g = -jnp.exp(a_log.astype(f32)) * jax.nn.softplus(p_a.astype(f32) + dt_bias.astype(f32))
    o, s_new = chunk_gated_delta(q, k, v, beta, g, s0.astype(f32))
    o = o * lax.rsqrt(jnp.mean(o * o, axis=-1, keepdims=True) + RMS_EPS) * norm_g.astype(f32)
    o = o * jax.nn.silu(p_z.astype(f32).reshape(b, t, GDN_HEADS, GDN_DV))
    return o.reshape(b, t, GDN_WIDTH), conv_new, s_new


def rwkv7_scan(r, decay, k, v, kk, kka, s0):
    def step(s, inp):
        r_t, w_t, k_t, v_t, kk_t, kka_t = inp
        sk = jnp.einsum('bhvk,bhk->bhv', s, kk_t)
        s = s * w_t[:, :, None, :] - sk[..., None] * kka_t[:, :, None, :] + v_t[..., None] * k_t[:, :, None, :]
        return s, jnp.einsum('bhvk,bhk->bhv', s, r_t)

    xs = tuple(jnp.moveaxis(z, 1, 0) for z in (r, decay, k, v, kk, kka))
    s, y = lax.scan(step, s0, xs)
    return jnp.moveaxis(y, 0, 1), s


def rwkv_mixer(p, shift_buf, s0, mu, w0, w_b, a0, a_b, g_b, k_k, k_a, r_k, gn_w, gn_b):
    f32 = jnp.float32
    b, t, _ = p.shape
    prev = jnp.concatenate([shift_buf[:, None].astype(p.dtype), p[:, :-1]], axis=1)
    xs = (p + (prev - p) * mu.astype(p.dtype)).astype(f32)
    splits = [RWKV_WIDTH, 2 * RWKV_WIDTH, 3 * RWKV_WIDTH, 3 * RWKV_WIDTH + RWKV_LORA_W,
              3 * RWKV_WIDTH + RWKV_LORA_W + RWKV_LORA_A]
    r, k, v, wd, ad, gd = jnp.split(xs, splits, axis=-1)
    w = -jax.nn.softplus(-(w0.astype(f32) + jnp.tanh(wd) @ w_b.astype(f32))) - 0.5
    decay = jnp.exp(-jnp.exp(w))
    a = jax.nn.sigmoid(a0.astype(f32) + ad @ a_b.astype(f32))
    gate = jax.nn.sigmoid(gd) @ g_b.astype(f32)

    def heads(z):
        return z.reshape(b, t, RWKV_HEADS, RWKV_HEAD)

    kk = l2_normalize(heads(k * k_k.astype(f32)))
    k = k * (1.0 + (a - 1.0) * k_a.astype(f32))
    r, k, v, decay, a = heads(r), heads(k), heads(v), heads(decay), heads(a)
    y, s_new = rwkv7_scan(r, decay, k, v, kk, kk * a, s0.astype(f32))
    mean = jnp.mean(y, axis=-1, keepdims=True)
    var = jnp.mean(jnp.square(y - mean), axis=-1, keepdims=True)
    y = (y - mean) * lax.rsqrt(var + GN_EPS) * gn_w.astype(f32).reshape(RWKV_HEADS, RWKV_HEAD) \
        + gn_b.astype(f32).reshape(RWKV_HEADS, RWKV_HEAD)
    y = y + jnp.sum(r * k * r_k.astype(f32), axis=-1, keepdims=True) * v
    return y.reshape(b, t, RWKV_WIDTH) * gate, p[:, -1], s_new


def conv_ffn(x, buf, w_up, conv_w, w_down):
    h, buf_new = causal_dwconv(x @ w_up, buf, conv_w)
    gate, up = jnp.split(h, 2, axis=-1)
    return (jax.nn.silu(gate) * up) @ w_down, buf_new


def layer(x, s_gdn, s_gconv, s_rwkv, s_shift, s_ffn,
          ln1_g, w_in, gdn_conv_w, gdn_a_log, gdn_dt_bias, gdn_norm_g,
          rwkv_mu, rwkv_w0, rwkv_w_b, rwkv_a0, rwkv_a_b, rwkv_g_b, rwkv_k_k, rwkv_k_a, rwkv_r_k,
          rwkv_gn_w, rwkv_gn_b, w_o, ln2_g, ffn_w_up, ffn_conv_w, ffn_w_down):
    proj = rms_norm(x, ln1_g) @ w_in
    o_a, gconv_new, gdn_new = gdn_mixer(
        proj[..., :OFF_GDN_Z], proj[..., OFF_GDN_Z:OFF_GDN_B], proj[..., OFF_GDN_B:OFF_GDN_A],
        proj[..., OFF_GDN_A:OFF_RWKV], s_gconv, s_gdn, gdn_conv_w, gdn_a_log, gdn_dt_bias, gdn_norm_g)
    o_b, shift_new, rwkv_new = rwkv_mixer(
        proj[..., OFF_RWKV:], s_shift, s_rwkv, rwkv_mu, rwkv_w0, rwkv_w_b, rwkv_a0, rwkv_a_b,
        rwkv_g_b, rwkv_k_k, rwkv_k_a, rwkv_r_k, rwkv_gn_w, rwkv_gn_b)
    mixed = jnp.concatenate([o_a, o_b], axis=-1).astype(x.dtype)
    x = x + mixed @ w_o
    f, ffn_new = conv_ffn(rms_norm(x, ln2_g), s_ffn, ffn_w_up, ffn_conv_w, ffn_w_down)
    return x + f, gdn_new, gconv_new, rwkv_new, shift_new, ffn_new


def setup_inputs(seed: int = 0) -> dict:
    key = jax.random.key(seed)
    keys = iter(jax.random.split(key, 40))

    def nrm(shape, scale):
        return scale * jax.random.normal(next(keys), shape, jnp.float32)

    def uni(shape, lo, hi):
        return jax.random.uniform(next(keys), shape, jnp.float32, lo, hi)

    L = DEPTH
    dt = jnp.exp(uni((L, GDN_HEADS), math.log(1e-3), math.log(1e-1)))
    return {
        'x_prompt': nrm((BATCH, SEQ, D_MODEL), 1.0),
        'x_sample': nrm((DEC_BATCH, DEC_SEQ, D_MODEL), 1.0),
        'state_gdn': nrm((L, DEC_BATCH, GDN_HEADS, GDN_DK, GDN_DV), 0.1),
        'state_gdn_conv': nrm((L, DEC_BATCH, GDN_CONV - 1, 3 * GDN_WIDTH), 1.0),
        'state_rwkv': nrm((L, DEC_BATCH, RWKV_HEADS, RWKV_HEAD, RWKV_HEAD), 0.1),
        'state_rwkv_shift': nrm((L, DEC_BATCH, RWKV_PROJ), 1.0),
        'state_ffn_conv': nrm((L, DEC_BATCH, FFN_CONV - 1, 2 * D_FF), 1.0),
        'ln1_g': 1.0 + nrm((L, D_MODEL), 0.02),
        'w_in': nrm((L, D_MODEL, IN_WIDTH), D_MODEL ** -0.5),
        'gdn_conv_w': nrm((L, GDN_CONV, 3 * GDN_WIDTH), GDN_CONV ** -0.5),
        'gdn_a_log': jnp.log(uni((L, GDN_HEADS), 1.0, 16.0)),
        'gdn_dt_bias': dt + jnp.log(-jnp.expm1(-dt)),
        'gdn_norm_g': 1.0 + nrm((L, GDN_DV), 0.02),
        'rwkv_mu': uni((L, RWKV_PROJ), 0.0, 1.0),
        'rwkv_w0': uni((L, RWKV_WIDTH), -6.0, 1.0),
        'rwkv_w_b': nrm((L, RWKV_LORA_W, RWKV_WIDTH), 0.5 * RWKV_LORA_W ** -0.5),
        'rwkv_a0': nrm((L, RWKV_WIDTH), 0.5),
        'rwkv_a_b': nrm((L, RWKV_LORA_A, RWKV_WIDTH), RWKV_LORA_A ** -0.5),
        'rwkv_g_b': nrm((L, RWKV_LORA_G, RWKV_WIDTH), RWKV_LORA_G ** -0.5),
        'rwkv_k_k': 0.85 + nrm((L, RWKV_WIDTH), 0.02),
        'rwkv_k_a': 1.0 + nrm((L, RWKV_WIDTH), 0.02),
        'rwkv_r_k': nrm((L, RWKV_HEADS, RWKV_HEAD), 0.1),
        'rwkv_gn_w': 1.0 + nrm((L, RWKV_WIDTH), 0.02),
        'rwkv_gn_b': nrm((L, RWKV_WIDTH), 0.02),
        'w_o': nrm((L, MIX_WIDTH, D_MODEL), MIX_WIDTH ** -0.5),
        'ln2_g': 1.0 + nrm((L, D_MODEL), 0.02),
        'ffn_w_up': nrm((L, D_MODEL, 2 * D_FF), D_MODEL ** -0.5),
        'ffn_conv_w': nrm((L, FFN_CONV, 2 * D_FF), FFN_CONV ** -0.5),
        'ffn_w_down': nrm((L, D_FF, D_MODEL), D_FF ** -0.5),
        'final_g': 1.0 + nrm((D_MODEL,), 0.02),
    }


def reference(x_prompt, x_sample, state_gdn, state_gdn_conv, state_rwkv, state_rwkv_shift, state_ffn_conv,
              ln1_g, w_in, gdn_conv_w, gdn_a_log, gdn_dt_bias, gdn_norm_g,
              rwkv_mu, rwkv_w0, rwkv_w_b, rwkv_a0, rwkv_a_b, rwkv_g_b, rwkv_k_k, rwkv_k_a, rwkv_r_k,
              rwkv_gn_w, rwkv_gn_b, w_o, ln2_g, ffn_w_up, ffn_conv_w, ffn_w_down, final_g):
    params = (ln1_g, w_in, gdn_conv_w, gdn_a_log, gdn_dt_bias, gdn_norm_g,
              rwkv_mu, rwkv_w0, rwkv_w_b, rwkv_a0, rwkv_a_b, rwkv_g_b, rwkv_k_k, rwkv_k_a, rwkv_r_k,
              rwkv_gn_w, rwkv_gn_b, w_o, ln2_g, ffn_w_up, ffn_conv_w, ffn_w_down)

    def trunk(x, states):
        new = [[] for _ in states]
        for l in range(DEPTH):
            x, *st = layer(x, *[s[l] for s in states], *[p[l] for p in params])
            for acc, s in zip(new, st):
                acc.append(s)
        return rms_norm(x, final_g), [jnp.stack(acc) for acc in new]

    sample_states = (state_gdn, state_gdn_conv, state_rwkv, state_rwkv_shift, state_ffn_conv)
    prompt_states = tuple(jnp.zeros((DEPTH, BATCH) + s.shape[2:], jnp.float32) for s in sample_states)
    y_prompt, (gdn_p, gconv_p, rwkv_p, shift_p, ffn_p) = trunk(x_prompt, prompt_states)
    y_sample, (gdn_s, gconv_s, rwkv_s, shift_s, ffn_s) = trunk(x_sample, sample_states)
    return (y_prompt, y_sample, gdn_p, gconv_p, rwkv_p, shift_p, ffn_p, gdn_s, gconv_s, rwkv_s, shift_s, ffn_s)
```

```cpp
#include <hip/hip_runtime.h>
#include <hip/hip_cooperative_groups.h>
#include <cstdio>
#include <cstdint>
namespace cg = cooperative_groups;
namespace pg8 {
#define PG8_LAS __attribute__((address_space(3)))
typedef unsigned short bf16_t;
typedef short bf16x8 __attribute__((ext_vector_type(8)));
typedef float f32x4 __attribute__((ext_vector_type(4)));
typedef unsigned u32x4 __attribute__((ext_vector_type(4)));
constexpr int BM = 256, BK = 64, HALF = 128, HTB = HALF * BK * 2  , STAGE_BYTES = 8 * HTB, NXCD = 8, WGM = 8;

__host__ __device__ __forceinline__ int lds_byte(int r, int c) { const int st = (r >> 4) * 2 + (c >> 5), rr = r & 15, cc = c & 31, ob = rr * 64 + cc * 2; return st * 1024 + (ob ^ (((ob >> 9) & 1) << 5)); }
__host__ __device__ __forceinline__ void stage_rc(int b, int& R, int& C) { const int st = b / 1024, sb = b % 1024, swz = sb ^ (((sb >> 9) & 1) << 5); R = (st >> 1) * 16 + swz / 64; C = (st & 1) * 32 + (swz % 64) / 2; }
__host__ __device__ __forceinline__ int perm32(int rho) { const int n = rho >> 4, i = rho & 15; return 8 * (i >> 2) + 4 * n + (i & 3); }

struct Unit { int pm, pn, k0, nt, seg; };
struct Gemm { const bf16_t* A; const bf16_t* Bt; int M, N, K; };

struct StaticOrder {
    int nM, nN, nwg, G, c, ntk;
    __host__ __device__ void init(int M, int N, int K, int G_, int c_) { nM = M / BM; nN = N / BM; nwg = nM * nN; G = G_; c = c_; ntk = K / BK; }
    __host__ __device__ bool next(int i, Unit& u) const {
        const long L = (long)i * G + c; if (L >= nwg) return false;
        int wgid = (int)L; { const int q = nwg / NXCD, r = nwg % NXCD, xcd = wgid % NXCD, off = wgid / NXCD; wgid = (xcd < r ? xcd * (q + 1) : r * (q + 1) + (xcd - r) * q) + off; }
        const int nig = WGM * nN, gid = wgid / nig, fm = gid * WGM, gsz = (nM - fm) < WGM ? (nM - fm) : WGM;
        u.pm = fm + ((wgid % nig) % gsz); u.pn = (wgid % nig) / gsz; u.k0 = 0; u.nt = ntk; u.seg = 0; return true;
    }
    __device__ __forceinline__ void a_ready(const Unit&) const {}
    __device__ __forceinline__ void done(const Unit&) const {}
};
__device__ __forceinline__ unsigned cvt_pk_bf16(float lo, float hi) { unsigned r; asm volatile("v_cvt_pk_bf16_f32 %0, %1, %2" : "=v"(r) : "v"(lo), "v"(hi)); return r; }
template <class Epi, class Sched, bool ALIGN_EPI = false, bool SP2 = false>
__device__ __forceinline__ void gemm_phase(PG8_LAS unsigned char* lds, const Gemm g, const Sched& S, const Epi& E) {
    const int tid = threadIdx.x, wid = __builtin_amdgcn_readfirstlane(tid >> 6), lane = tid & 63, wr = wid >> 2, wc = wid & 3, fr = lane & 15, fq = lane >> 4;
    const int K = g.K;
    unsigned voffA[2], voffB[2];
#pragma unroll
    for (int i = 0; i < 2; ++i) { int R, C; stage_rc(tid * 16 + i * 8192, R, C); const int Rb = Epi::PERM ? ((R & ~31) + perm32(R & 31)) : R;
        voffA[i] = (unsigned)(R * K + C) * 2u; voffB[i] = (unsigned)(Rb * K + C) * 2u; }
    const size_t kstep = (size_t)(BK * 2);
    const size_t hstep = (size_t)HALF * K * 2;
    const size_t tstep = 2 * hstep;
    const unsigned ldsw = (unsigned)wid * 1024u;
    const int aoff = lds_byte(wr * 64 + fr, fq * 8), boff = lds_byte(wc * 32 + fr, fq * 8);
#define PG8_SA(b, h) (((b) * 2 + (h)) * HTB)
#define PG8_SB(b, h) ((4 + (b) * 2 + (h)) * HTB)
#define PG8_STAGE(bufoff, gbase, voff) do { _Pragma("unroll") for (int _i = 0; _i < 2; ++_i) \
        __builtin_amdgcn_global_load_lds((const unsigned*)((const char*)(gbase) + (voff)[_i]), (PG8_LAS unsigned*)(lds + (bufoff) + ldsw + _i * 8192), 16, 0, 0); } while (0)
#define PG8_LDA(dst, b, h) do { _Pragma("unroll") for (int m = 0; m < 4; ++m) _Pragma("unroll") for (int k = 0; k < 2; ++k) dst[m][k] = *(const PG8_LAS bf16x8*)(lds + PG8_SA(b, h) + aoff + m * 2048 + k * 1024); } while (0)
#define PG8_LDB(dst, b, h) do { _Pragma("unroll") for (int n = 0; n < 2; ++n) _Pragma("unroll") for (int k = 0; k < 2; ++k) dst[n][k] = *(const PG8_LAS bf16x8*)(lds + PG8_SB(b, h) + boff + n * 2048 + k * 1024); } while (0)
#define PG8_MMA(ai, bj, At, Bt) do { __builtin_amdgcn_s_setprio(1); _Pragma("unroll") for (int m = 0; m < 4; ++m) _Pragma("unroll") for (int n = 0; n < 2; ++n) _Pragma("unroll") for (int k = 0; k < 2; ++k) \
        acc[ai][bj][m][n] = __builtin_amdgcn_mfma_f32_16x16x32_bf16(Bt[n][k], At[m][k], acc[ai][bj][m][n], 0, 0, 0); __builtin_amdgcn_s_setprio(0); } while (0)
#define PG8_WAIT_V(n) asm volatile("s_waitcnt vmcnt(" #n ")" ::: "memory")
#define PG8_WAIT_L(n) asm volatile("s_waitcnt lgkmcnt(" #n ")" ::: "memory")
#define PG8_BAR __builtin_amdgcn_s_barrier()
#define PG8_SCHED __builtin_amdgcn_sched_barrier(0)
    Unit cur, nxt; int ui = 0;
    if (!S.next(0, cur)) return;
    f32x4 acc[2][2][4][2];
#pragma unroll
    for (int a = 0; a < 2; ++a)
#pragma unroll
        for (int b = 0; b < 2; ++b)
#pragma unroll
            for (int m = 0; m < 4; ++m)
#pragma unroll
                for (int n = 0; n < 2; ++n) acc[a][b][m][n] = (f32x4){0.f, 0.f, 0.f, 0.f};
    bf16x8 At[4][2], B0[2][2], B1[2][2];
    const char* cA = (const char*)g.A + (size_t)cur.pm * tstep + (size_t)cur.k0 * kstep; const char* cB = (const char*)g.Bt + (size_t)cur.pn * tstep + (size_t)cur.k0 * kstep;
    S.a_ready(cur);
    if constexpr (SP2) {
        PG8_STAGE(PG8_SB(0, 0), cB, voffB); PG8_STAGE(PG8_SB(0, 1), cB + hstep, voffB); PG8_STAGE(PG8_SA(0, 0), cA, voffA); PG8_STAGE(PG8_SA(0, 1), cA + hstep, voffA);
        if (wr == 1) PG8_BAR;
        PG8_WAIT_V(2); PG8_BAR;
        PG8_STAGE(PG8_SB(1, 0), cB + kstep, voffB); PG8_STAGE(PG8_SA(1, 0), cA + kstep, voffA); PG8_STAGE(PG8_SB(1, 1), cB + hstep + kstep, voffB);
        PG8_WAIT_V(6); PG8_BAR;
    } else {
        PG8_STAGE(PG8_SB(0, 0), cB, voffB); PG8_STAGE(PG8_SA(0, 0), cA, voffA); PG8_STAGE(PG8_SB(0, 1), cB + hstep, voffB); PG8_STAGE(PG8_SA(0, 1), cA + hstep, voffA);
        if (wr == 1) PG8_BAR;
        PG8_WAIT_V(4); PG8_BAR;
        PG8_STAGE(PG8_SB(1, 0), cB + kstep, voffB); PG8_STAGE(PG8_SA(1, 0), cA + kstep, voffA); PG8_STAGE(PG8_SB(1, 1), cB + hstep + kstep, voffB);
        PG8_WAIT_V(6); PG8_BAR;
    }
    for (;;) {
        const bool has_next = S.next(ui + 1, nxt);
        const char* nA = has_next ? (const char*)g.A + (size_t)nxt.pm * tstep + (size_t)nxt.k0 * kstep : cA; const char* nB = has_next ? (const char*)g.Bt + (size_t)nxt.pn * tstep + (size_t)nxt.k0 * kstep : cB;
        const int nt = cur.nt;
        for (int t = 0; t < nt; t += 2) {
            const bool last = (t == nt - 2);
            const char* a1 = cA + (size_t)(t + 1) * kstep;
            const char* a2 = last ? nA : cA + (size_t)(t + 2) * kstep; const char* b2 = last ? nB : cB + (size_t)(t + 2) * kstep;
            const char* a3 = a2 + kstep; const char* b3 = b2 + kstep;
            if (last && has_next) S.a_ready(nxt);
            if constexpr (SP2) {
            PG8_LDB(B0, 0, 0); PG8_LDB(B1, 0, 1); PG8_SCHED; PG8_LDA(At, 0, 0); PG8_STAGE(PG8_SA(1, 1), a1 + hstep, voffA);
            PG8_WAIT_V(8); PG8_WAIT_L(0); PG8_BAR; PG8_MMA(0, 0, At, B0); PG8_MMA(0, 1, At, B1); PG8_BAR; PG8_SCHED;
            PG8_LDA(At, 0, 1); PG8_STAGE(PG8_SB(0, 0), b2, voffB); PG8_STAGE(PG8_SB(0, 1), b2 + hstep, voffB); PG8_STAGE(PG8_SA(0, 0), a2, voffA);
            PG8_WAIT_V(8); PG8_WAIT_L(0); PG8_BAR; PG8_MMA(1, 0, At, B0); PG8_MMA(1, 1, At, B1); PG8_BAR; PG8_SCHED;
            PG8_LDB(B0, 1, 0); PG8_LDB(B1, 1, 1); PG8_SCHED; PG8_LDA(At, 1, 0); PG8_STAGE(PG8_SA(0, 1), a2 + hstep, voffA);
            PG8_WAIT_V(8); PG8_WAIT_L(0); PG8_BAR; PG8_MMA(0, 0, At, B0); PG8_MMA(0, 1, At, B1); PG8_BAR; PG8_SCHED;
            PG8_LDA(At, 1, 1); PG8_STAGE(PG8_SB(1, 0), b3, voffB); PG8_STAGE(PG8_SB(1, 1), b3 + hstep, voffB); PG8_STAGE(PG8_SA(1, 0), a3, voffA);
            PG8_WAIT_V(8); PG8_WAIT_L(0); PG8_BAR; PG8_MMA(1, 0, At, B0); PG8_MMA(1, 1, At, B1); PG8_BAR; PG8_SCHED;
            } else {
            PG8_LDB(B0, 0, 0); PG8_SCHED; PG8_LDA(At, 0, 0); PG8_STAGE(PG8_SA(1, 1), a1 + hstep, voffA);
            PG8_WAIT_L(8); PG8_BAR; PG8_WAIT_L(0); PG8_MMA(0, 0, At, B0); PG8_BAR; PG8_SCHED;
            PG8_LDB(B1, 0, 1); PG8_STAGE(PG8_SB(0, 0), b2, voffB);
            PG8_BAR; PG8_WAIT_L(0); PG8_MMA(0, 1, At, B1); PG8_BAR;
            PG8_LDA(At, 0, 1); PG8_STAGE(PG8_SA(0, 0), a2, voffA);
            PG8_BAR; PG8_WAIT_L(0); PG8_MMA(1, 0, At, B0); PG8_BAR; PG8_SCHED;
            PG8_STAGE(PG8_SB(0, 1), b2 + hstep, voffB);
            PG8_WAIT_V(6); PG8_BAR; PG8_MMA(1, 1, At, B1); PG8_BAR;
            PG8_LDB(B0, 1, 0); PG8_SCHED; PG8_LDA(At, 1, 0); PG8_STAGE(PG8_SA(0, 1), a2 + hstep, voffA);
            PG8_WAIT_L(8); PG8_BAR; PG8_WAIT_L(0); PG8_MMA(0, 0, At, B0); PG8_BAR; PG8_SCHED;
            PG8_LDB(B1, 1, 1); PG8_STAGE(PG8_SB(1, 0), b3, voffB);
            PG8_BAR; PG8_WAIT_L(0); PG8_MMA(0, 1, At, B1); PG8_BAR;
            PG8_LDA(At, 1, 1); PG8_STAGE(PG8_SA(1, 0), a3, voffA);
            PG8_BAR; PG8_WAIT_L(0); PG8_MMA(1, 0, At, B0); PG8_BAR; PG8_SCHED;
            PG8_STAGE(PG8_SB(1, 1), b3 + hstep, voffB);
            PG8_WAIT_V(6); PG8_BAR; PG8_MMA(1, 1, At, B1); PG8_BAR;
            }
        }
        if constexpr (ALIGN_EPI) { if (wr == 0) PG8_BAR; }
        if constexpr (!Epi::AFTER_DRAIN) { E(acc, cur, wr, wc, fr, fq); S.done(cur); }
        if (!has_next) break;
#pragma unroll
        for (int a = 0; a < 2; ++a)
#pragma unroll
            for (int b = 0; b < 2; ++b)
#pragma unroll
                for (int m = 0; m < 4; ++m)
#pragma unroll
                    for (int n = 0; n < 2; ++n) acc[a][b][m][n] = (f32x4){0.f, 0.f, 0.f, 0.f};
        cur = nxt; cA = nA; cB = nB; ++ui;
        if constexpr (ALIGN_EPI) { if (wr == 1) PG8_BAR; }
    }
    PG8_WAIT_V(0);
    if constexpr (!ALIGN_EPI) { if (wr == 0) PG8_BAR; }
    PG8_BAR;
    if constexpr (Epi::AFTER_DRAIN) { E.fused(acc, cur, wr, wc, fr, fq, lds, wid, lane); S.done(cur); }
#undef PG8_SA
#undef PG8_SB
#undef PG8_STAGE
#undef PG8_LDA
#undef PG8_LDB
#undef PG8_MMA
#undef PG8_WAIT_V
#undef PG8_WAIT_L
#undef PG8_BAR
#undef PG8_SCHED
}
}

namespace pg8 {
struct EpiBf16P {
    static constexpr bool PERM = true, AFTER_DRAIN = false;
    bf16_t* O; int ldc;
    __device__ __forceinline__ void operator()(const f32x4 (&acc)[2][2][4][2], const Unit& u, int wr, int wc, int fr, int fq) const {
        const int row0 = u.pm * BM + wr * 64 + fr, col0 = u.pn * BM + wc * 32 + 8 * fq;
#pragma unroll
        for (int ai = 0; ai < 2; ++ai)
#pragma unroll
            for (int m = 0; m < 4; ++m) { bf16_t* rowp = O + (size_t)(row0 + ai * HALF + m * 16) * ldc + col0;
#pragma unroll
                for (int bj = 0; bj < 2; ++bj) { const f32x4 v0 = acc[ai][bj][m][0], v1 = acc[ai][bj][m][1];
                    u32x4 w; w.x = cvt_pk_bf16(v0[0], v0[1]); w.y = cvt_pk_bf16(v0[2], v0[3]); w.z = cvt_pk_bf16(v1[0], v1[1]); w.w = cvt_pk_bf16(v1[2], v1[3]);
                    *(u32x4*)(rowp + bj * HALF) = w; } }
    }
};
struct EpiH {
    static constexpr bool PERM = true, AFTER_DRAIN = false;
    bf16_t* O; float* ffn_p; float* ffn_s;
    __device__ __forceinline__ void operator()(const f32x4 (&acc)[2][2][4][2], const Unit& u, int wr, int wc, int fr, int fq) const {
        const int row0 = u.pm * BM + wr * 64 + fr, col0 = u.pn * BM + wc * 32 + 8 * fq;
#pragma unroll
        for (int ai = 0; ai < 2; ++ai)
#pragma unroll
            for (int m = 0; m < 4; ++m) { const int row = row0 + ai * HALF + m * 16; bf16_t* rowp = O + (size_t)row * 11264 + col0;
                float* tail = nullptr;
                if (row < 8192) { const int t = row & 2047; if (t >= 2046) tail = ffn_p + (size_t)((row >> 11) * 2 + (t - 2046)) * 11264 + col0; }
                else { const int r = row - 8192, t = r & 7; if (t >= 6) tail = ffn_s + (size_t)((r >> 3) * 2 + (t - 6)) * 11264 + col0; }
#pragma unroll
                for (int bj = 0; bj < 2; ++bj) { const f32x4 v0 = acc[ai][bj][m][0], v1 = acc[ai][bj][m][1];
                    u32x4 w; w.x = cvt_pk_bf16(v0[0], v0[1]); w.y = cvt_pk_bf16(v0[2], v0[3]); w.z = cvt_pk_bf16(v1[0], v1[1]); w.w = cvt_pk_bf16(v1[2], v1[3]);
                    *(u32x4*)(rowp + bj * HALF) = w;
                    if (tail) { *(f32x4*)(tail + bj * HALF) = v0; *(f32x4*)(tail + bj * HALF + 4) = v1; } } }
    }
};
struct EpiRes {
    static constexpr bool PERM = false, AFTER_DRAIN = false;
    const float* base_p; const float* base_s; float* out;
    __device__ __forceinline__ void operator()(const f32x4 (&acc)[2][2][4][2], const Unit& u, int wr, int wc, int fr, int fq) const {
        const int row0 = u.pm * BM + wr * 64 + fr, col0 = u.pn * BM + wc * 32 + 4 * fq;
        const float* base = (u.pm < 32) ? base_p : (base_s - (size_t)8192 * 2048);
#pragma unroll
        for (int ai = 0; ai < 2; ++ai)
#pragma unroll
            for (int m = 0; m < 4; ++m) { const size_t off = (size_t)(row0 + ai * HALF + m * 16) * 2048 + col0;
#pragma unroll
                for (int bj = 0; bj < 2; ++bj)
#pragma unroll
                    for (int n = 0; n < 2; ++n) { const f32x4 bs = *(const f32x4*)(base + off + bj * HALF + n * 16); *(f32x4*)(out + off + bj * HALF + n * 16) = bs + acc[ai][bj][m][n]; }
                asm volatile("" ::: "memory"); }
    }
};
struct SplitOrder {
    int c, ntk;
    __device__ void init(int K, int c_) { c = c_; ntk = K / BK; }
    __device__ bool next(int i, Unit& u) const {
        if (i == 0) { const int xcd = c & 7, j = c >> 3; u.pm = xcd * 4 + (j >> 3); u.pn = j & 7; u.k0 = 0; u.nt = ntk; u.seg = 0; return true; }
        if (i == 1) { const int uu = c >> 3, seg = c & 7, P = ntk >> 1, p0 = (seg * P) >> 3, p1 = ((seg + 1) * P) >> 3; u.pm = 32 + (uu >> 3); u.pn = uu & 7; u.k0 = 2 * p0; u.nt = 2 * (p1 - p0); u.seg = seg; return true; }
        return false;
    }
    __device__ __forceinline__ void a_ready(const Unit&) const {}
    __device__ __forceinline__ void done(const Unit&) const {}
};
struct EpiResSplit {
    static constexpr bool PERM = false, AFTER_DRAIN = false;
    const float* base_p; float* out_p; float* acc_s;
    __device__ __forceinline__ void operator()(const f32x4 (&acc)[2][2][4][2], const Unit& u, int wr, int wc, int fr, int fq) const {
        const int row0 = u.pm * BM + wr * 64 + fr, col0 = u.pn * BM + wc * 32 + 4 * fq;
        if (u.pm < 32) {
#pragma unroll
            for (int ai = 0; ai < 2; ++ai)
#pragma unroll
                for (int m = 0; m < 4; ++m) { const size_t off = (size_t)(row0 + ai * HALF + m * 16) * 2048 + col0;
#pragma unroll
                    for (int bj = 0; bj < 2; ++bj)
#pragma unroll
                        for (int n = 0; n < 2; ++n) { const f32x4 bs = *(const f32x4*)(base_p + off + bj * HALF + n * 16); *(f32x4*)(out_p + off + bj * HALF + n * 16) = bs + acc[ai][bj][m][n]; }
                    asm volatile("" ::: "memory"); }
        } else {
#pragma unroll
            for (int ai = 0; ai < 2; ++ai)
#pragma unroll
                for (int m = 0; m < 4; ++m) { float* p = acc_s + ((size_t)u.seg * 1024 + (size_t)(row0 - 8192 + ai * HALF + m * 16)) * 2048 + col0;
#pragma unroll
                    for (int bj = 0; bj < 2; ++bj)
#pragma unroll
                        for (int n = 0; n < 2; ++n) *(f32x4*)(p + bj * HALF + n * 16) = acc[ai][bj][m][n]; }
        }
    }
};
}

#define LAS __attribute__((address_space(3)))
typedef unsigned short bf16_t;
typedef float f32x4v __attribute__((ext_vector_type(4)));
typedef float f32x2v __attribute__((ext_vector_type(2)));
constexpr int MTOK = 9216, MPR = 8192, DM = 2048, NIN = 7440, NINP = 7680, DFF = 5632, DFF2 = 11264, RPROJ = 3328, OFFR = 4112;
constexpr int TT = 12, NTILES = MTOK / TT;
constexpr int LDS_BYTES = 131072;
constexpr size_t O_Y = 0, O_GDN_P = 18874368, O_GCONV_P = 19398656, O_RWKV_P = 19435520, O_SHIFT_P = 19697664, O_FFN_P = 19710976,
                 O_GDN_S = 19801088, O_GCONV_S = 36578304, O_RWKV_S = 37757952, O_SHIFT_S = 46146560, O_FFN_S = 46572544, O_END = 49456128;
constexpr size_t W_WTUP = 0, W_WTO = 46137344, W_PROJ = 54525952, W_GQKV = 196083712, W_GAB = 252706816, W_RS = 253296640, W_RV = 328794112, W_RW = 347668480, W_END1 = 385417216;
constexpr size_t W_PART = W_PROJ;
constexpr size_t W_MIXED = W_GQKV, W_H = W_WTO, W_WTDN = W_END1, W_ACT = W_H + (size_t)MTOK * DFF2 * 2 + (size_t)DM * DFF * 2, W_XN2 = W_ACT, W_END2 = W_ACT + (size_t)MTOK * DFF * 2, W_END3 = W_WTDN + (size_t)DM * DFF * 2;
static_assert(W_END2 <= W_END1 + 0, "late-phase overlay must fit");
static_assert(W_END3 == 408485888 && W_END2 == 380633088, "layout");
constexpr size_t W_BAR = W_END3, W_END4 = W_BAR + 8192;
constexpr size_t OB_WBT = O_FFN_S * 4, OB_ABT = OB_WBT + 1024 * 64 * 2, OB_GBT = OB_ABT + 1024 * 64 * 2;

struct Args { const float* in[30]; float* out; unsigned char* ws; int ph_lo, ph_hi; };

__device__ __forceinline__ float bf_lo(unsigned w) { return __uint_as_float(w << 16); }
__device__ __forceinline__ float bf_hi(unsigned w) { return __uint_as_float(w & 0xffff0000u); }
__device__ __forceinline__ unsigned pk2(float lo, float hi) { return pg8::cvt_pk_bf16(lo, hi); }
__device__ __forceinline__ unsigned pk2_safe(float lo, float hi) { unsigned r; asm volatile("s_nop 4\n\tv_cvt_pk_bf16_f32 %0, %1, %2" : "=v"(r) : "v"(lo), "v"(hi)); return r; }
__device__ __forceinline__ void unpack8(const uint4 w, float (&f)[8]) { f[0] = bf_lo(w.x); f[1] = bf_hi(w.x); f[2] = bf_lo(w.y); f[3] = bf_hi(w.y); f[4] = bf_lo(w.z); f[5] = bf_hi(w.z); f[6] = bf_lo(w.w); f[7] = bf_hi(w.w); }
__device__ __forceinline__ float wave_sum(float v) {
#pragma unroll
    for (int o = 1; o < 64; o <<= 1) v += __shfl_xor(v, o);
    return v;
}
__device__ __forceinline__ float half_sum32(float v) {
#pragma unroll
    for (int o = 1; o < 32; o <<= 1) v += __shfl_xor(v, o);
    return v;
}
__device__ __forceinline__ float sum16(float v) {
#pragma unroll
    for (int o = 1; o < 16; o <<= 1) v += __shfl_xor(v, o);
    return v;
}
template <int CTRL> __device__ __forceinline__ float dppf(float v) { return __int_as_float(__builtin_amdgcn_update_dpp(0, __float_as_int(v), CTRL, 0xF, 0xF, true)); }
__device__ __forceinline__ float reduce8(float v) {
    v += dppf<0xB1>(v);
    v += dppf<0x4E>(v);
    v += dppf<0x141>(v);
    return v;
}
__device__ __forceinline__ float sigmoidf_(float x) { return __builtin_amdgcn_rcpf(1.0f + __expf(-x)); }
__device__ __forceinline__ float siluf_(float x) { return x * __builtin_amdgcn_rcpf(1.0f + __expf(-x)); }
__device__ __forceinline__ float softplusf_(float x) { return fmaxf(x, 0.f) + __logf(1.0f + __expf(-fabsf(x))); }
__device__ __forceinline__ float tanhf_(float x) { const float e = __expf(-2.0f * fabsf(x)); const float r = (1.0f - e) * __builtin_amdgcn_rcpf(1.0f + e); return x < 0.f ? -r : r; }
__device__ __forceinline__ void rowinfo(int row, int& grp, int& b, int& t, int& T) {
    if (row < MPR) { grp = 0; b = row >> 11; t = row & 2047; T = 2048; } else { const int r = row - MPR; grp = 1; b = r >> 3; t = r & 7; T = 8; }
}
#define LDS_WAIT() asm volatile("s_waitcnt lgkmcnt(0)" ::: "memory")

__device__ __forceinline__ void transpose_item(const float* __restrict__ W, int K, int N, bf16_t* __restrict__ WT, LAS float* scr, int item, int nblk, int lane) {
    const int kb = item / nblk, nb = item - kb * nblk, k0 = 64 * kb, n0 = 64 * nb;
    const int r4 = lane >> 4, c4 = (lane & 15) * 4, n_in = n0 + c4;
    float4 v[16];
#pragma unroll
    for (int i = 0; i < 16; ++i) v[i] = (n_in < N) ? *(const float4*)(W + (size_t)(k0 + 4 * i + r4) * N + n_in) : make_float4(0.f, 0.f, 0.f, 0.f);
#pragma unroll
    for (int i = 0; i < 16; ++i) { const int k = 4 * i + r4; *(LAS f32x4v*)(scr + k * 64 + (c4 ^ (8 * ((k >> 3) & 7)))) = (f32x4v){v[i].x, v[i].y, v[i].z, v[i].w}; }
    LDS_WAIT();
    const int c = lane & 7;
#pragma unroll
    for (int j = 0; j < 8; ++j) { const int n = (lane >> 3) + 8 * j; const LAS float* sp = scr + (8 * c) * 64 + (n ^ (8 * c));
        uint4 o; o.x = pk2(sp[0], sp[64]); o.y = pk2(sp[128], sp[192]); o.z = pk2(sp[256], sp[320]); o.w = pk2(sp[384], sp[448]);
        *(uint4*)(WT + (size_t)(n0 + n) * K + k0 + 8 * c) = o; }
    LDS_WAIT();
}
__device__ __forceinline__ void rms_row_bf16(const float* __restrict__ xrow, const float* __restrict__ g, bf16_t* __restrict__ orow, int lane) {
    float4 v[8]; float ss = 0.f;
#pragma unroll
    for (int j = 0; j < 8; ++j) { v[j] = ((const float4*)xrow)[lane + 64 * j]; ss += (v[j].x * v[j].x + v[j].y * v[j].y) + (v[j].z * v[j].z + v[j].w * v[j].w); }
    const float rs = rsqrtf(wave_sum(ss) * (1.0f / DM) + 1e-6f);
#pragma unroll
    for (int j = 0; j < 8; ++j) { const float4 gg = ((const float4*)g)[lane + 64 * j];
        uint2 o; o.x = pk2(v[j].x * rs * gg.x, v[j].y * rs * gg.y); o.y = pk2(v[j].z * rs * gg.z, v[j].w * rs * gg.w);
        ((uint2*)orow)[lane + 64 * j] = o; }
}
__device__ __forceinline__ void rms_row_f32_inplace(float* xrow, const float* __restrict__ g, int lane) {
    float4 v[8]; float ss = 0.f;
#pragma unroll
    for (int j = 0; j < 8; ++j) { v[j] = ((const float4*)xrow)[lane + 64 * j]; ss += (v[j].x * v[j].x + v[j].y * v[j].y) + (v[j].z * v[j].z + v[j].w * v[j].w); }
    const float rs = rsqrtf(wave_sum(ss) * (1.0f / DM) + 1e-6f);
#pragma unroll
    for (int j = 0; j < 8; ++j) { const float4 gg = ((const float4*)g)[lane + 64 * j];
        float4 o; o.x = v[j].x * rs * gg.x; o.y = v[j].y * rs * gg.y; o.z = v[j].z * rs * gg.z; o.w = v[j].w * rs * gg.w;
        ((float4*)xrow)[lane + 64 * j] = o; }
}

__device__ __forceinline__ void prep_tile(const Args& A, LAS float* lw, int tile, int tid) {
    const bf16_t* PROJ = (const bf16_t*)(A.ws + W_PROJ);
    bf16_t* GQKV = (bf16_t*)(A.ws + W_GQKV); float* GA = (float*)(A.ws + W_GAB); float* GB = GA + MTOK * 8;
    bf16_t* RS = (bf16_t*)(A.ws + W_RS); bf16_t* RV = (bf16_t*)(A.ws + W_RV); float* RW = (float*)(A.ws + W_RW);
    const float* st_gconv = A.in[3]; const float* st_shift = A.in[5];
    const int row_base = tile * TT;
    const int c0 = tid * 2;
    unsigned pw[TT + 1][3];
#pragma unroll
    for (int i = 0; i < TT + 1; ++i) { int r = row_base - 1 + i; r = r < 0 ? 0 : r; const bf16_t* pr = PROJ + (size_t)r * NINP + OFFR + c0;
        pw[i][0] = *(const unsigned*)pr; pw[i][1] = *(const unsigned*)(pr + 1024); pw[i][2] = *(const unsigned*)(pr + 2048); }
    uint4 xr[TT + 3];
    { const int chx = (tid < 384 ? tid : 383) * 8;
#pragma unroll
      for (int i = 0; i < TT + 3; ++i) { int r = row_base - 3 + i; r = r < 0 ? 0 : r; xr[i] = *(const uint4*)(PROJ + (size_t)r * NINP + chx); } }
    {
        if (tid < 4 * 68) ((LAS unsigned*)lw)[TT * 68 + tid] = 0u;
        const float* mu = A.in[13];
#pragma unroll
        for (int i = 0; i < 2; ++i) { const int item = tid + 512 * i; if (item < TT * 64) { const int tk = item >> 6, jp = item & 63, row = row_base + tk; int grp, b, t, T; rowinfo(row, grp, b, t, T);
            const int col = 3072 + 2 * jp; const unsigned pw_ = *(const unsigned*)(PROJ + (size_t)row * NINP + OFFR + col);
            float q0, q1; if (t > 0) { const unsigned qw = *(const unsigned*)(PROJ + (size_t)(row - 1) * NINP + OFFR + col); q0 = bf_lo(qw); q1 = bf_hi(qw); }
            else if (grp) { const float2 sq = *(const float2*)(st_shift + (size_t)b * RPROJ + col); q0 = sq.x; q1 = sq.y; } else { q0 = 0.f; q1 = 0.f; }
            const float2 m2 = *(const float2*)(mu + col); const float p0 = bf_lo(pw_), p1 = bf_hi(pw_);
            float x0 = p0 + (q0 - p0) * m2.x, x1 = p1 + (q1 - p1) * m2.y;
            if (jp < 32) { x0 = tanhf_(x0); x1 = tanhf_(x1); }
            ((LAS unsigned*)lw)[tk * 68 + jp] = pk2_safe(x0, x1); } }
    }
    if (tid < 384) {
        const int ch = tid * 8, stream = tid >> 7;
        const float* cwp = A.in[9];
        float cw[4][8];
#pragma unroll
        for (int i = 0; i < 4; ++i) { const float4 a0 = *(const float4*)(cwp + i * 3072 + ch), a1 = *(const float4*)(cwp + i * 3072 + ch + 4);
            cw[i][0] = a0.x; cw[i][1] = a0.y; cw[i][2] = a0.z; cw[i][3] = a0.w; cw[i][4] = a1.x; cw[i][5] = a1.y; cw[i][6] = a1.z; cw[i][7] = a1.w; }
#pragma unroll
        for (int tk = 0; tk < TT; ++tk) {
            const int row = row_base + tk; int grp, b, t, T; rowinfo(row, grp, b, t, T);
            float y[8], xl[8];
#pragma unroll
            for (int e = 0; e < 8; ++e) y[e] = 0.f;
#pragma unroll
            for (int i = 0; i < 4; ++i) { const int tt = t - 3 + i; float x[8];
                if (tt >= 0) { unpack8(xr[tk + i], x); }
                else if (grp) { const float* sp = st_gconv + ((size_t)b * 3 + (t + i)) * 3072 + ch; const float4 a0 = *(const float4*)sp, a1 = *(const float4*)(sp + 4);
                    x[0] = a0.x; x[1] = a0.y; x[2] = a0.z; x[3] = a0.w; x[4] = a1.x; x[5] = a1.y; x[6] = a1.z; x[7] = a1.w; }
                else {
#pragma unroll
                    for (int e = 0; e < 8; ++e) x[e] = 0.f; }
#pragma unroll
                for (int e = 0; e < 8; ++e) { y[e] += cw[i][e] * x[e]; if (i == 3) xl[e] = x[e]; } }
            float ss = 0.f;
#pragma unroll
            for (int e = 0; e < 8; ++e) { y[e] = siluf_(y[e]); ss += y[e] * y[e]; }
            if (stream < 2) { ss = sum16(ss); const float sc = rsqrtf(ss + 1e-12f) * (stream == 0 ? 0.08838834764831845f : 1.0f);
#pragma unroll
                for (int e = 0; e < 8; ++e) y[e] *= sc; }
            uint4 o; o.x = pk2(y[0], y[1]); o.y = pk2(y[2], y[3]); o.z = pk2(y[4], y[5]); o.w = pk2(y[6], y[7]);
            *(uint4*)(GQKV + (size_t)row * 3072 + ch) = o;
            if (t >= T - 3) { float* gp = A.out + (grp ? O_GCONV_S : O_GCONV_P) + ((size_t)b * 3 + (t - (T - 3))) * 3072 + ch;
                *(float4*)gp = make_float4(xl[0], xl[1], xl[2], xl[3]); *(float4*)(gp + 4) = make_float4(xl[4], xl[5], xl[6], xl[7]); }
        }
    } else if (tid < 384 + TT * 8) {
        const int idx = tid - 384, tk = idx >> 3, h = idx & 7, row = row_base + tk;
        const float pb = bf_lo((unsigned)PROJ[(size_t)row * NINP + 4096 + h]), pa = bf_lo((unsigned)PROJ[(size_t)row * NINP + 4104 + h]);
        const float g = -__expf(A.in[10][h]) * softplusf_(pa + A.in[11][h]);
        GA[(size_t)row * 8 + h] = __expf(g); GB[(size_t)row * 8 + h] = sigmoidf_(pb);
    }
    __syncthreads();
    {
        const int wv_ = __builtin_amdgcn_readfirstlane(tid >> 6), ti = tid & 15, quad = (tid & 63) >> 4;
        LAS float* AWL = lw + 2048; LAS float* AAL = lw + 2048 + 13364;
        const LAS unsigned char* lb = (const LAS unsigned char*)lw + ti * 272 + quad * 16;
        pg8::bf16x8 bop[4];
#pragma unroll
        for (int ks = 0; ks < 4; ++ks) bop[ks] = *(const LAS pg8::bf16x8*)(lb + ks * 64);
#pragma unroll
        for (int which = 0; which < 2; ++which) {
            const bf16_t* WT = (const bf16_t*)((const unsigned char*)A.out + (which == 0 ? OB_WBT : OB_ABT)) + (size_t)(wv_ * 128 + ti) * 64 + quad * 8;
            const float* bias = A.in[which == 0 ? 14 : 16] + wv_ * 128 + quad * 4;
            LAS float* dst = (which == 0 ? AWL : AAL) + (ti < TT ? ti : TT) * 1028 + wv_ * 128 + quad * 4;
            pg8::bf16x8 aop[8][2];
#pragma unroll
            for (int t = 0; t < 8; ++t) { aop[t][0] = *(const pg8::bf16x8*)(WT + (size_t)t * 16 * 64); aop[t][1] = *(const pg8::bf16x8*)(WT + (size_t)t * 16 * 64 + 32); }
#pragma unroll
            for (int t = 0; t < 8; ++t) {
                pg8::f32x4 c = *(const pg8::f32x4*)(bias + t * 16);
                c = __builtin_amdgcn_mfma_f32_16x16x32_bf16(aop[t][0], bop[which * 2], c, 0, 0, 0);
                c = __builtin_amdgcn_mfma_f32_16x16x32_bf16(aop[t][1], bop[which * 2 + 1], c, 0, 0, 0);
                *(LAS f32x4v*)(dst + t * 16) = (f32x4v){c[0], c[1], c[2], c[3]};
            }
        }
    }
    __syncthreads();
    f32x2v aw[TT], aa[TT];
#pragma unroll
    for (int tk = 0; tk < TT; ++tk) { aw[tk] = *(const LAS f32x2v*)(lw + 2048 + tk * 1028 + c0); aa[tk] = *(const LAS f32x2v*)(lw + 2048 + 13364 + tk * 1028 + c0); }
    {
        const float* mu = A.in[13];
        const float2 mur = *(const float2*)(mu + c0), muk = *(const float2*)(mu + 1024 + c0), muv = *(const float2*)(mu + 2048 + c0);
        const float2 kkw = *(const float2*)(A.in[19] + c0), kaw = *(const float2*)(A.in[20] + c0);
#pragma unroll
        for (int tk = 0; tk < TT; ++tk) {
            const int row = row_base + tk; int grp, b, t, T; rowinfo(row, grp, b, t, T);
            const unsigned wr_ = pw[tk + 1][0], wk_ = pw[tk + 1][1], wv_ = pw[tk + 1][2];
            float r0 = bf_lo(wr_), r1 = bf_hi(wr_), k0 = bf_lo(wk_), k1 = bf_hi(wk_), v0 = bf_lo(wv_), v1 = bf_hi(wv_);
            float pr0, pr1, pk0, pk1, pv0, pv1;
            if (t > 0) { const unsigned a_ = pw[tk][0], b_ = pw[tk][1], c_ = pw[tk][2];
                pr0 = bf_lo(a_); pr1 = bf_hi(a_); pk0 = bf_lo(b_); pk1 = bf_hi(b_); pv0 = bf_lo(c_); pv1 = bf_hi(c_); }
            else if (grp) { const float* sp = st_shift + (size_t)b * RPROJ + c0; const float2 a_ = *(const float2*)sp, b_ = *(const float2*)(sp + 1024), c_ = *(const float2*)(sp + 2048);
                pr0 = a_.x; pr1 = a_.y; pk0 = b_.x; pk1 = b_.y; pv0 = c_.x; pv1 = c_.y; }
            else { pr0 = pr1 = pk0 = pk1 = pv0 = pv1 = 0.f; }
            r0 += (pr0 - r0) * mur.x; r1 += (pr1 - r1) * mur.y; k0 += (pk0 - k0) * muk.x; k1 += (pk1 - k1) * muk.y; v0 += (pv0 - v0) * muv.x; v1 += (pv1 - v1) * muv.y;
            const float w0_ = -softplusf_(-aw[tk].x) - 0.5f, w1_ = -softplusf_(-aw[tk].y) - 0.5f;
            const float d0 = __expf(-__expf(w0_)), d1 = __expf(-__expf(w1_));
            const float a0_ = sigmoidf_(aa[tk].x), a1_ = sigmoidf_(aa[tk].y);
            float q0 = k0 * kkw.x, q1 = k1 * kkw.y;
            const float inv = rsqrtf(half_sum32(q0 * q0 + q1 * q1) + 1e-12f);
            q0 *= inv; q1 *= inv;
            const float kp0 = k0 * (1.0f + (a0_ - 1.0f) * kaw.x), kp1 = k1 * (1.0f + (a1_ - 1.0f) * kaw.y);
            bf16_t* rs = RS + (size_t)row * 4096 + c0;
            *(unsigned*)rs = pk2(q0, q1); *(unsigned*)(rs + 1024) = pk2(q0 * a0_, q1 * a1_); *(unsigned*)(rs + 2048) = pk2(kp0, kp1); *(unsigned*)(rs + 3072) = pk2(r0, r1);
            *(unsigned*)(RV + (size_t)row * 1024 + c0) = pk2(v0, v1);
            *(float2*)(RW + (size_t)row * 1024 + c0) = make_float2(d0, d1);
        }
    }
    for (int tk = 0; tk < TT; ++tk) { const int row = row_base + tk; int grp, b, t, T; rowinfo(row, grp, b, t, T);
        if (t == T - 1) { float* sp = A.out + (grp ? O_SHIFT_S : O_SHIFT_P) + (size_t)b * RPROJ;
            for (int j = tid; j < RPROJ; j += 512) sp[j] = bf_lo((unsigned)PROJ[(size_t)row * NINP + OFFR + j]); } }
    __syncthreads();
}

constexpr int SCAN_LDS_PER_WAVE = 10752;
__device__ __forceinline__ void rwkv_sample_loop(LAS float* sl, const bf16_t* __restrict__ RS, const bf16_t* __restrict__ RV, const float* __restrict__ RW, float* __restrict__ yraw,
                                                 const float* __restrict__ st_in, float* __restrict__ st_out, int task0, int stride, int lane) {
    if (task0 >= 16384) return;
    const int part = lane & 7, rr = lane >> 3;
    LAS float* SB = sl; LAS float* WB = sl + 2048; LAS float* VB = sl + 2560;
    float4 nS0, nS1; uint4 nst[4]; float4 nsw[2]; uint4 nsv = make_uint4(0, 0, 0, 0);
#define RWS_LOAD(task_) do { const int bh_ = (task_) >> 3, v0_ = ((task_) & 7) * 8, h_ = bh_ & 15, row0_ = MPR + (bh_ >> 4) * 8; \
        const float* sp_ = st_in + (size_t)bh_ * 4096 + (size_t)(v0_ + rr) * 64 + part * 8; nS0 = *(const float4*)sp_; nS1 = *(const float4*)(sp_ + 4); \
        _Pragma("unroll") for (int i = 0; i < 4; ++i) { const int id = i * 64 + lane, step = id >> 5, s = (id >> 3) & 3, pc = id & 7; \
            nst[i] = *(const uint4*)(RS + (size_t)(row0_ + step) * 4096 + s * 1024 + h_ * 64 + pc * 8); } \
        _Pragma("unroll") for (int i = 0; i < 2; ++i) { const int id = i * 64 + lane, step = id >> 4, pc = id & 15; \
            nsw[i] = *(const float4*)(RW + (size_t)(row0_ + step) * 1024 + h_ * 64 + pc * 4); } \
        if (lane < 8) nsv = *(const uint4*)(RV + (size_t)(row0_ + lane) * 1024 + h_ * 64 + v0_); } while (0)
    RWS_LOAD(task0);
    for (int task = task0; task < 16384; task += stride) {
        const int bh = task >> 3, v0 = (task & 7) * 8, h = bh & 15, row0 = MPR + (bh >> 4) * 8;
        f32x2v S[4] = {(f32x2v){nS0.x, nS0.y}, (f32x2v){nS0.z, nS0.w}, (f32x2v){nS1.x, nS1.y}, (f32x2v){nS1.z, nS1.w}};
#pragma unroll
        for (int i = 0; i < 4; ++i) { const int id = i * 64 + lane, step = id >> 5, s = (id >> 3) & 3, pc = id & 7; float f[8]; unpack8(nst[i], f);
            LAS float* d = SB + (step * 4 + s) * 64 + pc * 8; *(LAS f32x4v*)d = (f32x4v){f[0], f[1], f[2], f[3]}; *(LAS f32x4v*)(d + 4) = (f32x4v){f[4], f[5], f[6], f[7]}; }
#pragma unroll
        for (int i = 0; i < 2; ++i) { const int id = i * 64 + lane, step = id >> 4, pc = id & 15; *(LAS f32x4v*)(WB + step * 64 + pc * 4) = (f32x4v){nsw[i].x, nsw[i].y, nsw[i].z, nsw[i].w}; }
        if (lane < 8) { float f[8]; unpack8(nsv, f); LAS float* d = VB + lane * 8; *(LAS f32x4v*)d = (f32x4v){f[0], f[1], f[2], f[3]}; *(LAS f32x4v*)(d + 4) = (f32x4v){f[4], f[5], f[6], f[7]}; }
        asm volatile("s_waitcnt lgkmcnt(0)" ::: "memory");
        __builtin_amdgcn_sched_barrier(0);
        if (task + stride < 16384) RWS_LOAD(task + stride);
        __builtin_amdgcn_sched_barrier(0);
        float ys[8];
        f32x4v kk0, kk1, ka0, ka1, kp0, kp1, r0, r1, w0, w1; float vv;
        f32x4v nkk0, nkk1, nka0, nka1, nkp0, nkp1, nr0, nr1, nw0, nw1; float nvv;
#define RW_OPS(s_) do { const LAS float* sb = SB + (s_) * 256 + part * 8; \
            nkk0 = *(const LAS f32x4v*)(sb); nkk1 = *(const LAS f32x4v*)(sb + 4); nka0 = *(const LAS f32x4v*)(sb + 64); nka1 = *(const LAS f32x4v*)(sb + 68); \
            nkp0 = *(const LAS f32x4v*)(sb + 128); nkp1 = *(const LAS f32x4v*)(sb + 132); nr0 = *(const LAS f32x4v*)(sb + 192); nr1 = *(const LAS f32x4v*)(sb + 196); \
            nw0 = *(const LAS f32x4v*)(WB + (s_) * 64 + part * 8); nw1 = *(const LAS f32x4v*)(WB + (s_) * 64 + part * 8 + 4); nvv = VB[(s_) * 8 + rr]; } while (0)
        RW_OPS(0);
#pragma unroll
        for (int s = 0; s < 8; ++s) {
            kk0 = nkk0; kk1 = nkk1; ka0 = nka0; ka1 = nka1; kp0 = nkp0; kp1 = nkp1; r0 = nr0; r1 = nr1; w0 = nw0; w1 = nw1; vv = nvv;
            if (s < 7) RW_OPS(s + 1);
            __builtin_amdgcn_sched_barrier(0);
            f32x2v acc = S[0] * kk0.lo, acc1 = S[1] * kk0.hi; acc = S[2] * kk1.lo + acc; acc1 = S[3] * kk1.hi + acc1; acc += acc1;
            const float sk = reduce8(acc.x + acc.y);
            const f32x2v nsk = (f32x2v){-sk, -sk}, vv2 = (f32x2v){vv, vv};
            S[0] = S[0] * w0.lo + (ka0.lo * nsk + kp0.lo * vv2);
            S[1] = S[1] * w0.hi + (ka0.hi * nsk + kp0.hi * vv2);
            S[2] = S[2] * w1.lo + (ka1.lo * nsk + kp1.lo * vv2);
            S[3] = S[3] * w1.hi + (ka1.hi * nsk + kp1.hi * vv2);
            f32x2v ya = S[0] * r0.lo, ya1 = S[1] * r0.hi; ya = S[2] * r1.lo + ya; ya1 = S[3] * r1.hi + ya1; ya += ya1;
            ys[s] = reduce8(ya.x + ya.y);
            __builtin_amdgcn_sched_barrier(0);
        }
#undef RW_OPS
        { float ysel = ys[0];
#pragma unroll
          for (int i = 1; i < 8; ++i) ysel = (part == i) ? ys[i] : ysel;
          yraw[(size_t)(row0 + part) * 2048 + 1024 + h * 64 + v0 + rr] = ysel; }
        { float* d = st_out + (size_t)bh * 4096 + (size_t)(v0 + rr) * 64 + part * 8; *(float4*)d = make_float4(S[0].x, S[0].y, S[1].x, S[1].y); *(float4*)(d + 4) = make_float4(S[2].x, S[2].y, S[3].x, S[3].y); }
        asm volatile("" ::: "memory");
    }
#undef RWS_LOAD
}
__device__ __forceinline__ void gdn_sample_loop(LAS float* sl, const bf16_t* __restrict__ GQKV, const float* __restrict__ GA, const float* __restrict__ GB, float* __restrict__ yraw,
                                                const float* __restrict__ st_in, float* __restrict__ st_out, int task0, int stride, int lane) {
    if (task0 >= 16384) return;
    const int part = lane & 7, cc = lane >> 3;
    LAS float* KB = sl; LAS float* QB = sl + 1056; LAS float* VB = sl + 2112; LAS float* AB = sl + 2176;
    const int rdoff = part * 16 + (part >> 2) * 4;
    float nS[16]; uint4 nst[4]; uint4 nsv = make_uint4(0, 0, 0, 0); float nsa = 0.f, nsb = 0.f;
#define GDS_LOAD(task_) do { const int bh_ = (task_) >> 4, j0_ = ((task_) & 15) * 8, h_ = bh_ & 7, row0_ = MPR + (bh_ >> 3) * 8; \
        const float* sp_ = st_in + (size_t)bh_ * 16384 + (size_t)(part * 16) * 128 + j0_ + cc; \
        _Pragma("unroll") for (int e = 0; e < 16; ++e) nS[e] = sp_[(size_t)e * 128]; \
        _Pragma("unroll") for (int i = 0; i < 4; ++i) { const int id = i * 64 + lane, s = id >> 7, step = (id >> 4) & 7, pc = id & 15; \
            nst[i] = *(const uint4*)(GQKV + (size_t)(row0_ + step) * 3072 + (s == 0 ? 1024 : 0) + h_ * 128 + pc * 8); } \
        if (lane < 8) { nsv = *(const uint4*)(GQKV + (size_t)(row0_ + lane) * 3072 + 2048 + h_ * 128 + j0_); \
            nsa = GA[(size_t)(row0_ + lane) * 8 + h_]; nsb = GB[(size_t)(row0_ + lane) * 8 + h_]; } } while (0)
    GDS_LOAD(task0);
    for (int task = task0; task < 16384; task += stride) {
        const int bh = task >> 4, j0 = (task & 15) * 8, h = bh & 7, row0 = MPR + (bh >> 3) * 8;
        f32x2v S[8];
#pragma unroll
        for (int e = 0; e < 8; ++e) S[e] = (f32x2v){nS[2 * e], nS[2 * e + 1]};
#pragma unroll
        for (int i = 0; i < 4; ++i) { const int id = i * 64 + lane, s = id >> 7, step = (id >> 4) & 7, pc = id & 15, pp = pc >> 1; float f[8]; unpack8(nst[i], f);
            LAS float* d = (s == 0 ? KB : QB) + step * 132 + pp * 16 + (pp >> 2) * 4 + (pc & 1) * 8; *(LAS f32x4v*)d = (f32x4v){f[0], f[1], f[2], f[3]}; *(LAS f32x4v*)(d + 4) = (f32x4v){f[4], f[5], f[6], f[7]}; }
        if (lane < 8) { float f[8]; unpack8(nsv, f); LAS float* d = VB + lane * 8; *(LAS f32x4v*)d = (f32x4v){f[0], f[1], f[2], f[3]}; *(LAS f32x4v*)(d + 4) = (f32x4v){f[4], f[5], f[6], f[7]};
            AB[lane * 2] = nsa; AB[lane * 2 + 1] = nsb; }
        asm volatile("s_waitcnt lgkmcnt(0)" ::: "memory");
        __builtin_amdgcn_sched_barrier(0);
        if (task + stride < 16384) GDS_LOAD(task + stride);
        __builtin_amdgcn_sched_barrier(0);
        float os[8];
        f32x4v k[4], q[4], nk[4], nq[4]; float v, a, beta, nv, na, nbeta;
#define GD_OPS(s_) do { const LAS float* kb = KB + (s_) * 132 + rdoff; const LAS float* qb = QB + (s_) * 132 + rdoff; \
            _Pragma("unroll") for (int i = 0; i < 4; ++i) { nk[i] = *(const LAS f32x4v*)(kb + 4 * i); nq[i] = *(const LAS f32x4v*)(qb + 4 * i); } \
            nv = VB[(s_) * 8 + cc]; na = AB[(s_) * 2]; nbeta = AB[(s_) * 2 + 1]; } while (0)
        GD_OPS(0);
#pragma unroll
        for (int s = 0; s < 8; ++s) {
#pragma unroll
            for (int i = 0; i < 4; ++i) { k[i] = nk[i]; q[i] = nq[i]; }
            v = nv; a = na; beta = nbeta;
            if (s < 7) GD_OPS(s + 1);
            __builtin_amdgcn_sched_barrier(0);
            f32x2v acc = S[0] * k[0].lo, acc1 = S[1] * k[0].hi;
#pragma unroll
            for (int i = 1; i < 4; ++i) { acc = S[2 * i] * k[i].lo + acc; acc1 = S[2 * i + 1] * k[i].hi + acc1; }
            acc += acc1;
            const float kS = reduce8(acc.x + acc.y);
            const float cf = beta * (v - a * kS);
            const f32x2v cf2 = (f32x2v){cf, cf}, a2 = (f32x2v){a, a};
#pragma unroll
            for (int i = 0; i < 4; ++i) { S[2 * i] = S[2 * i] * a2 + k[i].lo * cf2; S[2 * i + 1] = S[2 * i + 1] * a2 + k[i].hi * cf2; }
            f32x2v oa = S[0] * q[0].lo, oa1 = S[1] * q[0].hi;
#pragma unroll
            for (int i = 1; i < 4; ++i) { oa = S[2 * i] * q[i].lo + oa; oa1 = S[2 * i + 1] * q[i].hi + oa1; }
            oa += oa1;
            os[s] = reduce8(oa.x + oa.y);
            __builtin_amdgcn_sched_barrier(0);
        }
#undef GD_OPS
        { float osel = os[0];
#pragma unroll
          for (int i = 1; i < 8; ++i) osel = (part == i) ? os[i] : osel;
          yraw[(size_t)(row0 + part) * 2048 + h * 128 + j0 + cc] = osel; }
        { float* d = st_out + (size_t)bh * 16384 + (size_t)(part * 16) * 128 + j0 + cc;
#pragma unroll
          for (int e = 0; e < 8; ++e) { d[(size_t)(2 * e) * 128] = S[e].x; d[(size_t)(2 * e + 1) * 128] = S[e].y; } }
        asm volatile("" ::: "memory");
    }
#undef GDS_LOAD
}

__device__ __forceinline__ void gdn_sample_cols(LAS float* sl, const bf16_t* __restrict__ GQKV, const float* __restrict__ GA, const float* __restrict__ GB, float* __restrict__ yraw,
                                                const float* __restrict__ st_in, float* __restrict__ st_out, int task, int lane) {
    const int bh = task >> 1, j = (task & 1) * 64 + lane, h = bh & 7, row0 = MPR + (bh >> 3) * 8;
    LAS float* KB = sl; LAS float* QB = sl + 1024; LAS float* VB = sl + 2048; LAS float* AB = sl + 2560;
    f32x2v S[64];
    { const float* sp = st_in + (size_t)bh * 16384 + j;
#pragma unroll
      for (int i = 0; i < 64; ++i) { S[i] = (f32x2v){sp[0], sp[128]}; sp += 256; asm volatile("" : "+v"(sp)); } }
    {
        uint4 st[4];
#pragma unroll
        for (int i = 0; i < 4; ++i) { const int id = i * 64 + lane, s = id >> 7, step = (id >> 4) & 7, pc = id & 15;
            st[i] = *(const uint4*)(GQKV + (size_t)(row0 + step) * 3072 + (s == 0 ? 1024 : 0) + h * 128 + pc * 8); }
        unsigned short vv[8];
#pragma unroll
        for (int s = 0; s < 8; ++s) vv[s] = GQKV[(size_t)(row0 + s) * 3072 + 2048 + h * 128 + j];
        float sa = 0.f, sbt = 0.f;
        if (lane < 8) { sa = GA[(size_t)(row0 + lane) * 8 + h]; sbt = GB[(size_t)(row0 + lane) * 8 + h]; }
#pragma unroll
        for (int i = 0; i < 4; ++i) { const int id = i * 64 + lane, s = id >> 7, step = (id >> 4) & 7, pc = id & 15; float f[8]; unpack8(st[i], f);
            LAS float* d = (s == 0 ? KB : QB) + step * 128 + pc * 8; *(LAS f32x4v*)d = (f32x4v){f[0], f[1], f[2], f[3]}; *(LAS f32x4v*)(d + 4) = (f32x4v){f[4], f[5], f[6], f[7]}; }
#pragma unroll
        for (int s = 0; s < 8; ++s) VB[s * 64 + lane] = bf_lo((unsigned)vv[s]);
        if (lane < 8) { AB[lane * 2] = sa; AB[lane * 2 + 1] = sbt; }
        asm volatile("s_waitcnt lgkmcnt(0)" ::: "memory");
    }
#pragma unroll 1
    for (int s = 0; s < 8; ++s) {
        const LAS float* kb = KB + s * 128; const LAS float* qb = QB + s * 128;
        const float v = VB[s * 64 + lane], a = AB[s * 2], beta = AB[s * 2 + 1];
        f32x2v acc0 = (f32x2v){0.f, 0.f}, acc1 = (f32x2v){0.f, 0.f};
#pragma unroll
        for (int i = 0; i < 32; ++i) { const f32x4v kq = *(const LAS f32x4v*)(kb + 4 * i); acc0 = S[2 * i] * kq.lo + acc0; acc1 = S[2 * i + 1] * kq.hi + acc1; if ((i & 7) == 7) __builtin_amdgcn_sched_barrier(0); }
        acc0 += acc1;
        const float kS = acc0.x + acc0.y;
        const float cf = beta * (v - a * kS);
        const f32x2v cf2 = (f32x2v){cf, cf}, a2 = (f32x2v){a, a};
        f32x2v o0 = (f32x2v){0.f, 0.f}, o1 = (f32x2v){0.f, 0.f};
#pragma unroll
        for (int i = 0; i < 32; ++i) { const f32x4v kq = *(const LAS f32x4v*)(kb + 4 * i), qq = *(const LAS f32x4v*)(qb + 4 * i);
            S[2 * i] = S[2 * i] * a2 + kq.lo * cf2; S[2 * i + 1] = S[2 * i + 1] * a2 + kq.hi * cf2;
            o0 = S[2 * i] * qq.lo + o0; o1 = S[2 * i + 1] * qq.hi + o1; if ((i & 3) == 3) __builtin_amdgcn_sched_barrier(0); }
        o0 += o1;
        yraw[(size_t)(row0 + s) * 2048 + h * 128 + j] = o0.x + o0.y;
    }
    { float* dp = st_out + (size_t)bh * 16384 + j;
#pragma unroll
      for (int i = 0; i < 64; ++i) { dp[0] = S[i].x; dp[128] = S[i].y; dp += 256; asm volatile("" : "+v"(dp)); } }
    asm volatile("s_waitcnt lgkmcnt(0)" ::: "memory");
}

__device__ __forceinline__ float reduce16(float v) { v = reduce8(v); v += dppf<0x140>(v); return v; }
__device__ __forceinline__ void gdn_prompt_block(LAS float* L, const bf16_t* __restrict__ GQKV, const float* __restrict__ GA, const float* __restrict__ GB, float* __restrict__ yraw,
                                                 int row0, int T, int h, int jblk, float* __restrict__ s_out, int tid, int wave, int lane) {
    constexpr int BUF = 4768;
    const int part = lane & 15, cc = lane >> 4, j0 = jblk + wave * 4, rdoff = part * 8 + (part >> 3) * 4;
    f32x2v S[4];
#pragma unroll
    for (int e = 0; e < 4; ++e) S[e] = (f32x2v){0.f, 0.f};
    const int ss = tid >> 8, sstep = (tid >> 4) & 15, spc = tid & 15, vstep = (tid >> 2) & 15, vp = tid & 3, astep = tid & 15;
    uint4 st, sv = make_uint4(0, 0, 0, 0); float sa = 0.f, sbt = 0.f;
    const int nch = T >> 4;
#define GB_LOAD(c) do { const int t0_ = (c) * 16; st = *(const uint4*)(GQKV + (size_t)(row0 + t0_ + sstep) * 3072 + (ss == 0 ? 1024 : 0) + h * 128 + spc * 8); \
        if (tid < 64) sv = *(const uint4*)(GQKV + (size_t)(row0 + t0_ + vstep) * 3072 + 2048 + h * 128 + jblk + vp * 8); \
        else if (tid < 80) { sa = GA[(size_t)(row0 + t0_ + astep) * 8 + h]; sbt = GB[(size_t)(row0 + t0_ + astep) * 8 + h]; } } while (0)
#define GB_WRITE(b) do { LAS float* base = L + (b) * BUF; { float f[8]; unpack8(st, f); LAS float* d = base + ss * 2112 + sstep * 132 + spc * 8 + (spc >> 3) * 4; \
            *(LAS f32x4v*)d = (f32x4v){f[0], f[1], f[2], f[3]}; *(LAS f32x4v*)(d + 4) = (f32x4v){f[4], f[5], f[6], f[7]}; } \
        if (tid < 64) { float f[8]; unpack8(sv, f); LAS float* d = base + 4224 + vstep * 32 + vp * 8; *(LAS f32x4v*)d = (f32x4v){f[0], f[1], f[2], f[3]}; *(LAS f32x4v*)(d + 4) = (f32x4v){f[4], f[5], f[6], f[7]}; } \
        else if (tid < 80) { base[4736 + astep * 2] = sa; base[4736 + astep * 2 + 1] = sbt; } } while (0)
    GB_LOAD(0); GB_WRITE(0);
    __syncthreads();
    for (int c = 0; c < nch; ++c) {
        if (c + 1 < nch) GB_LOAD(c + 1);
        __builtin_amdgcn_sched_barrier(0);
        const LAS float* base = L + (c & 1) * BUF;
        float os[16];
        f32x2v k[4], q[4], nk[4], nq[4]; float v, a, beta, nv, na, nbeta;
#define GB_OPS(s_) do { const LAS float* kb = base + (s_) * 132 + rdoff; const LAS float* qb = base + 2112 + (s_) * 132 + rdoff; \
            _Pragma("unroll") for (int i = 0; i < 2; ++i) { const f32x4v t0 = *(const LAS f32x4v*)(kb + 4 * i), t1 = *(const LAS f32x4v*)(qb + 4 * i); \
                nk[2 * i] = t0.lo; nk[2 * i + 1] = t0.hi; nq[2 * i] = t1.lo; nq[2 * i + 1] = t1.hi; } \
            nv = base[4224 + (s_) * 32 + wave * 4 + cc]; na = base[4736 + (s_) * 2]; nbeta = base[4736 + (s_) * 2 + 1]; } while (0)
        GB_OPS(0);
#pragma unroll
        for (int s = 0; s < 16; ++s) {
#pragma unroll
            for (int i = 0; i < 4; ++i) { k[i] = nk[i]; q[i] = nq[i]; }
            v = nv; a = na; beta = nbeta;
            if (s < 15) GB_OPS(s + 1);
            __builtin_amdgcn_sched_barrier(0);
            f32x2v acc = S[0] * k[0], acc1 = S[1] * k[1]; acc = S[2] * k[2] + acc; acc1 = S[3] * k[3] + acc1; acc += acc1;
            const float kS = reduce16(acc.x + acc.y);
            const float cf = beta * (v - a * kS);
            const f32x2v cf2 = (f32x2v){cf, cf}, a2 = (f32x2v){a, a};
#pragma unroll
            for (int i = 0; i < 4; ++i) S[i] = S[i] * a2 + k[i] * cf2;
            f32x2v oa = S[0] * q[0], oa1 = S[1] * q[1]; oa = S[2] * q[2] + oa; oa1 = S[3] * q[3] + oa1; oa += oa1;
            os[s] = reduce16(oa.x + oa.y);
            __builtin_amdgcn_sched_barrier(0);
        }
#undef GB_OPS
        { float osel = os[0];
#pragma unroll
          for (int i = 1; i < 16; ++i) osel = (part == i) ? os[i] : osel;
          yraw[(size_t)(row0 + c * 16 + part) * 2048 + h * 128 + j0 + cc] = osel; }
        if (c + 1 < nch) GB_WRITE((c + 1) & 1);
        __syncthreads();
    }
#undef GB_LOAD
#undef GB_WRITE
#pragma unroll
    for (int e = 0; e < 4; ++e) { s_out[(size_t)(part * 8 + 2 * e) * 128 + j0 + cc] = S[e].x; s_out[(size_t)(part * 8 + 2 * e + 1) * 128 + j0 + cc] = S[e].y; }
}
__device__ __forceinline__ void rwkv_prompt_block(LAS float* L, const bf16_t* __restrict__ RS, const bf16_t* __restrict__ RV, const float* __restrict__ RW, float* __restrict__ yraw,
                                                  int row0, int T, int h, int vblk, float* __restrict__ s_out, int tid, int wave, int lane) {
    constexpr int BUF = 5632;
    const int part = lane & 15, rr = lane >> 4, v0 = vblk + wave * 4;
    f32x2v S[2] = {(f32x2v){0.f, 0.f}, (f32x2v){0.f, 0.f}};
    const int sstep = tid >> 5, ss = (tid >> 3) & 3, spc = tid & 7, wstep = (tid >> 4) & 15, wpc = tid & 15, vstep = (tid >> 2) & 15, vp = tid & 3;
    uint4 st, sv = make_uint4(0, 0, 0, 0); float4 sw = make_float4(0.f, 0.f, 0.f, 0.f);
    const int nch = T >> 4;
#define RB_LOAD(c) do { const int t0_ = (c) * 16; st = *(const uint4*)(RS + (size_t)(row0 + t0_ + sstep) * 4096 + ss * 1024 + h * 64 + spc * 8); \
        if (tid < 256) sw = *(const float4*)(RW + (size_t)(row0 + t0_ + wstep) * 1024 + h * 64 + wpc * 4); \
        else if (tid < 320) sv = *(const uint4*)(RV + (size_t)(row0 + t0_ + vstep) * 1024 + h * 64 + vblk + vp * 8); } while (0)
#define RB_WRITE(b) do { LAS float* base = L + (b) * BUF; { float f[8]; unpack8(st, f); LAS float* d = base + (sstep * 4 + ss) * 64 + spc * 8; \
            *(LAS f32x4v*)d = (f32x4v){f[0], f[1], f[2], f[3]}; *(LAS f32x4v*)(d + 4) = (f32x4v){f[4], f[5], f[6], f[7]}; } \
        if (tid < 256) *(LAS f32x4v*)(base + 4096 + wstep * 64 + wpc * 4) = (f32x4v){sw.x, sw.y, sw.z, sw.w}; \
        else if (tid < 320) { float f[8]; unpack8(sv, f); LAS float* d = base + 5120 + vstep * 32 + vp * 8; *(LAS f32x4v*)d = (f32x4v){f[0], f[1], f[2], f[3]}; *(LAS f32x4v*)(d + 4) = (f32x4v){f[4], f[5], f[6], f[7]}; } } while (0)
    RB_LOAD(0); RB_WRITE(0);
    __syncthreads();
    for (int c = 0; c < nch; ++c) {
        if (c + 1 < nch) RB_LOAD(c + 1);
        __builtin_amdgcn_sched_barrier(0);
        const LAS float* base = L + (c & 1) * BUF;
        float ys[16];
        f32x4v kk, ka, kp, r, w, nkk, nka, nkp, nr, nw; float vv, nvv;
#define RB_OPS(s_) do { const LAS float* sb = base + (s_) * 256 + part * 4; nkk = *(const LAS f32x4v*)(sb); nka = *(const LAS f32x4v*)(sb + 64); nkp = *(const LAS f32x4v*)(sb + 128); nr = *(const LAS f32x4v*)(sb + 192); \
            nw = *(const LAS f32x4v*)(base + 4096 + (s_) * 64 + part * 4); nvv = base[5120 + (s_) * 32 + wave * 4 + rr]; } while (0)
        RB_OPS(0);
#pragma unroll
        for (int s = 0; s < 16; ++s) {
            kk = nkk; ka = nka; kp = nkp; r = nr; w = nw; vv = nvv;
            if (s < 15) RB_OPS(s + 1);
            __builtin_amdgcn_sched_barrier(0);
            f32x2v acc = S[0] * kk.lo + S[1] * kk.hi;
            const float sk = reduce16(acc.x + acc.y);
            const f32x2v nsk = (f32x2v){-sk, -sk}, vv2 = (f32x2v){vv, vv};
            S[0] = S[0] * w.lo + (ka.lo * nsk + kp.lo * vv2);
            S[1] = S[1] * w.hi + (ka.hi * nsk + kp.hi * vv2);
            f32x2v ya = S[0] * r.lo + S[1] * r.hi;
            ys[s] = reduce16(ya.x + ya.y);
            __builtin_amdgcn_sched_barrier(0);
        }
#undef RB_OPS
        { float ysel = ys[0];
#pragma unroll
          for (int i = 1; i < 16; ++i) ysel = (part == i) ? ys[i] : ysel;
          yraw[(size_t)(row0 + c * 16 + part) * 2048 + 1024 + h * 64 + v0 + rr] = ysel; }
        if (c + 1 < nch) RB_WRITE((c + 1) & 1);
        __syncthreads();
    }
#undef RB_LOAD
#undef RB_WRITE
    *(float4*)(s_out + (size_t)(v0 + rr) * 64 + part * 4) = make_float4(S[0].x, S[0].y, S[1].x, S[1].y);
}

__device__ __forceinline__ void post_tile(const Args& A, LAS float* lg, int tile, int tid) {
    const bf16_t* PROJ = (const bf16_t*)(A.ws + W_PROJ);
    const bf16_t* RS = (const bf16_t*)(A.ws + W_RS); const bf16_t* RV = (const bf16_t*)(A.ws + W_RV);
    bf16_t* MIXED = (bf16_t*)(A.ws + W_MIXED);
    const float* yraw = A.out + O_Y; const float* st_shift = A.in[5];
    const int row_base = tile * TT;
    const int c0 = tid * 2;
    float2 yv[TT], ov[TT]; unsigned rwv[TT], kwv[TT], vwv[TT], zwv[TT];
#pragma unroll
    for (int tk = 0; tk < TT; ++tk) { const int row = row_base + tk;
        yv[tk] = *(const float2*)(yraw + (size_t)row * 2048 + 1024 + c0); ov[tk] = *(const float2*)(yraw + (size_t)row * 2048 + c0);
        rwv[tk] = *(const unsigned*)(RS + (size_t)row * 4096 + 3072 + c0); kwv[tk] = *(const unsigned*)(RS + (size_t)row * 4096 + 2048 + c0); vwv[tk] = *(const unsigned*)(RV + (size_t)row * 1024 + c0);
        zwv[tk] = *(const unsigned*)(PROJ + (size_t)row * NINP + 3072 + c0); }
    {
        if (tid < 4 * 68) ((LAS unsigned*)lg)[TT * 68 + tid] = 0u;
        const float* mu = A.in[13];
#pragma unroll
        for (int i = 0; i < 2; ++i) { const int item = tid + 512 * i; if (item < TT * 64) { const int tk = item >> 6, jp = item & 63, row = row_base + tk; int grp, b, t, T; rowinfo(row, grp, b, t, T);
            const int col = 3200 + 2 * jp; const unsigned pw_ = *(const unsigned*)(PROJ + (size_t)row * NINP + OFFR + col);
            float q0, q1; if (t > 0) { const unsigned qw = *(const unsigned*)(PROJ + (size_t)(row - 1) * NINP + OFFR + col); q0 = bf_lo(qw); q1 = bf_hi(qw); }
            else if (grp) { const float2 sq = *(const float2*)(st_shift + (size_t)b * RPROJ + col); q0 = sq.x; q1 = sq.y; } else { q0 = 0.f; q1 = 0.f; }
            const float2 m2 = *(const float2*)(mu + col); const float p0 = bf_lo(pw_), p1 = bf_hi(pw_);
            ((LAS unsigned*)lg)[tk * 68 + jp] = pk2_safe(sigmoidf_(p0 + (q0 - p0) * m2.x), sigmoidf_(p1 + (q1 - p1) * m2.y)); } }
    }
    __syncthreads();
    {
        const int wv_ = __builtin_amdgcn_readfirstlane(tid >> 6), ti = tid & 15, quad = (tid & 63) >> 4;
        const LAS unsigned char* lb = (const LAS unsigned char*)lg + ti * 272 + quad * 16;
        pg8::bf16x8 bop[4];
#pragma unroll
        for (int ks = 0; ks < 4; ++ks) bop[ks] = *(const LAS pg8::bf16x8*)(lb + ks * 64);
        const bf16_t* WT = (const bf16_t*)((const unsigned char*)A.out + OB_GBT) + (size_t)(wv_ * 128 + ti) * 128 + quad * 8;
        LAS float* dst = lg + 2048 + (ti < TT ? ti : TT) * 1028 + wv_ * 128 + quad * 4;
#pragma unroll
        for (int hh = 0; hh < 2; ++hh) {
            pg8::bf16x8 aop[4][4];
#pragma unroll
            for (int t = 0; t < 4; ++t)
#pragma unroll
                for (int ks = 0; ks < 4; ++ks) aop[t][ks] = *(const pg8::bf16x8*)(WT + (size_t)(hh * 4 + t) * 16 * 128 + ks * 32);
#pragma unroll
            for (int t = 0; t < 4; ++t) {
                pg8::f32x4 c = (pg8::f32x4){0.f, 0.f, 0.f, 0.f};
#pragma unroll
                for (int ks = 0; ks < 4; ++ks) c = __builtin_amdgcn_mfma_f32_16x16x32_bf16(aop[t][ks], bop[ks], c, 0, 0, 0);
                *(LAS f32x4v*)(dst + (hh * 4 + t) * 16) = (f32x4v){c[0], c[1], c[2], c[3]};
            }
        }
    }
    __syncthreads();
    f32x2v gate[TT];
#pragma unroll
    for (int tk = 0; tk < TT; ++tk) gate[tk] = *(const LAS f32x2v*)(lg + 2048 + tk * 1028 + c0);
    const float2 gnw = *(const float2*)(A.in[22] + c0), gnb = *(const float2*)(A.in[23] + c0), rk = *(const float2*)(A.in[21] + c0);
    const float2 ng = *(const float2*)(A.in[12] + (c0 & 127));
#pragma unroll
    for (int tk = 0; tk < TT; ++tk) {
        const int row = row_base + tk;
        {
            const float2 y = yv[tk];
            const float mean = half_sum32(y.x + y.y) * (1.0f / 64.0f);
            const float d0 = y.x - mean, d1 = y.y - mean;
            const float var = half_sum32(d0 * d0 + d1 * d1) * (1.0f / 64.0f);
            const float rs = rsqrtf(var + 64e-5f);
            const unsigned rw = rwv[tk], kw = kwv[tk], vw = vwv[tk];
            const float bon = half_sum32(bf_lo(rw) * bf_lo(kw) * rk.x + bf_hi(rw) * bf_hi(kw) * rk.y);
            const float o0 = (d0 * rs * gnw.x + gnb.x + bon * bf_lo(vw)) * gate[tk].x, o1 = (d1 * rs * gnw.y + gnb.y + bon * bf_hi(vw)) * gate[tk].y;
            *(unsigned*)(MIXED + (size_t)row * 2048 + 1024 + c0) = pk2(o0, o1);
        }
        {
            const float2 o = ov[tk];
            const float rs = rsqrtf(wave_sum(o.x * o.x + o.y * o.y) * (1.0f / 128.0f) + 1e-6f);
            const unsigned zw = zwv[tk];
            *(unsigned*)(MIXED + (size_t)row * 2048 + c0) = pk2(o.x * rs * ng.x * siluf_(bf_lo(zw)), o.y * rs * ng.y * siluf_(bf_hi(zw)));
        }
    }
    __syncthreads();
}

__device__ __forceinline__ void act_item(const Args& A, int item, int lane) {
    const bf16_t* H = (const bf16_t*)(A.ws + W_H); bf16_t* ACT = (bf16_t*)(A.ws + W_ACT);
    const float* cwp = A.in[27]; const float* st_ffn = A.in[6];
    const int cgp = item % 11, rg = item / 11, ch = (cgp * 64 + lane) * 8;
    float cg_[3][8], cu_[3][8];
#pragma unroll
    for (int i = 0; i < 3; ++i) { const float4 a0 = *(const float4*)(cwp + (size_t)i * DFF2 + ch), a1 = *(const float4*)(cwp + (size_t)i * DFF2 + ch + 4), b0 = *(const float4*)(cwp + (size_t)i * DFF2 + DFF + ch), b1 = *(const float4*)(cwp + (size_t)i * DFF2 + DFF + ch + 4);
        cg_[i][0] = a0.x; cg_[i][1] = a0.y; cg_[i][2] = a0.z; cg_[i][3] = a0.w; cg_[i][4] = a1.x; cg_[i][5] = a1.y; cg_[i][6] = a1.z; cg_[i][7] = a1.w;
        cu_[i][0] = b0.x; cu_[i][1] = b0.y; cu_[i][2] = b0.z; cu_[i][3] = b0.w; cu_[i][4] = b1.x; cu_[i][5] = b1.y; cu_[i][6] = b1.z; cu_[i][7] = b1.w; }
    uint4 hg[11], hu[11];
#pragma unroll
    for (int i = 0; i < 11; ++i) { int r = rg * 9 - 2 + i; r = r < 0 ? 0 : r; hg[i] = *(const uint4*)(H + (size_t)r * DFF2 + ch); hu[i] = *(const uint4*)(H + (size_t)r * DFF2 + DFF + ch); }
#pragma unroll
    for (int rI = 0; rI < 9; ++rI) {
        const int row = rg * 9 + rI; int grp, b, t, T; rowinfo(row, grp, b, t, T);
        float g[8], u[8];
#pragma unroll
        for (int e = 0; e < 8; ++e) { g[e] = 0.f; u[e] = 0.f; }
#pragma unroll
        for (int i = 0; i < 3; ++i) { const int tt = t - 2 + i; float xg[8], xu[8];
            if (tt >= 0) { unpack8(hg[rI + i], xg); unpack8(hu[rI + i], xu); }
            else if (grp) { const float* sp = st_ffn + ((size_t)b * 2 + (t + i)) * DFF2 + ch; const float4 a0 = *(const float4*)sp, a1 = *(const float4*)(sp + 4), b0 = *(const float4*)(sp + DFF), b1 = *(const float4*)(sp + DFF + 4);
                xg[0] = a0.x; xg[1] = a0.y; xg[2] = a0.z; xg[3] = a0.w; xg[4] = a1.x; xg[5] = a1.y; xg[6] = a1.z; xg[7] = a1.w;
                xu[0] = b0.x; xu[1] = b0.y; xu[2] = b0.z; xu[3] = b0.w; xu[4] = b1.x; xu[5] = b1.y; xu[6] = b1.z; xu[7] = b1.w; }
            else {
#pragma unroll
                for (int e = 0; e < 8; ++e) { xg[e] = 0.f; xu[e] = 0.f; } }
#pragma unroll
            for (int e = 0; e < 8; ++e) { g[e] += cg_[i][e] * xg[e]; u[e] += cu_[i][e] * xu[e]; } }
        float o[8];
#pragma unroll
        for (int e = 0; e < 8; ++e) o[e] = siluf_(g[e]) * u[e];
        uint4 w; w.x = pk2(o[0], o[1]); w.y = pk2(o[2], o[3]); w.z = pk2(o[4], o[5]); w.w = pk2(o[6], o[7]);
        *(uint4*)(ACT + (size_t)row * DFF + ch) = w;
    }
}

__device__ __forceinline__ void fast_grid_barrier(unsigned* bar, unsigned round, unsigned G) {
    asm volatile("s_waitcnt vmcnt(0)" ::: "memory");
    __syncthreads();
    if (threadIdx.x == 0) {
        __builtin_amdgcn_fence(__ATOMIC_RELEASE, "agent");
        asm volatile("s_waitcnt vmcnt(0)" ::: "memory");
        const unsigned g = blockIdx.x >> 4, ngroups = (G + 15u) >> 4, gsize = (G - g * 16u) < 16u ? (G - g * 16u) : 16u;
        unsigned* cnt = bar + 32u * (1u + g); unsigned* top = bar + 32u * 20u; unsigned* gen = bar + 32u * (24u + g);
        const unsigned old = __hip_atomic_fetch_add(cnt, 1u, __ATOMIC_RELAXED, __HIP_MEMORY_SCOPE_AGENT);
        if (old + 1u == round * gsize) {
            const unsigned t = __hip_atomic_fetch_add(top, 1u, __ATOMIC_RELAXED, __HIP_MEMORY_SCOPE_AGENT);
            if (t + 1u == round * ngroups) { for (unsigned q = 0; q < ngroups; ++q) __hip_atomic_store(bar + 32u * (24u + q), round, __ATOMIC_RELAXED, __HIP_MEMORY_SCOPE_AGENT); }
        }
        unsigned sp = 0u;
        while (__hip_atomic_load(gen, __ATOMIC_RELAXED, __HIP_MEMORY_SCOPE_AGENT) < round) { __builtin_amdgcn_s_sleep(1); if (++sp > (1u << 22)) break; }
        __builtin_amdgcn_fence(__ATOMIC_ACQUIRE, "agent");
        asm volatile("s_waitcnt vmcnt(0)" ::: "memory");
    }
    __syncthreads();
}

__global__ void __launch_bounds__(512, 2) hymba_fwd(Args A) {
    extern __shared__ __attribute__((aligned(16))) unsigned char lds_raw[];
    LAS unsigned char* lds = (LAS unsigned char*)lds_raw;
    cg::grid_group grid = cg::this_grid();
    const int tid = threadIdx.x, lane = tid & 63, wave = __builtin_amdgcn_readfirstlane(tid >> 6);
    const int G = gridDim.x, bx = blockIdx.x, gw = bx * 8 + wave, NGW = G * 8;
    const int lo = A.ph_lo, hi = A.ph_hi;
#define IN(k) (lo <= (k) && (k) < hi)
    unsigned* barcnt = (unsigned*)(A.ws + W_BAR); unsigned nbar = 0u;
#define SEAM(k) do { if (IN(k) && IN((k) + 1)) { ++nbar; fast_grid_barrier(barcnt, nbar, (unsigned)G); } } while (0)
    if (hi < 0) grid.sync();
    unsigned char* ws = A.ws; float* out = A.out;
    bf16_t* XN = (bf16_t*)(out + O_GDN_S);
    bf16_t* WT_IN = (bf16_t*)(out + O_RWKV_S);
    bf16_t* WT_O = (bf16_t*)(ws + W_WTO); bf16_t* WT_UP = (bf16_t*)(ws + W_WTUP); bf16_t* WT_DN = (bf16_t*)(ws + W_WTDN);
    bf16_t* PROJ = (bf16_t*)(ws + W_PROJ); bf16_t* MIXED = (bf16_t*)(ws + W_MIXED); bf16_t* XN2 = (bf16_t*)(ws + W_XN2);
    bf16_t* HB = (bf16_t*)(ws + W_H); bf16_t* ACT = (bf16_t*)(ws + W_ACT);
    float* X1 = out + O_Y; float* PART = (float*)(ws + W_PART);

    if (IN(0)) {
        LAS float* scr = (LAS float*)(lds + wave * 16384);
        constexpr int I_IN = 32 * (NINP / 64);
        for (int it = gw; it < I_IN; it += NGW) transpose_item(A.in[8], DM, NIN, WT_IN, scr, it, NINP / 64, lane);
        for (int i = bx * 512 + tid; i < 4096; i += G * 512) {
            int r = i; const float* W; bf16_t* WT; int K, j0;
            if (r < 1024) { W = A.in[15]; WT = (bf16_t*)((unsigned char*)out + OB_WBT); K = 64; j0 = 0; }
            else if (r < 2048) { r -= 1024; W = A.in[17]; WT = (bf16_t*)((unsigned char*)out + OB_ABT); K = 64; j0 = 0; }
            else { r -= 2048; W = A.in[18]; WT = (bf16_t*)((unsigned char*)out + OB_GBT); K = 128; j0 = (r >> 10) * 64; r &= 1023; }
            const int ch = r;
#pragma unroll
            for (int q = 0; q < 8; ++q) { float f[8];
#pragma unroll
                for (int e = 0; e < 8; ++e) f[e] = W[(size_t)(j0 + q * 8 + e) * 1024 + ch];
                uint4 o; o.x = pk2(f[0], f[1]); o.y = pk2(f[2], f[3]); o.z = pk2(f[4], f[5]); o.w = pk2(f[6], f[7]);
                *(uint4*)(WT + (size_t)ch * K + j0 + q * 8) = o; }
        }
        for (int m = gw; m < MTOK; m += NGW) { const float* xr = (m < MPR) ? A.in[0] + (size_t)m * DM : A.in[1] + (size_t)(m - MPR) * DM; rms_row_bf16(xr, A.in[7], XN + (size_t)m * DM, lane); }
        __syncthreads();
    }
    SEAM(0);
    if (IN(1)) {
        pg8::Gemm g{XN, WT_IN, MTOK, NINP, DM}; pg8::StaticOrder S; S.init(MTOK, NINP, DM, G, bx);
        pg8::EpiBf16P E{PROJ, NINP};
        pg8::gemm_phase<pg8::EpiBf16P, pg8::StaticOrder, true, true>(lds, g, S, E);
    }
    SEAM(1);
    if (IN(2)) { for (int tile = bx; tile < NTILES; tile += G) prep_tile(A, (LAS float*)lds, tile, tid); }
    SEAM(2);
    if (IN(3)) {
        LAS float* sl = (LAS float*)(lds + wave * 16384);
        const bf16_t* GQKV = (const bf16_t*)(ws + W_GQKV); const float* GA = (const float*)(ws + W_GAB); const float* GB = GA + MTOK * 8;
        const bf16_t* RS = (const bf16_t*)(ws + W_RS); const bf16_t* RV = (const bf16_t*)(ws + W_RV); const float* RW = (const float*)(ws + W_RW);
        float* yraw = out + O_Y;
        const bool heavy = (G == 256) && (bx >= 128);
        const int nshare = (G == 256) ? 3072 : NGW, share0 = (G == 256) ? (heavy ? 1024 + ((bx - 128) * 8 + wave) * 2 : gw) : gw, nsh = heavy ? 2 : 1;
        for (int task = gw; task < 2048; task += NGW) gdn_sample_cols(sl, GQKV, GA, GB, yraw, A.in[2], out + O_GDN_S, task, lane);
        for (int sh = 0; sh < nsh; ++sh) {
            rwkv_sample_loop(sl, RS, RV, RW, yraw, A.in[4], out + O_RWKV_S, share0 + sh, nshare, lane);
            constexpr int I_O = 32 * (DM / 64), I_UP = 32 * (DFF2 / 64), I_DN = (DFF / 64) * (DM / 64);
            for (int it = share0 + sh; it < I_O + I_UP + I_DN; it += nshare) {
                int r = it;
                if (r < I_O) { transpose_item(A.in[24], DM, DM, WT_O, sl, r, DM / 64, lane); continue; } r -= I_O;
                if (r < I_UP) { transpose_item(A.in[26], DM, DFF2, WT_UP, sl, r, DFF2 / 64, lane); continue; } r -= I_UP;
                transpose_item(A.in[28], DFF, DM, WT_DN, sl, r, DM / 64, lane);
            }
        }
        __syncthreads();
        for (int u = bx; u < 256; u += G) {
            if (u < 128) { const int bh = u >> 2, cq = u & 3;
                gdn_prompt_block((LAS float*)lds, GQKV, GA, GB, yraw, (bh >> 3) * 2048, 2048, bh & 7, cq * 32, out + O_GDN_P + (size_t)bh * 16384, tid, wave, lane); }
            else { const int uu = u - 128, bh = uu >> 1, hf = uu & 1;
                rwkv_prompt_block((LAS float*)lds, RS, RV, RW, yraw, (bh >> 4) * 2048, 2048, bh & 15, hf * 32, out + O_RWKV_P + (size_t)bh * 4096, tid, wave, lane); }
        }
        __syncthreads();
    }
    SEAM(3);
    if (IN(4)) {
        for (int tile = bx; tile < NTILES; tile += G) post_tile(A, (LAS float*)lds, tile, tid);
    }
    SEAM(4);
    if (IN(5)) {
        pg8::Gemm g{MIXED, WT_O, MTOK, DM, DM}; pg8::SplitOrder S; S.init(DM, bx);
        pg8::EpiResSplit E{A.in[0], X1, PART};
        pg8::gemm_phase<pg8::EpiResSplit, pg8::SplitOrder, true, true>(lds, g, S, E);
    }
    SEAM(5);
    if (IN(6)) {
        LAS float* scr = (LAS float*)(lds + wave * 16384);
        for (int m = gw; m < MTOK; m += NGW) {
            if (m >= MPR) { const float4* xs = (const float4*)(A.in[1] + (size_t)(m - MPR) * DM); float4* xo = (float4*)(X1 + (size_t)m * DM);
#pragma unroll
                for (int j = 0; j < 8; ++j) { float4 a = xs[lane + 64 * j];
#pragma unroll
                    for (int sg = 0; sg < 8; ++sg) { const float4 b = ((const float4*)(PART + ((size_t)sg * 1024 + (m - MPR)) * DM))[lane + 64 * j]; a.x += b.x; a.y += b.y; a.z += b.z; a.w += b.w; }
                    xo[lane + 64 * j] = a; } }
            rms_row_bf16(X1 + (size_t)m * DM, A.in[25], XN2 + (size_t)m * DM, lane);
        }
        __syncthreads();
    }
    SEAM(6);
    if (IN(7)) {
        pg8::Gemm g{XN2, WT_UP, MTOK, DFF2, DM}; pg8::StaticOrder S; S.init(MTOK, DFF2, DM, G, bx);
        pg8::EpiH E{HB, out + O_FFN_P, out + O_FFN_S};
        pg8::gemm_phase<pg8::EpiH, pg8::StaticOrder, true, true>(lds, g, S, E);
    }
    SEAM(7);
    if (IN(8)) { for (int it = gw; it < 11 * (MTOK / 9); it += NGW) act_item(A, it, lane); }
    SEAM(8);
    if (IN(9)) {
        pg8::Gemm g{ACT, WT_DN, MTOK, DM, DFF}; pg8::SplitOrder S; S.init(DFF, bx);
        pg8::EpiResSplit E{X1, X1, PART};
        pg8::gemm_phase<pg8::EpiResSplit, pg8::SplitOrder, true, true>(lds, g, S, E);
    }
    SEAM(9);
    if (IN(10)) { for (int m = gw; m < MTOK; m += NGW) {
            if (m >= MPR) { float4* xo = (float4*)(X1 + (size_t)m * DM);
#pragma unroll
                for (int j = 0; j < 8; ++j) { float4 a = xo[lane + 64 * j];
#pragma unroll
                    for (int sg = 0; sg < 8; ++sg) { const float4 b = ((const float4*)(PART + ((size_t)sg * 1024 + (m - MPR)) * DM))[lane + 64 * j]; a.x += b.x; a.y += b.y; a.z += b.z; a.w += b.w; }
                    xo[lane + 64 * j] = a; } }
            rms_row_f32_inplace(X1 + (size_t)m * DM, A.in[29], lane); } }
#undef IN
#undef SEAM
}

#ifndef N_LAUNCH_SPLIT
#define N_LAUNCH_SPLIT 0
#endif
extern "C" void kernel_launch(void* const* d_in, const int* in_sizes, int n_in, void* d_out, int out_size, void* d_ws, size_t ws_size, hipStream_t stream) {
    static int grid = 0;
    if (grid == 0) {
        int dev = 0, cus = 0, per_cu = 0;
        hipGetDevice(&dev);
        hipDeviceGetAttribute(&cus, hipDeviceAttributeMultiprocessorCount, dev);
        if (hipFuncSetAttribute((const void*)hymba_fwd, hipFuncAttributeMaxDynamicSharedMemorySize, LDS_BYTES) != hipSuccess) fprintf(stderr, "kernel_launch: hipFuncSetAttribute failed\n");
        if (hipOccupancyMaxActiveBlocksPerMultiprocessor(&per_cu, (const void*)hymba_fwd, 512, LDS_BYTES) != hipSuccess || per_cu < 1) { fprintf(stderr, "kernel_launch: occupancy query says %d\n", per_cu); per_cu = 1; }
        (void)hipGetLastError();
        grid = cus * 1;
        if (n_in != 30 || out_size != (int)O_END || ws_size < W_END4) fprintf(stderr, "kernel_launch: unexpected sizes n_in %d out %d ws %zu (need %zu)\n", n_in, out_size, ws_size, (size_t)W_END3);
    }
    if (hipMemsetAsync((char*)d_ws + W_BAR, 0, 8192, stream) != hipSuccess) fprintf(stderr, "kernel_launch: memset of the barrier word failed\n");
    Args a{};
    for (int i = 0; i < 30; ++i) a.in[i] = (const float*)d_in[i];
    a.out = (float*)d_out; a.ws = (unsigned char*)d_ws;
#if N_LAUNCH_SPLIT
    for (int p = 0; p <= 10; ++p) { a.ph_lo = p; a.ph_hi = p + 1; void* args[] = {&a};
        hipError_t e = hipLaunchCooperativeKernel((const void*)hymba_fwd, dim3(grid), dim3(512), args, LDS_BYTES, stream);
        if (e != hipSuccess) { fprintf(stderr, "kernel_launch: launch of phase %d failed: %s\n", p, hipGetErrorString(e)); break; } }
#else
    a.ph_lo = 0; a.ph_hi = 11; void* args[] = {&a};
    hipError_t e = hipLaunchCooperativeKernel((const void*)hymba_fwd, dim3(grid), dim3(512), args, LDS_BYTES, stream);
    if (e != hipSuccess) fprintf(stderr, "kernel_launch: cooperative launch failed: %s (grid %d)\n", hipGetErrorString(e), grid);
#endif
}
```

```cpp
#include <hip/hip_runtime.h>
#include <hip/hip_cooperative_groups.h>
#include <cstdio>
#include <cstdint>
namespace cg = cooperative_groups;
namespace pg8 {
#define PG8_LAS __attribute__((address_space(3)))
typedef unsigned short bf16_t;
typedef short bf16x8 __attribute__((ext_vector_type(8)));
typedef float f32x4 __attribute__((ext_vector_type(4)));
typedef unsigned u32x4 __attribute__((ext_vector_type(4)));
constexpr int BM = 256, BK = 64, HALF = 128, HTB = HALF * BK * 2  , STAGE_BYTES = 8 * HTB, NXCD = 8, WGM = 8;

__host__ __device__ __forceinline__ int lds_byte(int r, int c) { const int st = (r >> 4) * 2 + (c >> 5), rr = r & 15, cc = c & 31, ob = rr * 64 + cc * 2; return st * 1024 + (ob ^ (((ob >> 9) & 1) << 5)); }
__host__ __device__ __forceinline__ void stage_rc(int b, int& R, int& C) { const int st = b / 1024, sb = b % 1024, swz = sb ^ (((sb >> 9) & 1) << 5); R = (st >> 1) * 16 + swz / 64; C = (st & 1) * 32 + (swz % 64) / 2; }
__host__ __device__ __forceinline__ int perm32(int rho) { const int n = rho >> 4, i = rho & 15; return 8 * (i >> 2) + 4 * n + (i & 3); }

struct Unit { int pm, pn, k0, nt, seg; };
struct Gemm { const bf16_t* A; const bf16_t* Bt; int M, N, K; };

struct StaticOrder {
    int nM, nN, nwg, G, c, ntk;
    __host__ __device__ void init(int M, int N, int K, int G_, int c_) { nM = M / BM; nN = N / BM; nwg = nM * nN; G = G_; c = c_; ntk = K / BK; }
    __host__ __device__ bool next(int i, Unit& u) const {
        const long L = (long)i * G + c; if (L >= nwg) return false;
        int wgid = (int)L; { const int q = nwg / NXCD, r = nwg % NXCD, xcd = wgid % NXCD, off = wgid / NXCD; wgid = (xcd < r ? xcd * (q + 1) : r * (q + 1) + (xcd - r) * q) + off; }
        const int nig = WGM * nN, gid = wgid / nig, fm = gid * WGM, gsz = (nM - fm) < WGM ? (nM - fm) : WGM;
        u.pm = fm + ((wgid % nig) % gsz); u.pn = (wgid % nig) / gsz; u.k0 = 0; u.nt = ntk; u.seg = 0; return true;
    }
    __device__ __forceinline__ void a_ready(const Unit&) const {}
    __device__ __forceinline__ void done(const Unit&) const {}
};
__device__ __forceinline__ unsigned cvt_pk_bf16(float lo, float hi) { unsigned r; asm volatile("v_cvt_pk_bf16_f32 %0, %1, %2" : "=v"(r) : "v"(lo), "v"(hi)); return r; }
template <class Epi, class Sched, bool ALIGN_EPI = false, bool SP2 = false>
__device__ __forceinline__ void gemm_phase(PG8_LAS unsigned char* lds, const Gemm g, const Sched& S, const Epi& E) {
    const int tid = threadIdx.x, wid = __builtin_amdgcn_readfirstlane(tid >> 6), lane = tid & 63, wr = wid >> 2, wc = wid & 3, fr = lane & 15, fq = lane >> 4;
    const int K = g.K;
    unsigned voffA[2], voffB[2];
#pragma unroll
    for (int i = 0; i < 2; ++i) { int R, C; stage_rc(tid * 16 + i * 8192, R, C); const int Rb = Epi::PERM ? ((R & ~31) + perm32(R & 31)) : R;
        voffA[i] = (unsigned)(R * K + C) * 2u; voffB[i] = (unsigned)(Rb * K + C) * 2u; }
    const size_t kstep = (size_t)(BK * 2);
    const size_t hstep = (size_t)HALF * K * 2;
    const size_t tstep = 2 * hstep;
    const unsigned ldsw = (unsigned)wid * 1024u;
    const int aoff = lds_byte(wr * 64 + fr, fq * 8), boff = lds_byte(wc * 32 + fr, fq * 8);
#define PG8_SA(b, h) (((b) * 2 + (h)) * HTB)
#define PG8_SB(b, h) ((4 + (b) * 2 + (h)) * HTB)
#define PG8_STAGE(bufoff, gbase, voff) do { _Pragma("unroll") for (int _i = 0; _i < 2; ++_i) \
        __builtin_amdgcn_global_load_lds((const unsigned*)((const char*)(gbase) + (voff)[_i]), (PG8_LAS unsigned*)(lds + (bufoff) + ldsw + _i * 8192), 16, 0, 0); } while (0)
#define PG8_LDA(dst, b, h) do { _Pragma("unroll") for (int m = 0; m < 4; ++m) _Pragma("unroll") for (int k = 0; k < 2; ++k) dst[m][k] = *(const PG8_LAS bf16x8*)(lds + PG8_SA(b, h) + aoff + m * 2048 + k * 1024); } while (0)
#define PG8_LDB(dst, b, h) do { _Pragma("unroll") for (int n = 0; n < 2; ++n) _Pragma("unroll") for (int k = 0; k < 2; ++k) dst[n][k] = *(const PG8_LAS bf16x8*)(lds + PG8_SB(b, h) + boff + n * 2048 + k * 1024); } while (0)
#define PG8_MMA(ai, bj, At, Bt) do { __builtin_amdgcn_s_setprio(1); _Pragma("unroll") for (int m = 0; m < 4; ++m) _Pragma("unroll") for (int n = 0; n < 2; ++n) _Pragma("unroll") for (int k = 0; k < 2; ++k) \
        acc[ai][bj][m][n] = __builtin_amdgcn_mfma_f32_16x16x32_bf16(Bt[n][k], At[m][k], acc[ai][bj][m][n], 0, 0, 0); __builtin_amdgcn_s_setprio(0); } while (0)
#define PG8_WAIT_V(n) asm volatile("s_waitcnt vmcnt(" #n ")" ::: "memory")
#define PG8_WAIT_L(n) asm volatile("s_waitcnt lgkmcnt(" #n ")" ::: "memory")
#define PG8_BAR __builtin_amdgcn_s_barrier()
#define PG8_SCHED __builtin_amdgcn_sched_barrier(0)
    Unit cur, nxt; int ui = 0;
    if (!S.next(0, cur)) return;
    f32x4 acc[2][2][4][2];
#pragma unroll
    for (int a = 0; a < 2; ++a)
#pragma unroll
        for (int b = 0; b < 2; ++b)
#pragma unroll
            for (int m = 0; m < 4; ++m)
#pragma unroll
                for (int n = 0; n < 2; ++n) acc[a][b][m][n] = (f32x4){0.f, 0.f, 0.f, 0.f};
    bf16x8 At[4][2], B0[2][2], B1[2][2];
    const char* cA = (const char*)g.A + (size_t)cur.pm * tstep + (size_t)cur.k0 * kstep; const char* cB = (const char*)g.Bt + (size_t)cur.pn * tstep + (size_t)cur.k0 * kstep;
    S.a_ready(cur);
    if constexpr (SP2) {
        PG8_STAGE(PG8_SB(0, 0), cB, voffB); PG8_STAGE(PG8_SB(0, 1), cB + hstep, voffB); PG8_STAGE(PG8_SA(0, 0), cA, voffA); PG8_STAGE(PG8_SA(0, 1), cA + hstep, voffA);
        if (wr == 1) PG8_BAR;
        PG8_WAIT_V(2); PG8_BAR;
        PG8_STAGE(PG8_SB(1, 0), cB + kstep, voffB); PG8_STAGE(PG8_SA(1, 0), cA + kstep, voffA); PG8_STAGE(PG8_SB(1, 1), cB + hstep + kstep, voffB);
        PG8_WAIT_V(6); PG8_BAR;
    } else {
        PG8_STAGE(PG8_SB(0, 0), cB, voffB); PG8_STAGE(PG8_SA(0, 0), cA, voffA); PG8_STAGE(PG8_SB(0, 1), cB + hstep, voffB); PG8_STAGE(PG8_SA(0, 1), cA + hstep, voffA);
        if (wr == 1) PG8_BAR;
        PG8_WAIT_V(4); PG8_BAR;
        PG8_STAGE(PG8_SB(1, 0), cB + kstep, voffB); PG8_STAGE(PG8_SA(1, 0), cA + kstep, voffA); PG8_STAGE(PG8_SB(1, 1), cB + hstep + kstep, voffB);
        PG8_WAIT_V(6); PG8_BAR;
    }
    for (;;) {
        const bool has_next = S.next(ui + 1, nxt);
        const char* nA = has_next ? (const char*)g.A + (size_t)nxt.pm * tstep + (size_t)nxt.k0 * kstep : cA; const char* nB = has_next ? (const char*)g.Bt + (size_t)nxt.pn * tstep + (size_t)nxt.k0 * kstep : cB;
        const int nt = cur.nt;
        for (int t = 0; t < nt; t += 2) {
            const bool last = (t == nt - 2);
            const char* a1 = cA + (size_t)(t + 1) * kstep;
            const char* a2 = last ? nA : cA + (size_t)(t + 2) * kstep; const char* b2 = last ? nB : cB + (size_t)(t + 2) * kstep;
            const char* a3 = a2 + kstep; const char* b3 = b2 + kstep;
            if (last && has_next) S.a_ready(nxt);
            if constexpr (SP2) {
            PG8_LDB(B0, 0, 0); PG8_LDB(B1, 0, 1); PG8_SCHED; PG8_LDA(At, 0, 0); PG8_STAGE(PG8_SA(1, 1), a1 + hstep, voffA);
            PG8_WAIT_V(8); PG8_WAIT_L(0); PG8_BAR; PG8_MMA(0, 0, At, B0); PG8_MMA(0, 1, At, B1); PG8_BAR; PG8_SCHED;
            PG8_LDA(At, 0, 1); PG8_STAGE(PG8_SB(0, 0), b2, voffB); PG8_STAGE(PG8_SB(0, 1), b2 + hstep, voffB); PG8_STAGE(PG8_SA(0, 0), a2, voffA);
            PG8_WAIT_V(8); PG8_WAIT_L(0); PG8_BAR; PG8_MMA(1, 0, At, B0); PG8_MMA(1, 1, At, B1); PG8_BAR; PG8_SCHED;
            PG8_LDB(B0, 1, 0); PG8_LDB(B1, 1, 1); PG8_SCHED; PG8_LDA(At, 1, 0); PG8_STAGE(PG8_SA(0, 1), a2 + hstep, voffA);
            PG8_WAIT_V(8); PG8_WAIT_L(0); PG8_BAR; PG8_MMA(0, 0, At, B0); PG8_MMA(0, 1, At, B1); PG8_BAR; PG8_SCHED;
            PG8_LDA(At, 1, 1); PG8_STAGE(PG8_SB(1, 0), b3, voffB); PG8_STAGE(PG8_SB(1, 1), b3 + hstep, voffB); PG8_STAGE(PG8_SA(1, 0), a3, voffA);
            PG8_WAIT_V(8); PG8_WAIT_L(0); PG8_BAR; PG8_MMA(1, 0, At, B0); PG8_MMA(1, 1, At, B1); PG8_BAR; PG8_SCHED;
            } else {
            PG8_LDB(B0, 0, 0); PG8_SCHED; PG8_LDA(At, 0, 0); PG8_STAGE(PG8_SA(1, 1), a1 + hstep, voffA);
            PG8_WAIT_L(8); PG8_BAR; PG8_WAIT_L(0); PG8_MMA(0, 0, At, B0); PG8_BAR; PG8_SCHED;
            PG8_LDB(B1, 0, 1); PG8_STAGE(PG8_SB(0, 0), b2, voffB);
            PG8_BAR; PG8_WAIT_L(0); PG8_MMA(0, 1, At, B1); PG8_BAR;
            PG8_LDA(At, 0, 1); PG8_STAGE(PG8_SA(0, 0), a2, voffA);
            PG8_BAR; PG8_WAIT_L(0); PG8_MMA(1, 0, At, B0); PG8_BAR; PG8_SCHED;
            PG8_STAGE(PG8_SB(0, 1), b2 + hstep, voffB);
            PG8_WAIT_V(6); PG8_BAR; PG8_MMA(1, 1, At, B1); PG8_BAR;
            PG8_LDB(B0, 1, 0); PG8_SCHED; PG8_LDA(At, 1, 0); PG8_STAGE(PG8_SA(0, 1), a2 + hstep, voffA);
            PG8_WAIT_L(8); PG8_BAR; PG8_WAIT_L(0); PG8_MMA(0, 0, At, B0); PG8_BAR; PG8_SCHED;
            PG8_LDB(B1, 1, 1); PG8_STAGE(PG8_SB(1, 0), b3, voffB);
            PG8_BAR; PG8_WAIT_L(0); PG8_MMA(0, 1, At, B1); PG8_BAR;
            PG8_LDA(At, 1, 1); PG8_STAGE(PG8_SA(1, 0), a3, voffA);
            PG8_BAR; PG8_WAIT_L(0); PG8_MMA(1, 0, At, B0); PG8_BAR; PG8_SCHED;
            PG8_STAGE(PG8_SB(1, 1), b3 + hstep, voffB);
            PG8_WAIT_V(6); PG8_BAR; PG8_MMA(1, 1, At, B1); PG8_BAR;
            }
        }
        if constexpr (ALIGN_EPI) { if (wr == 0) PG8_BAR; }
        if constexpr (!Epi::AFTER_DRAIN) { E(acc, cur, wr, wc, fr, fq); S.done(cur); }
        if (!has_next) break;
#pragma unroll
        for (int a = 0; a < 2; ++a)
#pragma unroll
            for (int b = 0; b < 2; ++b)
#pragma unroll
                for (int m = 0; m < 4; ++m)
#pragma unroll
                    for (int n = 0; n < 2; ++n) acc[a][b][m][n] = (f32x4){0.f, 0.f, 0.f, 0.f};
        cur = nxt; cA = nA; cB = nB; ++ui;
        if constexpr (ALIGN_EPI) { if (wr == 1) PG8_BAR; }
    }
    PG8_WAIT_V(0);
    if constexpr (!ALIGN_EPI) { if (wr == 0) PG8_BAR; }
    PG8_BAR;
    if constexpr (Epi::AFTER_DRAIN) { E.fused(acc, cur, wr, wc, fr, fq, lds, wid, lane); S.done(cur); }
#undef PG8_SA
#undef PG8_SB
#undef PG8_STAGE
#undef PG8_LDA
#undef PG8_LDB
#undef PG8_MMA
#undef PG8_WAIT_V
#undef PG8_WAIT_L
#undef PG8_BAR
#undef PG8_SCHED
}
}

namespace pg8 {
struct EpiBf16P {
    static constexpr bool PERM = true, AFTER_DRAIN = false;
    bf16_t* O; int ldc;
    __device__ __forceinline__ void operator()(const f32x4 (&acc)[2][2][4][2], const Unit& u, int wr, int wc, int fr, int fq) const {
        const int row0 = u.pm * BM + wr * 64 + fr, col0 = u.pn * BM + wc * 32 + 8 * fq;
#pragma unroll
        for (int ai = 0; ai < 2; ++ai)
#pragma unroll
            for (int m = 0; m < 4; ++m) { bf16_t* rowp = O + (size_t)(row0 + ai * HALF + m * 16) * ldc + col0;
#pragma unroll
                for (int bj = 0; bj < 2; ++bj) { const f32x4 v0 = acc[ai][bj][m][0], v1 = acc[ai][bj][m][1];
                    u32x4 w; w.x = cvt_pk_bf16(v0[0], v0[1]); w.y = cvt_pk_bf16(v0[2], v0[3]); w.z = cvt_pk_bf16(v1[0], v1[1]); w.w = cvt_pk_bf16(v1[2], v1[3]);
                    *(u32x4*)(rowp + bj * HALF) = w; } }
    }
};
struct EpiH {
    static constexpr bool PERM = true, AFTER_DRAIN = false;
    bf16_t* O; float* ffn_p; float* ffn_s;
    __device__ __forceinline__ void operator()(const f32x4 (&acc)[2][2][4][2], const Unit& u, int wr, int wc, int fr, int fq) const {
        const int row0 = u.pm * BM + wr * 64 + fr, col0 = u.pn * BM + wc * 32 + 8 * fq;
#pragma unroll
        for (int ai = 0; ai < 2; ++ai)
#pragma unroll
            for (int m = 0; m < 4; ++m) { const int row = row0 + ai * HALF + m * 16; bf16_t* rowp = O + (size_t)row * 11264 + col0;
                float* tail = nullptr;
                if (row < 8192) { const int t = row & 2047; if (t >= 2046) tail = ffn_p + (size_t)((row >> 11) * 2 + (t - 2046)) * 11264 + col0; }
                else { const int r = row - 8192, t = r & 7; if (t >= 6) tail = ffn_s + (size_t)((r >> 3) * 2 + (t - 6)) * 11264 + col0; }
#pragma unroll
                for (int bj = 0; bj < 2; ++bj) { const f32x4 v0 = acc[ai][bj][m][0], v1 = acc[ai][bj][m][1];
                    u32x4 w; w.x = cvt_pk_bf16(v0[0], v0[1]); w.y = cvt_pk_bf16(v0[2], v0[3]); w.z = cvt_pk_bf16(v1[0], v1[1]); w.w = cvt_pk_bf16(v1[2], v1[3]);
                    *(u32x4*)(rowp + bj * HALF) = w;
                    if (tail) { *(f32x4*)(tail + bj * HALF) = v0; *(f32x4*)(tail + bj * HALF + 4) = v1; } } }
    }
};
struct EpiRes {
    static constexpr bool PERM = false, AFTER_DRAIN = false;
    const float* base_p; const float* base_s; float* out;
    __device__ __forceinline__ void operator()(const f32x4 (&acc)[2][2][4][2], const Unit& u, int wr, int wc, int fr, int fq) const {
        const int row0 = u.pm * BM + wr * 64 + fr, col0 = u.pn * BM + wc * 32 + 4 * fq;
        const float* base = (u.pm < 32) ? base_p : (base_s - (size_t)8192 * 2048);
#pragma unroll
        for (int ai = 0; ai < 2; ++ai)
#pragma unroll
            for (int m = 0; m < 4; ++m) { const size_t off = (size_t)(row0 + ai * HALF + m * 16) * 2048 + col0;
#pragma unroll
                for (int bj = 0; bj < 2; ++bj)
#pragma unroll
                    for (int n = 0; n < 2; ++n) { const f32x4 bs = *(const f32x4*)(base + off + bj * HALF + n * 16); *(f32x4*)(out + off + bj * HALF + n * 16) = bs + acc[ai][bj][m][n]; }
                asm volatile("" ::: "memory"); }
    }
};
struct SplitOrder {
    int c, ntk;
    __device__ void init(int K, int c_) { c = c_; ntk = K / BK; }
    __device__ bool next(int i, Unit& u) const {
        if (i == 0) { const int xcd = c & 7, j = c >> 3; u.pm = xcd * 4 + (j >> 3); u.pn = j & 7; u.k0 = 0; u.nt = ntk; u.seg = 0; return true; }
        if (i == 1) { const int uu = c >> 3, seg = c & 7, P = ntk >> 1, p0 = (seg * P) >> 3, p1 = ((seg + 1) * P) >> 3; u.pm = 32 + (uu >> 3); u.pn = uu & 7; u.k0 = 2 * p0; u.nt = 2 * (p1 - p0); u.seg = seg; return true; }
        return false;
    }
    __device__ __forceinline__ void a_ready(const Unit&) const {}
    __device__ __forceinline__ void done(const Unit&) const {}
};
struct EpiResSplit {
    static constexpr bool PERM = false, AFTER_DRAIN = false;
    const float* base_p; float* out_p; float* acc_s;
    __device__ __forceinline__ void operator()(const f32x4 (&acc)[2][2][4][2], const Unit& u, int wr, int wc, int fr, int fq) const {
        const int row0 = u.pm * BM + wr * 64 + fr, col0 = u.pn * BM + wc * 32 + 4 * fq;
        if (u.pm < 32) {
#pragma unroll
            for (int ai = 0; ai < 2; ++ai)
#pragma unroll
                for (int m = 0; m < 4; ++m) { const size_t off = (size_t)(row0 + ai * HALF + m * 16) * 2048 + col0;
#pragma unroll
                    for (int bj = 0; bj < 2; ++bj)
#pragma unroll
                        for (int n = 0; n < 2; ++n) { const f32x4 bs = *(const f32x4*)(base_p + off + bj * HALF + n * 16); *(f32x4*)(out_p + off + bj * HALF + n * 16) = bs + acc[ai][bj][m][n]; }
                    asm volatile("" ::: "memory"); }
        } else {
#pragma unroll
            for (int ai = 0; ai < 2; ++ai)
#pragma unroll
                for (int m = 0; m < 4; ++m) { bf16_t* p = (bf16_t*)acc_s + ((size_t)u.seg * 1024 + (size_t)(row0 - 8192 + ai * HALF + m * 16)) * 2048 + col0;
#pragma unroll
                    for (int bj = 0; bj < 2; ++bj)
#pragma unroll
                        for (int n = 0; n < 2; ++n) { const f32x4 v = acc[ai][bj][m][n]; typedef unsigned u32x2_ __attribute__((ext_vector_type(2))); u32x2_ w; w.x = cvt_pk_bf16(v[0], v[1]); w.y = cvt_pk_bf16(v[2], v[3]);
                            *(u32x2_*)(p + bj * HALF + n * 16) = w; } }
        }
    }
};
}

#define LAS __attribute__((address_space(3)))
typedef unsigned short bf16_t;
typedef float f32x4v __attribute__((ext_vector_type(4)));
typedef float f32x2v __attribute__((ext_vector_type(2)));
constexpr int MTOK = 9216, MPR = 8192, DM = 2048, NIN = 7440, NINP = 7680, DFF = 5632, DFF2 = 11264, RPROJ = 3328, OFFR = 4112;
constexpr int TT = 12, NTILES = MTOK / TT;
constexpr int LDS_BYTES = 131072;
constexpr size_t O_Y = 0, O_GDN_P = 18874368, O_GCONV_P = 19398656, O_RWKV_P = 19435520, O_SHIFT_P = 19697664, O_FFN_P = 19710976,
                 O_GDN_S = 19801088, O_GCONV_S = 36578304, O_RWKV_S = 37757952, O_SHIFT_S = 46146560, O_FFN_S = 46572544, O_END = 49456128;
constexpr size_t W_WTUP = 0, W_WTO = 46137344, W_PROJ = 54525952, W_GQKV = 196083712, W_GAB = 252706816, W_RS = 253296640, W_RV = 328794112, W_RW = 347668480, W_END1 = 385417216;
constexpr size_t W_PART = W_PROJ;
constexpr size_t W_MIXED = W_GQKV, W_H = W_WTO, W_WTDN = W_END1, W_ACT = W_H + (size_t)MTOK * DFF2 * 2 + (size_t)DM * DFF * 2, W_XN2 = W_ACT, W_END2 = W_ACT + (size_t)MTOK * DFF * 2, W_END3 = W_WTDN + (size_t)DM * DFF * 2;
static_assert(W_END2 <= W_END1 + 0, "late-phase overlay must fit");
static_assert(W_END3 == 408485888 && W_END2 == 380633088, "layout");
constexpr size_t W_BAR = W_END3, W_END4 = W_BAR + 8192;
constexpr size_t OB_WBT = O_FFN_S * 4, OB_ABT = OB_WBT + 1024 * 64 * 2, OB_GBT = OB_ABT + 1024 * 64 * 2;

struct Args { const float* in[30]; float* out; unsigned char* ws; int ph_lo, ph_hi; };

__device__ __forceinline__ float bf_lo(unsigned w) { return __uint_as_float(w << 16); }
__device__ __forceinline__ float bf_hi(unsigned w) { return __uint_as_float(w & 0xffff0000u); }
__device__ __forceinline__ unsigned pk2(float lo, float hi) { return pg8::cvt_pk_bf16(lo, hi); }
__device__ __forceinline__ unsigned pk2_safe(float lo, float hi) { unsigned r; asm volatile("s_nop 4\n\tv_cvt_pk_bf16_f32 %0, %1, %2" : "=v"(r) : "v"(lo), "v"(hi)); return r; }
__device__ __forceinline__ void unpack8(const uint4 w, float (&f)[8]) { f[0] = bf_lo(w.x); f[1] = bf_hi(w.x); f[2] = bf_lo(w.y); f[3] = bf_hi(w.y); f[4] = bf_lo(w.z); f[5] = bf_hi(w.z); f[6] = bf_lo(w.w); f[7] = bf_hi(w.w); }
__device__ __forceinline__ float wave_sum(float v) {
#pragma unroll
    for (int o = 1; o < 64; o <<= 1) v += __shfl_xor(v, o);
    return v;
}
__device__ __forceinline__ float half_sum32(float v) {
#pragma unroll
    for (int o = 1; o < 32; o <<= 1) v += __shfl_xor(v, o);
    return v;
}
__device__ __forceinline__ float sum16(float v) {
#pragma unroll
    for (int o = 1; o < 16; o <<= 1) v += __shfl_xor(v, o);
    return v;
}
template <int CTRL> __device__ __forceinline__ float dppf(float v) { return __int_as_float(__builtin_amdgcn_update_dpp(0, __float_as_int(v), CTRL, 0xF, 0xF, true)); }
__device__ __forceinline__ float reduce8(float v) {
    v += dppf<0xB1>(v);
    v += dppf<0x4E>(v);
    v += dppf<0x141>(v);
    return v;
}
__device__ __forceinline__ float sigmoidf_(float x) { return __builtin_amdgcn_rcpf(1.0f + __expf(-x)); }
__device__ __forceinline__ float siluf_(float x) { return x * __builtin_amdgcn_rcpf(1.0f + __expf(-x)); }
__device__ __forceinline__ float softplusf_(float x) { return fmaxf(x, 0.f) + __logf(1.0f + __expf(-fabsf(x))); }
__device__ __forceinline__ float tanhf_(float x) { const float e = __expf(-2.0f * fabsf(x)); const float r = (1.0f - e) * __builtin_amdgcn_rcpf(1.0f + e); return x < 0.f ? -r : r; }
__device__ __forceinline__ void rowinfo(int row, int& grp, int& b, int& t, int& T) {
    if (row < MPR) { grp = 0; b = row >> 11; t = row & 2047; T = 2048; } else { const int r = row - MPR; grp = 1; b = r >> 3; t = r & 7; T = 8; }
}
#define LDS_WAIT() asm volatile("s_waitcnt lgkmcnt(0)" ::: "memory")

__device__ __forceinline__ void transpose_item(const float* __restrict__ W, int K, int N, bf16_t* __restrict__ WT, LAS float* scr, int item, int nblk, int lane) {
    const int kb = item / nblk, nb = item - kb * nblk, k0 = 64 * kb, n0 = 64 * nb;
    const int r4 = lane >> 4, c4 = (lane & 15) * 4, n_in = n0 + c4;
    float4 v[16];
#pragma unroll
    for (int i = 0; i < 16; ++i) v[i] = (n_in < N) ? *(const float4*)(W + (size_t)(k0 + 4 * i + r4) * N + n_in) : make_float4(0.f, 0.f, 0.f, 0.f);
#pragma unroll
    for (int i = 0; i < 16; ++i) { const int k = 4 * i + r4; *(LAS f32x4v*)(scr + k * 64 + (c4 ^ (8 * ((k >> 3) & 7)))) = (f32x4v){v[i].x, v[i].y, v[i].z, v[i].w}; }
    LDS_WAIT();
    const int c = lane & 7;
#pragma unroll
    for (int j = 0; j < 8; ++j) { const int n = (lane >> 3) + 8 * j; const LAS float* sp = scr + (8 * c) * 64 + (n ^ (8 * c));
        uint4 o; o.x = pk2(sp[0], sp[64]); o.y = pk2(sp[128], sp[192]); o.z = pk2(sp[256], sp[320]); o.w = pk2(sp[384], sp[448]);
        *(uint4*)(WT + (size_t)(n0 + n) * K + k0 + 8 * c) = o; }
    LDS_WAIT();
}
__device__ __forceinline__ void rms_row_bf16(const float* __restrict__ xrow, const float* __restrict__ g, bf16_t* __restrict__ orow, int lane) {
    float4 v[8]; float ss = 0.f;
#pragma unroll
    for (int j = 0; j < 8; ++j) { v[j] = ((const float4*)xrow)[lane + 64 * j]; ss += (v[j].x * v[j].x + v[j].y * v[j].y) + (v[j].z * v[j].z + v[j].w * v[j].w); }
    const float rs = rsqrtf(wave_sum(ss) * (1.0f / DM) + 1e-6f);
#pragma unroll
    for (int j = 0; j < 8; ++j) { const float4 gg = ((const float4*)g)[lane + 64 * j];
        uint2 o; o.x = pk2(v[j].x * rs * gg.x, v[j].y * rs * gg.y); o.y = pk2(v[j].z * rs * gg.z, v[j].w * rs * gg.w);
        ((uint2*)orow)[lane + 64 * j] = o; }
}
__device__ __forceinline__ void rms_row_f32_inplace(float* xrow, const float* __restrict__ g, int lane) {
    float4 v[8]; float ss = 0.f;
#pragma unroll
    for (int j = 0; j < 8; ++j) { v[j] = ((const float4*)xrow)[lane + 64 * j]; ss += (v[j].x * v[j].x + v[j].y * v[j].y) + (v[j].z * v[j].z + v[j].w * v[j].w); }
    const float rs = rsqrtf(wave_sum(ss) * (1.0f / DM) + 1e-6f);
#pragma unroll
    for (int j = 0; j < 8; ++j) { const float4 gg = ((const float4*)g)[lane + 64 * j];
        float4 o; o.x = v[j].x * rs * gg.x; o.y = v[j].y * rs * gg.y; o.z = v[j].z * rs * gg.z; o.w = v[j].w * rs * gg.w;
        ((float4*)xrow)[lane + 64 * j] = o; }
}

__device__ __forceinline__ void prep_tile(const Args& A, LAS float* lw, int tile, int tid) {
    const bf16_t* PROJ = (const bf16_t*)(A.ws + W_PROJ);
    bf16_t* GQKV = (bf16_t*)(A.ws + W_GQKV); float* GA = (float*)(A.ws + W_GAB); float* GB = GA + MTOK * 8;
    bf16_t* RS = (bf16_t*)(A.ws + W_RS); bf16_t* RV = (bf16_t*)(A.ws + W_RV); float* RW = (float*)(A.ws + W_RW);
    const float* st_gconv = A.in[3]; const float* st_shift = A.in[5];
    const int row_base = tile * TT;
    const int c0 = tid * 2;
    unsigned pw[TT + 1][3];
#pragma unroll
    for (int i = 0; i < TT + 1; ++i) { int r = row_base - 1 + i; r = r < 0 ? 0 : r; const bf16_t* pr = PROJ + (size_t)r * NINP + OFFR + c0;
        pw[i][0] = *(const unsigned*)pr; pw[i][1] = *(const unsigned*)(pr + 1024); pw[i][2] = *(const unsigned*)(pr + 2048); }
    uint4 xr[TT + 3];
    { const int chx = (tid < 384 ? tid : 383) * 8;
#pragma unroll
      for (int i = 0; i < TT + 3; ++i) { int r = row_base - 3 + i; r = r < 0 ? 0 : r; xr[i] = *(const uint4*)(PROJ + (size_t)r * NINP + chx); } }
    {
        if (tid < 4 * 68) ((LAS unsigned*)lw)[TT * 68 + tid] = 0u;
        const float* mu = A.in[13];
#pragma unroll
        for (int i = 0; i < 2; ++i) { const int item = tid + 512 * i; if (item < TT * 64) { const int tk = item >> 6, jp = item & 63, row = row_base + tk; int grp, b, t, T; rowinfo(row, grp, b, t, T);
            const int col = 3072 + 2 * jp; const unsigned pw_ = *(const unsigned*)(PROJ + (size_t)row * NINP + OFFR + col);
            float q0, q1; if (t > 0) { const unsigned qw = *(const unsigned*)(PROJ + (size_t)(row - 1) * NINP + OFFR + col); q0 = bf_lo(qw); q1 = bf_hi(qw); }
            else if (grp) { const float2 sq = *(const float2*)(st_shift + (size_t)b * RPROJ + col); q0 = sq.x; q1 = sq.y; } else { q0 = 0.f; q1 = 0.f; }
            const float2 m2 = *(const float2*)(mu + col); const float p0 = bf_lo(pw_), p1 = bf_hi(pw_);
            float x0 = p0 + (q0 - p0) * m2.x, x1 = p1 + (q1 - p1) * m2.y;
            if (jp < 32) { x0 = tanhf_(x0); x1 = tanhf_(x1); }
            ((LAS unsigned*)lw)[tk * 68 + jp] = pk2_safe(x0, x1); } }
    }
    if (tid < 384) {
        const int ch = tid * 8, stream = tid >> 7;
        const float* cwp = A.in[9];
        float cw[4][8];
#pragma unroll
        for (int i = 0; i < 4; ++i) { const float4 a0 = *(const float4*)(cwp + i * 3072 + ch), a1 = *(const float4*)(cwp + i * 3072 + ch + 4);
            cw[i][0] = a0.x; cw[i][1] = a0.y; cw[i][2] = a0.z; cw[i][3] = a0.w; cw[i][4] = a1.x; cw[i][5] = a1.y; cw[i][6] = a1.z; cw[i][7] = a1.w; }
#pragma unroll
        for (int tk = 0; tk < TT; ++tk) {
            const int row = row_base + tk; int grp, b, t, T; rowinfo(row, grp, b, t, T);
            float y[8], xl[8];
#pragma unroll
            for (int e = 0; e < 8; ++e) y[e] = 0.f;
#pragma unroll
            for (int i = 0; i < 4; ++i) { const int tt = t - 3 + i; float x[8];
                if (tt >= 0) { unpack8(xr[tk + i], x); }
                else if (grp) { const float* sp = st_gconv + ((size_t)b * 3 + (t + i)) * 3072 + ch; const float4 a0 = *(const float4*)sp, a1 = *(const float4*)(sp + 4);
                    x[0] = a0.x; x[1] = a0.y; x[2] = a0.z; x[3] = a0.w; x[4] = a1.x; x[5] = a1.y; x[6] = a1.z; x[7] = a1.w; }
                else {
#pragma unroll
                    for (int e = 0; e < 8; ++e) x[e] = 0.f; }
#pragma unroll
                for (int e = 0; e < 8; ++e) { y[e] += cw[i][e] * x[e]; if (i == 3) xl[e] = x[e]; } }
            float ss = 0.f;
#pragma unroll
            for (int e = 0; e < 8; ++e) { y[e] = siluf_(y[e]); ss += y[e] * y[e]; }
            if (stream < 2) { ss = sum16(ss); const float sc = rsqrtf(ss + 1e-12f) * (stream == 0 ? 0.08838834764831845f : 1.0f);
#pragma unroll
                for (int e = 0; e < 8; ++e) y[e] *= sc; }
            uint4 o; o.x = pk2(y[0], y[1]); o.y = pk2(y[2], y[3]); o.z = pk2(y[4], y[5]); o.w = pk2(y[6], y[7]);
            *(uint4*)(GQKV + (size_t)row * 3072 + ch) = o;
            if (t >= T - 3) { float* gp = A.out + (grp ? O_GCONV_S : O_GCONV_P) + ((size_t)b * 3 + (t - (T - 3))) * 3072 + ch;
                *(float4*)gp = make_float4(xl[0], xl[1], xl[2], xl[3]); *(float4*)(gp + 4) = make_float4(xl[4], xl[5], xl[6], xl[7]); }
        }
    } else if (tid < 384 + TT * 8) {
        const int idx = tid - 384, tk = idx >> 3, h = idx & 7, row = row_base + tk;
        const float pb = bf_lo((unsigned)PROJ[(size_t)row * NINP + 4096 + h]), pa = bf_lo((unsigned)PROJ[(size_t)row * NINP + 4104 + h]);
        const float g = -__expf(A.in[10][h]) * softplusf_(pa + A.in[11][h]);
        GA[(size_t)row * 8 + h] = __expf(g); GB[(size_t)row * 8 + h] = sigmoidf_(pb);
    }
    __syncthreads();
    {
        const int wv_ = __builtin_amdgcn_readfirstlane(tid >> 6), ti = tid & 15, quad = (tid & 63) >> 4;
        LAS float* AWL = lw + 2048; LAS float* AAL = lw + 2048 + 13364;
        const LAS unsigned char* lb = (const LAS unsigned char*)lw + ti * 272 + quad * 16;
        pg8::bf16x8 bop[4];
#pragma unroll
        for (int ks = 0; ks < 4; ++ks) bop[ks] = *(const LAS pg8::bf16x8*)(lb + ks * 64);
#pragma unroll
        for (int which = 0; which < 2; ++which) {
            const bf16_t* WT = (const bf16_t*)((const unsigned char*)A.out + (which == 0 ? OB_WBT : OB_ABT)) + (size_t)(wv_ * 128 + ti) * 64 + quad * 8;
            const float* bias = A.in[which == 0 ? 14 : 16] + wv_ * 128 + quad * 4;
            LAS float* dst = (which == 0 ? AWL : AAL) + (ti < TT ? ti : TT) * 1028 + wv_ * 128 + quad * 4;
            pg8::bf16x8 aop[8][2];
#pragma unroll
            for (int t = 0; t < 8; ++t) { aop[t][0] = *(const pg8::bf16x8*)(WT + (size_t)t * 16 * 64); aop[t][1] = *(const pg8::bf16x8*)(WT + (size_t)t * 16 * 64 + 32); }
#pragma unroll
            for (int t = 0; t < 8; ++t) {
                pg8::f32x4 c = *(const pg8::f32x4*)(bias + t * 16);
                c = __builtin_amdgcn_mfma_f32_16x16x32_bf16(aop[t][0], bop[which * 2], c, 0, 0, 0);
                c = __builtin_amdgcn_mfma_f32_16x16x32_bf16(aop[t][1], bop[which * 2 + 1], c, 0, 0, 0);
                *(LAS f32x4v*)(dst + t * 16) = (f32x4v){c[0], c[1], c[2], c[3]};
            }
        }
    }
    __syncthreads();
    f32x2v aw[TT], aa[TT];
#pragma unroll
    for (int tk = 0; tk < TT; ++tk) { aw[tk] = *(const LAS f32x2v*)(lw + 2048 + tk * 1028 + c0); aa[tk] = *(const LAS f32x2v*)(lw + 2048 + 13364 + tk * 1028 + c0); }
    {
        const float* mu = A.in[13];
        const float2 mur = *(const float2*)(mu + c0), muk = *(const float2*)(mu + 1024 + c0), muv = *(const float2*)(mu + 2048 + c0);
        const float2 kkw = *(const float2*)(A.in[19] + c0), kaw = *(const float2*)(A.in[20] + c0);
#pragma unroll
        for (int tk = 0; tk < TT; ++tk) {
            const int row = row_base + tk; int grp, b, t, T; rowinfo(row, grp, b, t, T);
            const unsigned wr_ = pw[tk + 1][0], wk_ = pw[tk + 1][1], wv_ = pw[tk + 1][2];
            float r0 = bf_lo(wr_), r1 = bf_hi(wr_), k0 = bf_lo(wk_), k1 = bf_hi(wk_), v0 = bf_lo(wv_), v1 = bf_hi(wv_);
            float pr0, pr1, pk0, pk1, pv0, pv1;
            if (t > 0) { const unsigned a_ = pw[tk][0], b_ = pw[tk][1], c_ = pw[tk][2];
                pr0 = bf_lo(a_); pr1 = bf_hi(a_); pk0 = bf_lo(b_); pk1 = bf_hi(b_); pv0 = bf_lo(c_); pv1 = bf_hi(c_); }
            else if (grp) { const float* sp = st_shift + (size_t)b * RPROJ + c0; const float2 a_ = *(const float2*)sp, b_ = *(const float2*)(sp + 1024), c_ = *(const float2*)(sp + 2048);
                pr0 = a_.x; pr1 = a_.y; pk0 = b_.x; pk1 = b_.y; pv0 = c_.x; pv1 = c_.y; }
            else { pr0 = pr1 = pk0 = pk1 = pv0 = pv1 = 0.f; }
            r0 += (pr0 - r0) * mur.x; r1 += (pr1 - r1) * mur.y; k0 += (pk0 - k0) * muk.x; k1 += (pk1 - k1) * muk.y; v0 += (pv0 - v0) * muv.x; v1 += (pv1 - v1) * muv.y;
            const float w0_ = -softplusf_(-aw[tk].x) - 0.5f, w1_ = -softplusf_(-aw[tk].y) - 0.5f;
            const float d0 = __expf(-__expf(w0_)), d1 = __expf(-__expf(w1_));
            const float a0_ = sigmoidf_(aa[tk].x), a1_ = sigmoidf_(aa[tk].y);
            float q0 = k0 * kkw.x, q1 = k1 * kkw.y;
            const float inv = rsqrtf(half_sum32(q0 * q0 + q1 * q1) + 1e-12f);
            q0 *= inv; q1 *= inv;
            const float kp0 = k0 * (1.0f + (a0_ - 1.0f) * kaw.x), kp1 = k1 * (1.0f + (a1_ - 1.0f) * kaw.y);
            bf16_t* rs = RS + (size_t)row * 4096 + c0;
            *(unsigned*)rs = pk2(q0, q1); *(unsigned*)(rs + 1024) = pk2(q0 * a0_, q1 * a1_); *(unsigned*)(rs + 2048) = pk2(kp0, kp1); *(unsigned*)(rs + 3072) = pk2(r0, r1);
            *(unsigned*)(RV + (size_t)row * 1024 + c0) = pk2(v0, v1);
            *(float2*)(RW + (size_t)row * 1024 + c0) = make_float2(d0, d1);
        }
    }
    for (int tk = 0; tk < TT; ++tk) { const int row = row_base + tk; int grp, b, t, T; rowinfo(row, grp, b, t, T);
        if (t == T - 1) { float* sp = A.out + (grp ? O_SHIFT_S : O_SHIFT_P) + (size_t)b * RPROJ;
            for (int j = tid; j < RPROJ; j += 512) sp[j] = bf_lo((unsigned)PROJ[(size_t)row * NINP + OFFR + j]); } }
    __syncthreads();
}

constexpr int SCAN_LDS_PER_WAVE = 10752;
__device__ __forceinline__ void rwkv_sample_loop(LAS float* sl, const bf16_t* __restrict__ RS, const bf16_t* __restrict__ RV, const float* __restrict__ RW, float* __restrict__ yraw,
                                                 const float* __restrict__ st_in, float* __restrict__ st_out, int task0, int stride, int lane) {
    if (task0 >= 16384) return;
    const int part = lane & 7, rr = lane >> 3;
    LAS float* SB = sl; LAS float* WB = sl + 2048; LAS float* VB = sl + 2560;
    float4 nS0, nS1; uint4 nst[4]; float4 nsw[2]; uint4 nsv = make_uint4(0, 0, 0, 0);
#define RWS_LOAD(task_) do { const int bh_ = (task_) >> 3, v0_ = ((task_) & 7) * 8, h_ = bh_ & 15, row0_ = MPR + (bh_ >> 4) * 8; \
        const float* sp_ = st_in + (size_t)bh_ * 4096 + (size_t)(v0_ + rr) * 64 + part * 8; nS0 = *(const float4*)sp_; nS1 = *(const float4*)(sp_ + 4); \
        _Pragma("unroll") for (int i = 0; i < 4; ++i) { const int id = i * 64 + lane, step = id >> 5, s = (id >> 3) & 3, pc = id & 7; \
            nst[i] = *(const uint4*)(RS + (size_t)(row0_ + step) * 4096 + s * 1024 + h_ * 64 + pc * 8); } \
        _Pragma("unroll") for (int i = 0; i < 2; ++i) { const int id = i * 64 + lane, step = id >> 4, pc = id & 15; \
            nsw[i] = *(const float4*)(RW + (size_t)(row0_ + step) * 1024 + h_ * 64 + pc * 4); } \
        if (lane < 8) nsv = *(const uint4*)(RV + (size_t)(row0_ + lane) * 1024 + h_ * 64 + v0_); } while (0)
    RWS_LOAD(task0);
    for (int task = task0; task < 16384; task += stride) {
        const int bh = task >> 3, v0 = (task & 7) * 8, h = bh & 15, row0 = MPR + (bh >> 4) * 8;
        f32x2v S[4] = {(f32x2v){nS0.x, nS0.y}, (f32x2v){nS0.z, nS0.w}, (f32x2v){nS1.x, nS1.y}, (f32x2v){nS1.z, nS1.w}};
#pragma unroll
        for (int i = 0; i < 4; ++i) { const int id = i * 64 + lane, step = id >> 5, s = (id >> 3) & 3, pc = id & 7; float f[8]; unpack8(nst[i], f);
            LAS float* d = SB + (step * 4 + s) * 64 + pc * 8; *(LAS f32x4v*)d = (f32x4v){f[0], f[1], f[2], f[3]}; *(LAS f32x4v*)(d + 4) = (f32x4v){f[4], f[5], f[6], f[7]}; }
#pragma unroll
        for (int i = 0; i < 2; ++i) { const int id = i * 64 + lane, step = id >> 4, pc = id & 15; *(LAS f32x4v*)(WB + step * 64 + pc * 4) = (f32x4v){nsw[i].x, nsw[i].y, nsw[i].z, nsw[i].w}; }
        if (lane < 8) { float f[8]; unpack8(nsv, f); LAS float* d = VB + lane * 8; *(LAS f32x4v*)d = (f32x4v){f[0], f[1], f[2], f[3]}; *(LAS f32x4v*)(d + 4) = (f32x4v){f[4], f[5], f[6], f[7]}; }
        asm volatile("s_waitcnt lgkmcnt(0)" ::: "memory");
        __builtin_amdgcn_sched_barrier(0);
        if (task + stride < 16384) RWS_LOAD(task + stride);
        __builtin_amdgcn_sched_barrier(0);
        float ys[8];
        f32x4v kk0, kk1, ka0, ka1, kp0, kp1, r0, r1, w0, w1; float vv;
        f32x4v nkk0, nkk1, nka0, nka1, nkp0, nkp1, nr0, nr1, nw0, nw1; float nvv;
#define RW_OPS(s_) do { const LAS float* sb = SB + (s_) * 256 + part * 8; \
            nkk0 = *(const LAS f32x4v*)(sb); nkk1 = *(const LAS f32x4v*)(sb + 4); nka0 = *(const LAS f32x4v*)(sb + 64); nka1 = *(const LAS f32x4v*)(sb + 68); \
            nkp0 = *(const LAS f32x4v*)(sb + 128); nkp1 = *(const LAS f32x4v*)(sb + 132); nr0 = *(const LAS f32x4v*)(sb + 192); nr1 = *(const LAS f32x4v*)(sb + 196); \
            nw0 = *(const LAS f32x4v*)(WB + (s_) * 64 + part * 8); nw1 = *(const LAS f32x4v*)(WB + (s_) * 64 + part * 8 + 4); nvv = VB[(s_) * 8 + rr]; } while (0)
        RW_OPS(0);
#pragma unroll
        for (int s = 0; s < 8; ++s) {
            kk0 = nkk0; kk1 = nkk1; ka0 = nka0; ka1 = nka1; kp0 = nkp0; kp1 = nkp1; r0 = nr0; r1 = nr1; w0 = nw0; w1 = nw1; vv = nvv;
            if (s < 7) RW_OPS(s + 1);
            __builtin_amdgcn_sched_barrier(0);
            f32x2v acc = S[0] * kk0.lo, acc1 = S[1] * kk0.hi; acc = S[2] * kk1.lo + acc; acc1 = S[3] * kk1.hi + acc1; acc += acc1;
            const float sk = reduce8(acc.x + acc.y);
            const f32x2v nsk = (f32x2v){-sk, -sk}, vv2 = (f32x2v){vv, vv};
            S[0] = S[0] * w0.lo + (ka0.lo * nsk + kp0.lo * vv2);
            S[1] = S[1] * w0.hi + (ka0.hi * nsk + kp0.hi * vv2);
            S[2] = S[2] * w1.lo + (ka1.lo * nsk + kp1.lo * vv2);
            S[3] = S[3] * w1.hi + (ka1.hi * nsk + kp1.hi * vv2);
            f32x2v ya = S[0] * r0.lo, ya1 = S[1] * r0.hi; ya = S[2] * r1.lo + ya; ya1 = S[3] * r1.hi + ya1; ya += ya1;
            ys[s] = reduce8(ya.x + ya.y);
            __builtin_amdgcn_sched_barrier(0);
        }
#undef RW_OPS
        { float ysel = ys[0];
#pragma unroll
          for (int i = 1; i < 8; ++i) ysel = (part == i) ? ys[i] : ysel;
          yraw[(size_t)(row0 + part) * 2048 + 1024 + h * 64 + v0 + rr] = ysel; }
        { float* d = st_out + (size_t)bh * 4096 + (size_t)(v0 + rr) * 64 + part * 8; *(float4*)d = make_float4(S[0].x, S[0].y, S[1].x, S[1].y); *(float4*)(d + 4) = make_float4(S[2].x, S[2].y, S[3].x, S[3].y); }
        asm volatile("" ::: "memory");
    }
#undef RWS_LOAD
}
__device__ __forceinline__ void gdn_sample_loop(LAS float* sl, const bf16_t* __restrict__ GQKV, const float* __restrict__ GA, const float* __restrict__ GB, float* __restrict__ yraw,
                                                const float* __restrict__ st_in, float* __restrict__ st_out, int task0, int stride, int lane) {
    if (task0 >= 16384) return;
    const int part = lane & 7, cc = lane >> 3;
    LAS float* KB = sl; LAS float* QB = sl + 1056; LAS float* VB = sl + 2112; LAS float* AB = sl + 2176;
    const int rdoff = part * 16 + (part >> 2) * 4;
    float nS[16]; uint4 nst[4]; uint4 nsv = make_uint4(0, 0, 0, 0); float nsa = 0.f, nsb = 0.f;
#define GDS_LOAD(task_) do { const int bh_ = (task_) >> 4, j0_ = ((task_) & 15) * 8, h_ = bh_ & 7, row0_ = MPR + (bh_ >> 3) * 8; \
        const float* sp_ = st_in + (size_t)bh_ * 16384 + (size_t)(part * 16) * 128 + j0_ + cc; \
        _Pragma("unroll") for (int e = 0; e < 16; ++e) nS[e] = sp_[(size_t)e * 128]; \
        _Pragma("unroll") for (int i = 0; i < 4; ++i) { const int id = i * 64 + lane, s = id >> 7, step = (id >> 4) & 7, pc = id & 15; \
            nst[i] = *(const uint4*)(GQKV + (size_t)(row0_ + step) * 3072 + (s == 0 ? 1024 : 0) + h_ * 128 + pc * 8); } \
        if (lane < 8) { nsv = *(const uint4*)(GQKV + (size_t)(row0_ + lane) * 3072 + 2048 + h_ * 128 + j0_); \
            nsa = GA[(size_t)(row0_ + lane) * 8 + h_]; nsb = GB[(size_t)(row0_ + lane) * 8 + h_]; } } while (0)
    GDS_LOAD(task0);
    for (int task = task0; task < 16384; task += stride) {
        const int bh = task >> 4, j0 = (task & 15) * 8, h = bh & 7, row0 = MPR + (bh >> 3) * 8;
        f32x2v S[8];
#pragma unroll
        for (int e = 0; e < 8; ++e) S[e] = (f32x2v){nS[2 * e], nS[2 * e + 1]};
#pragma unroll
        for (int i = 0; i < 4; ++i) { const int id = i * 64 + lane, s = id >> 7, step = (id >> 4) & 7, pc = id & 15, pp = pc >> 1; float f[8]; unpack8(nst[i], f);
            LAS float* d = (s == 0 ? KB : QB) + step * 132 + pp * 16 + (pp >> 2) * 4 + (pc & 1) * 8; *(LAS f32x4v*)d = (f32x4v){f[0], f[1], f[2], f[3]}; *(LAS f32x4v*)(d + 4) = (f32x4v){f[4], f[5], f[6], f[7]}; }
        if (lane < 8) { float f[8]; unpack8(nsv, f); LAS float* d = VB + lane * 8; *(LAS f32x4v*)d = (f32x4v){f[0], f[1], f[2], f[3]}; *(LAS f32x4v*)(d + 4) = (f32x4v){f[4], f[5], f[6], f[7]};
            AB[lane * 2] = nsa; AB[lane * 2 + 1] = nsb; }
        asm volatile("s_waitcnt lgkmcnt(0)" ::: "memory");
        __builtin_amdgcn_sched_barrier(0);
        if (task + stride < 16384) GDS_LOAD(task + stride);
        __builtin_amdgcn_sched_barrier(0);
        float os[8];
        f32x4v k[4], q[4], nk[4], nq[4]; float v, a, beta, nv, na, nbeta;
#define GD_OPS(s_) do { const LAS float* kb = KB + (s_) * 132 + rdoff; const LAS float* qb = QB + (s_) * 132 + rdoff; \
            _Pragma("unroll") for (int i = 0; i < 4; ++i) { nk[i] = *(const LAS f32x4v*)(kb + 4 * i); nq[i] = *(const LAS f32x4v*)(qb + 4 * i); } \
            nv = VB[(s_) * 8 + cc]; na = AB[(s_) * 2]; nbeta = AB[(s_) * 2 + 1]; } while (0)
        GD_OPS(0);
#pragma unroll
        for (int s = 0; s < 8; ++s) {
#pragma unroll
            for (int i = 0; i < 4; ++i) { k[i] = nk[i]; q[i] = nq[i]; }
            v = nv; a = na; beta = nbeta;
            if (s < 7) GD_OPS(s + 1);
            __builtin_amdgcn_sched_barrier(0);
            f32x2v acc = S[0] * k[0].lo, acc1 = S[1] * k[0].hi;
#pragma unroll
            for (int i = 1; i < 4; ++i) { acc = S[2 * i] * k[i].lo + acc; acc1 = S[2 * i + 1] * k[i].hi + acc1; }
            acc += acc1;
            const float kS = reduce8(acc.x + acc.y);
            const float cf = beta * (v - a * kS);
            const f32x2v cf2 = (f32x2v){cf, cf}, a2 = (f32x2v){a, a};
#pragma unroll
            for (int i = 0; i < 4; ++i) { S[2 * i] = S[2 * i] * a2 + k[i].lo * cf2; S[2 * i + 1] = S[2 * i + 1] * a2 + k[i].hi * cf2; }
            f32x2v oa = S[0] * q[0].lo, oa1 = S[1] * q[0].hi;
#pragma unroll
            for (int i = 1; i < 4; ++i) { oa = S[2 * i] * q[i].lo + oa; oa1 = S[2 * i + 1] * q[i].hi + oa1; }
            oa += oa1;
            os[s] = reduce8(oa.x + oa.y);
            __builtin_amdgcn_sched_barrier(0);
        }
#undef GD_OPS
        { float osel = os[0];
#pragma unroll
          for (int i = 1; i < 8; ++i) osel = (part == i) ? os[i] : osel;
          yraw[(size_t)(row0 + part) * 2048 + h * 128 + j0 + cc] = osel; }
        { float* d = st_out + (size_t)bh * 16384 + (size_t)(part * 16) * 128 + j0 + cc;
#pragma unroll
          for (int e = 0; e < 8; ++e) { d[(size_t)(2 * e) * 128] = S[e].x; d[(size_t)(2 * e + 1) * 128] = S[e].y; } }
        asm volatile("" ::: "memory");
    }
#undef GDS_LOAD
}

__device__ __forceinline__ void gdn_sample_cols(LAS float* sl, const bf16_t* __restrict__ GQKV, const float* __restrict__ GA, const float* __restrict__ GB, float* __restrict__ yraw,
                                                const float* __restrict__ st_in, float* __restrict__ st_out, int task, int lane) {
    const int bh = task >> 1, j = (task & 1) * 64 + lane, h = bh & 7, row0 = MPR + (bh >> 3) * 8;
    LAS float* KB = sl; LAS float* QB = sl + 1024; LAS float* VB = sl + 2048; LAS float* AB = sl + 2560;
    f32x2v S[64];
    { const float* sp = st_in + (size_t)bh * 16384 + j;
#pragma unroll
      for (int i = 0; i < 64; ++i) { S[i] = (f32x2v){sp[0], sp[128]}; sp += 256; asm volatile("" : "+v"(sp)); } }
    {
        uint4 st[4];
#pragma unroll
        for (int i = 0; i < 4; ++i) { const int id = i * 64 + lane, s = id >> 7, step = (id >> 4) & 7, pc = id & 15;
            st[i] = *(const uint4*)(GQKV + (size_t)(row0 + step) * 3072 + (s == 0 ? 1024 : 0) + h * 128 + pc * 8); }
        unsigned short vv[8];
#pragma unroll
        for (int s = 0; s < 8; ++s) vv[s] = GQKV[(size_t)(row0 + s) * 3072 + 2048 + h * 128 + j];
        float sa = 0.f, sbt = 0.f;
        if (lane < 8) { sa = GA[(size_t)(row0 + lane) * 8 + h]; sbt = GB[(size_t)(row0 + lane) * 8 + h]; }
#pragma unroll
        for (int i = 0; i < 4; ++i) { const int id = i * 64 + lane, s = id >> 7, step = (id >> 4) & 7, pc = id & 15; float f[8]; unpack8(st[i], f);
            LAS float* d = (s == 0 ? KB : QB) + step * 128 + pc * 8; *(LAS f32x4v*)d = (f32x4v){f[0], f[1], f[2], f[3]}; *(LAS f32x4v*)(d + 4) = (f32x4v){f[4], f[5], f[6], f[7]}; }
#pragma unroll
        for (int s = 0; s < 8; ++s) VB[s * 64 + lane] = bf_lo((unsigned)vv[s]);
        if (lane < 8) { AB[lane * 2] = sa; AB[lane * 2 + 1] = sbt; }
        asm volatile("s_waitcnt lgkmcnt(0)" ::: "memory");
    }
#pragma unroll 1
    for (int s = 0; s < 8; ++s) {
        const LAS float* kb = KB + s * 128; const LAS float* qb = QB + s * 128;
        const float v = VB[s * 64 + lane], a = AB[s * 2], beta = AB[s * 2 + 1];
        f32x2v acc0 = (f32x2v){0.f, 0.f}, acc1 = (f32x2v){0.f, 0.f};
#pragma unroll
        for (int i = 0; i < 32; ++i) { const f32x4v kq = *(const LAS f32x4v*)(kb + 4 * i); acc0 = S[2 * i] * kq.lo + acc0; acc1 = S[2 * i + 1] * kq.hi + acc1; if ((i & 7) == 7) __builtin_amdgcn_sched_barrier(0); }
        acc0 += acc1;
        const float kS = acc0.x + acc0.y;
        const float cf = beta * (v - a * kS);
        const f32x2v cf2 = (f32x2v){cf, cf}, a2 = (f32x2v){a, a};
        f32x2v o0 = (f32x2v){0.f, 0.f}, o1 = (f32x2v){0.f, 0.f};
#pragma unroll
        for (int i = 0; i < 32; ++i) { const f32x4v kq = *(const LAS f32x4v*)(kb + 4 * i), qq = *(const LAS f32x4v*)(qb + 4 * i);
            S[2 * i] = S[2 * i] * a2 + kq.lo * cf2; S[2 * i + 1] = S[2 * i + 1] * a2 + kq.hi * cf2;
            o0 = S[2 * i] * qq.lo + o0; o1 = S[2 * i + 1] * qq.hi + o1; if ((i & 3) == 3) __builtin_amdgcn_sched_barrier(0); }
        o0 += o1;
        yraw[(size_t)(row0 + s) * 2048 + h * 128 + j] = o0.x + o0.y;
    }
    { float* dp = st_out + (size_t)bh * 16384 + j;
#pragma unroll
      for (int i = 0; i < 64; ++i) { dp[0] = S[i].x; dp[128] = S[i].y; dp += 256; asm volatile("" : "+v"(dp)); } }
    asm volatile("s_waitcnt lgkmcnt(0)" ::: "memory");
}

__device__ __forceinline__ float reduce16(float v) { v = reduce8(v); v += dppf<0x140>(v); return v; }
__device__ __forceinline__ void gdn_prompt_block(LAS float* L, const bf16_t* __restrict__ GQKV, const float* __restrict__ GA, const float* __restrict__ GB, float* __restrict__ yraw,
                                                 int row0, int T, int h, int jblk, float* __restrict__ s_out, int tid, int wave, int lane) {
    constexpr int BUF = 4768;
    const int part = lane & 15, cc = lane >> 4, j0 = jblk + wave * 4, rdoff = part * 8 + (part >> 3) * 4;
    f32x2v S[4];
#pragma unroll
    for (int e = 0; e < 4; ++e) S[e] = (f32x2v){0.f, 0.f};
    const int ss = tid >> 8, sstep = (tid >> 4) & 15, spc = tid & 15, vstep = (tid >> 2) & 15, vp = tid & 3, astep = tid & 15;
    uint4 st, sv = make_uint4(0, 0, 0, 0); float sa = 0.f, sbt = 0.f;
    const int nch = T >> 4;
#define GB_LOAD(c) do { const int t0_ = (c) * 16; st = *(const uint4*)(GQKV + (size_t)(row0 + t0_ + sstep) * 3072 + (ss == 0 ? 1024 : 0) + h * 128 + spc * 8); \
        if (tid < 64) sv = *(const uint4*)(GQKV + (size_t)(row0 + t0_ + vstep) * 3072 + 2048 + h * 128 + jblk + vp * 8); \
        else if (tid < 80) { sa = GA[(size_t)(row0 + t0_ + astep) * 8 + h]; sbt = GB[(size_t)(row0 + t0_ + astep) * 8 + h]; } } while (0)
#define GB_WRITE(b) do { LAS float* base = L + (b) * BUF; { float f[8]; unpack8(st, f); LAS float* d = base + ss * 2112 + sstep * 132 + spc * 8 + (spc >> 3) * 4; \
            *(LAS f32x4v*)d = (f32x4v){f[0], f[1], f[2], f[3]}; *(LAS f32x4v*)(d + 4) = (f32x4v){f[4], f[5], f[6], f[7]}; } \
        if (tid < 64) { float f[8]; unpack8(sv, f); LAS float* d = base + 4224 + vstep * 32 + vp * 8; *(LAS f32x4v*)d = (f32x4v){f[0], f[1], f[2], f[3]}; *(LAS f32x4v*)(d + 4) = (f32x4v){f[4], f[5], f[6], f[7]}; } \
        else if (tid < 80) { base[4736 + astep * 2] = sa; base[4736 + astep * 2 + 1] = sbt; } } while (0)
    GB_LOAD(0); GB_WRITE(0);
    __syncthreads();
    for (int c = 0; c < nch; ++c) {
        if (c + 1 < nch) GB_LOAD(c + 1);
        __builtin_amdgcn_sched_barrier(0);
        const LAS float* base = L + (c & 1) * BUF;
        float os[16];
        f32x2v k[4], q[4], nk[4], nq[4]; float v, a, beta, nv, na, nbeta;
#define GB_OPS(s_) do { const LAS float* kb = base + (s_) * 132 + rdoff; const LAS float* qb = base + 2112 + (s_) * 132 + rdoff; \
            _Pragma("unroll") for (int i = 0; i < 2; ++i) { const f32x4v t0 = *(const LAS f32x4v*)(kb + 4 * i), t1 = *(const LAS f32x4v*)(qb + 4 * i); \
                nk[2 * i] = t0.lo; nk[2 * i + 1] = t0.hi; nq[2 * i] = t1.lo; nq[2 * i + 1] = t1.hi; } \
            nv = base[4224 + (s_) * 32 + wave * 4 + cc]; na = base[4736 + (s_) * 2]; nbeta = base[4736 + (s_) * 2 + 1]; } while (0)
        GB_OPS(0);
#pragma unroll
        for (int s = 0; s < 16; ++s) {
#pragma unroll
            for (int i = 0; i < 4; ++i) { k[i] = nk[i]; q[i] = nq[i]; }
            v = nv; a = na; beta = nbeta;
            if (s < 15) GB_OPS(s + 1);
            __builtin_amdgcn_sched_barrier(0);
            f32x2v acc = S[0] * k[0], acc1 = S[1] * k[1]; acc = S[2] * k[2] + acc; acc1 = S[3] * k[3] + acc1; acc += acc1;
            const float kS = reduce16(acc.x + acc.y);
            const float cf = beta * (v - a * kS);
            const f32x2v cf2 = (f32x2v){cf, cf}, a2 = (f32x2v){a, a};
#pragma unroll
            for (int i = 0; i < 4; ++i) S[i] = S[i] * a2 + k[i] * cf2;
            f32x2v oa = S[0] * q[0], oa1 = S[1] * q[1]; oa = S[2] * q[2] + oa; oa1 = S[3] * q[3] + oa1; oa += oa1;
            os[s] = reduce16(oa.x + oa.y);
            __builtin_amdgcn_sched_barrier(0);
        }
#undef GB_OPS
        { float osel = os[0];
#pragma unroll
          for (int i = 1; i < 16; ++i) osel = (part == i) ? os[i] : osel;
          yraw[(size_t)(row0 + c * 16 + part) * 2048 + h * 128 + j0 + cc] = osel; }
        if (c + 1 < nch) GB_WRITE((c + 1) & 1);
        __syncthreads();
    }
#undef GB_LOAD
#undef GB_WRITE
#pragma unroll
    for (int e = 0; e < 4; ++e) { s_out[(size_t)(part * 8 + 2 * e) * 128 + j0 + cc] = S[e].x; s_out[(size_t)(part * 8 + 2 * e + 1) * 128 + j0 + cc] = S[e].y; }
}
__device__ __forceinline__ void rwkv_prompt_block(LAS float* L, const bf16_t* __restrict__ RS, const bf16_t* __restrict__ RV, const float* __restrict__ RW, float* __restrict__ yraw,
                                                  int row0, int T, int h, int vblk, float* __restrict__ s_out, int tid, int wave, int lane) {
    constexpr int BUF = 5632;
    const int part = lane & 15, rr = lane >> 4, v0 = vblk + wave * 4;
    f32x2v S[2] = {(f32x2v){0.f, 0.f}, (f32x2v){0.f, 0.f}};
    const int sstep = tid >> 5, ss = (tid >> 3) & 3, spc = tid & 7, wstep = (tid >> 4) & 15, wpc = tid & 15, vstep = (tid >> 2) & 15, vp = tid & 3;
    uint4 st, sv = make_uint4(0, 0, 0, 0); float4 sw = make_float4(0.f, 0.f, 0.f, 0.f);
    const int nch = T >> 4;
#define RB_LOAD(c) do { const int t0_ = (c) * 16; st = *(const uint4*)(RS + (size_t)(row0 + t0_ + sstep) * 4096 + ss * 1024 + h * 64 + spc * 8); \
        if (tid < 256) sw = *(const float4*)(RW + (size_t)(row0 + t0_ + wstep) * 1024 + h * 64 + wpc * 4); \
        else if (tid < 320) sv = *(const uint4*)(RV + (size_t)(row0 + t0_ + vstep) * 1024 + h * 64 + vblk + vp * 8); } while (0)
#define RB_WRITE(b) do { LAS float* base = L + (b) * BUF; { float f[8]; unpack8(st, f); LAS float* d = base + (sstep * 4 + ss) * 64 + spc * 8; \
            *(LAS f32x4v*)d = (f32x4v){f[0], f[1], f[2], f[3]}; *(LAS f32x4v*)(d + 4) = (f32x4v){f[4], f[5], f[6], f[7]}; } \
        if (tid < 256) *(LAS f32x4v*)(base + 4096 + wstep * 64 + wpc * 4) = (f32x4v){sw.x, sw.y, sw.z, sw.w}; \
        else if (tid < 320) { float f[8]; unpack8(sv, f); LAS float* d = base + 5120 + vstep * 32 + vp * 8; *(LAS f32x4v*)d = (f32x4v){f[0], f[1], f[2], f[3]}; *(LAS f32x4v*)(d + 4) = (f32x4v){f[4], f[5], f[6], f[7]}; } } while (0)
    RB_LOAD(0); RB_WRITE(0);
    __syncthreads();
    for (int c = 0; c < nch; ++c) {
        if (c + 1 < nch) RB_LOAD(c + 1);
        __builtin_amdgcn_sched_barrier(0);
        const LAS float* base = L + (c & 1) * BUF;
        float ys[16];
        f32x4v kk, ka, kp, r, w, nkk, nka, nkp, nr, nw; float vv, nvv;
#define RB_OPS(s_) do { const LAS float* sb = base + (s_) * 256 + part * 4; nkk = *(const LAS f32x4v*)(sb); nka = *(const LAS f32x4v*)(sb + 64); nkp = *(const LAS f32x4v*)(sb + 128); nr = *(const LAS f32x4v*)(sb + 192); \
            nw = *(const LAS f32x4v*)(base + 4096 + (s_) * 64 + part * 4); nvv = base[5120 + (s_) * 32 + wave * 4 + rr]; } while (0)
        RB_OPS(0);
#pragma unroll
        for (int s = 0; s < 16; ++s) {
            kk = nkk; ka = nka; kp = nkp; r = nr; w = nw; vv = nvv;
            if (s < 15) RB_OPS(s + 1);
            __builtin_amdgcn_sched_barrier(0);
            f32x2v acc = S[0] * kk.lo + S[1] * kk.hi;
            const float sk = reduce16(acc.x + acc.y);
            const f32x2v nsk = (f32x2v){-sk, -sk}, vv2 = (f32x2v){vv, vv};
            S[0] = S[0] * w.lo + (ka.lo * nsk + kp.lo * vv2);
            S[1] = S[1] * w.hi + (ka.hi * nsk + kp.hi * vv2);
            f32x2v ya = S[0] * r.lo + S[1] * r.hi;
            ys[s] = reduce16(ya.x + ya.y);
            __builtin_amdgcn_sched_barrier(0);
        }
#undef RB_OPS
        { float ysel = ys[0];
#pragma unroll
          for (int i = 1; i < 16; ++i) ysel = (part == i) ? ys[i] : ysel;
          yraw[(size_t)(row0 + c * 16 + part) * 2048 + 1024 + h * 64 + v0 + rr] = ysel; }
        if (c + 1 < nch) RB_WRITE((c + 1) & 1);
        __syncthreads();
    }
#undef RB_LOAD
#undef RB_WRITE
    *(float4*)(s_out + (size_t)(v0 + rr) * 64 + part * 4) = make_float4(S[0].x, S[0].y, S[1].x, S[1].y);
}

__device__ __forceinline__ void post_tile(const Args& A, LAS float* lg, int tile, int tid) {
    const bf16_t* PROJ = (const bf16_t*)(A.ws + W_PROJ);
    const bf16_t* RS = (const bf16_t*)(A.ws + W_RS); const bf16_t* RV = (const bf16_t*)(A.ws + W_RV);
    bf16_t* MIXED = (bf16_t*)(A.ws + W_MIXED);
    const float* yraw = A.out + O_Y; const float* st_shift = A.in[5];
    const int row_base = tile * TT;
    const int c0 = tid * 2;
    float2 yv[TT], ov[TT]; unsigned rwv[TT], kwv[TT], vwv[TT], zwv[TT];
#pragma unroll
    for (int tk = 0; tk < TT; ++tk) { const int row = row_base + tk;
        yv[tk] = *(const float2*)(yraw + (size_t)row * 2048 + 1024 + c0); ov[tk] = *(const float2*)(yraw + (size_t)row * 2048 + c0);
        rwv[tk] = *(const unsigned*)(RS + (size_t)row * 4096 + 3072 + c0); kwv[tk] = *(const unsigned*)(RS + (size_t)row * 4096 + 2048 + c0); vwv[tk] = *(const unsigned*)(RV + (size_t)row * 1024 + c0);
        zwv[tk] = *(const unsigned*)(PROJ + (size_t)row * NINP + 3072 + c0); }
    {
        if (tid < 4 * 68) ((LAS unsigned*)lg)[TT * 68 + tid] = 0u;
        const float* mu = A.in[13];
#pragma unroll
        for (int i = 0; i < 2; ++i) { const int item = tid + 512 * i; if (item < TT * 64) { const int tk = item >> 6, jp = item & 63, row = row_base + tk; int grp, b, t, T; rowinfo(row, grp, b, t, T);
            const int col = 3200 + 2 * jp; const unsigned pw_ = *(const unsigned*)(PROJ + (size_t)row * NINP + OFFR + col);
            float q0, q1; if (t > 0) { const unsigned qw = *(const unsigned*)(PROJ + (size_t)(row - 1) * NINP + OFFR + col); q0 = bf_lo(qw); q1 = bf_hi(qw); }
            else if (grp) { const float2 sq = *(const float2*)(st_shift + (size_t)b * RPROJ + col); q0 = sq.x; q1 = sq.y; } else { q0 = 0.f; q1 = 0.f; }
            const float2 m2 = *(const float2*)(mu + col); const float p0 = bf_lo(pw_), p1 = bf_hi(pw_);
            ((LAS unsigned*)lg)[tk * 68 + jp] = pk2_safe(sigmoidf_(p0 + (q0 - p0) * m2.x), sigmoidf_(p1 + (q1 - p1) * m2.y)); } }
    }
    __syncthreads();
    {
        const int wv_ = __builtin_amdgcn_readfirstlane(tid >> 6), ti = tid & 15, quad = (tid & 63) >> 4;
        const LAS unsigned char* lb = (const LAS unsigned char*)lg + ti * 272 + quad * 16;
        pg8::bf16x8 bop[4];
#pragma unroll
        for (int ks = 0; ks < 4; ++ks) bop[ks] = *(const LAS pg8::bf16x8*)(lb + ks * 64);
        const bf16_t* WT = (const bf16_t*)((const unsigned char*)A.out + OB_GBT) + (size_t)(wv_ * 128 + ti) * 128 + quad * 8;
        LAS float* dst = lg + 2048 + (ti < TT ? ti : TT) * 1028 + wv_ * 128 + quad * 4;
#pragma unroll
        for (int hh = 0; hh < 2; ++hh) {
            pg8::bf16x8 aop[4][4];
#pragma unroll
            for (int t = 0; t < 4; ++t)
#pragma unroll
                for (int ks = 0; ks < 4; ++ks) aop[t][ks] = *(const pg8::bf16x8*)(WT + (size_t)(hh * 4 + t) * 16 * 128 + ks * 32);
#pragma unroll
            for (int t = 0; t < 4; ++t) {
                pg8::f32x4 c = (pg8::f32x4){0.f, 0.f, 0.f, 0.f};
#pragma unroll
                for (int ks = 0; ks < 4; ++ks) c = __builtin_amdgcn_mfma_f32_16x16x32_bf16(aop[t][ks], bop[ks], c, 0, 0, 0);
                *(LAS f32x4v*)(dst + (hh * 4 + t) * 16) = (f32x4v){c[0], c[1], c[2], c[3]};
            }
        }
    }
    __syncthreads();
    f32x2v gate[TT];
#pragma unroll
    for (int tk = 0; tk < TT; ++tk) gate[tk] = *(const LAS f32x2v*)(lg + 2048 + tk * 1028 + c0);
    const float2 gnw = *(const float2*)(A.in[22] + c0), gnb = *(const float2*)(A.in[23] + c0), rk = *(const float2*)(A.in[21] + c0);
    const float2 ng = *(const float2*)(A.in[12] + (c0 & 127));
#pragma unroll
    for (int tk = 0; tk < TT; ++tk) {
        const int row = row_base + tk;
        {
            const float2 y = yv[tk];
            const float mean = half_sum32(y.x + y.y) * (1.0f / 64.0f);
            const float d0 = y.x - mean, d1 = y.y - mean;
            const float var = half_sum32(d0 * d0 + d1 * d1) * (1.0f / 64.0f);
            const float rs = rsqrtf(var + 64e-5f);
            const unsigned rw = rwv[tk], kw = kwv[tk], vw = vwv[tk];
            const float bon = half_sum32(bf_lo(rw) * bf_lo(kw) * rk.x + bf_hi(rw) * bf_hi(kw) * rk.y);
            const float o0 = (d0 * rs * gnw.x + gnb.x + bon * bf_lo(vw)) * gate[tk].x, o1 = (d1 * rs * gnw.y + gnb.y + bon * bf_hi(vw)) * gate[tk].y;
            *(unsigned*)(MIXED + (size_t)row * 2048 + 1024 + c0) = pk2(o0, o1);
        }
        {
            const float2 o = ov[tk];
            const float rs = rsqrtf(wave_sum(o.x * o.x + o.y * o.y) * (1.0f / 128.0f) + 1e-6f);
            const unsigned zw = zwv[tk];
            *(unsigned*)(MIXED + (size_t)row * 2048 + c0) = pk2(o.x * rs * ng.x * siluf_(bf_lo(zw)), o.y * rs * ng.y * siluf_(bf_hi(zw)));
        }
    }
    __syncthreads();
}

__device__ __forceinline__ void act_item(const Args& A, int item, int lane) {
    const bf16_t* H = (const bf16_t*)(A.ws + W_H); bf16_t* ACT = (bf16_t*)(A.ws + W_ACT);
    const float* cwp = A.in[27]; const float* st_ffn = A.in[6];
    const int cgp = item % 11, rg = item / 11, ch = (cgp * 64 + lane) * 8;
    float cg_[3][8], cu_[3][8];
#pragma unroll
    for (int i = 0; i < 3; ++i) { const float4 a0 = *(const float4*)(cwp + (size_t)i * DFF2 + ch), a1 = *(const float4*)(cwp + (size_t)i * DFF2 + ch + 4), b0 = *(const float4*)(cwp + (size_t)i * DFF2 + DFF + ch), b1 = *(const float4*)(cwp + (size_t)i * DFF2 + DFF + ch + 4);
        cg_[i][0] = a0.x; cg_[i][1] = a0.y; cg_[i][2] = a0.z; cg_[i][3] = a0.w; cg_[i][4] = a1.x; cg_[i][5] = a1.y; cg_[i][6] = a1.z; cg_[i][7] = a1.w;
        cu_[i][0] = b0.x; cu_[i][1] = b0.y; cu_[i][2] = b0.z; cu_[i][3] = b0.w; cu_[i][4] = b1.x; cu_[i][5] = b1.y; cu_[i][6] = b1.z; cu_[i][7] = b1.w; }
    uint4 hg[11], hu[11];
#pragma unroll
    for (int i = 0; i < 11; ++i) { int r = rg * 9 - 2 + i; r = r < 0 ? 0 : r; hg[i] = *(const uint4*)(H + (size_t)r * DFF2 + ch); hu[i] = *(const uint4*)(H + (size_t)r * DFF2 + DFF + ch); }
#pragma unroll
    for (int rI = 0; rI < 9; ++rI) {
        const int row = rg * 9 + rI; int grp, b, t, T; rowinfo(row, grp, b, t, T);
        float g[8], u[8];
#pragma unroll
        for (int e = 0; e < 8; ++e) { g[e] = 0.f; u[e] = 0.f; }
#pragma unroll
        for (int i = 0; i < 3; ++i) { const int tt = t - 2 + i; float xg[8], xu[8];
            if (tt >= 0) { unpack8(hg[rI + i], xg); unpack8(hu[rI + i], xu); }
            else if (grp) { const float* sp = st_ffn + ((size_t)b * 2 + (t + i)) * DFF2 + ch; const float4 a0 = *(const float4*)sp, a1 = *(const float4*)(sp + 4), b0 = *(const float4*)(sp + DFF), b1 = *(const float4*)(sp + DFF + 4);
                xg[0] = a0.x; xg[1] = a0.y; xg[2] = a0.z; xg[3] = a0.w; xg[4] = a1.x; xg[5] = a1.y; xg[6] = a1.z; xg[7] = a1.w;
                xu[0] = b0.x; xu[1] = b0.y; xu[2] = b0.z; xu[3] = b0.w; xu[4] = b1.x; xu[5] = b1.y; xu[6] = b1.z; xu[7] = b1.w; }
            else {
#pragma unroll
                for (int e = 0; e < 8; ++e) { xg[e] = 0.f; xu[e] = 0.f; } }
#pragma unroll
            for (int e = 0; e < 8; ++e) { g[e] += cg_[i][e] * xg[e]; u[e] += cu_[i][e] * xu[e]; } }
        float o[8];
#pragma unroll
        for (int e = 0; e < 8; ++e) o[e] = siluf_(g[e]) * u[e];
        uint4 w; w.x = pk2(o[0], o[1]); w.y = pk2(o[2], o[3]); w.z = pk2(o[4], o[5]); w.w = pk2(o[6], o[7]);
        *(uint4*)(ACT + (size_t)row * DFF + ch) = w;
    }
}

__device__ __forceinline__ void fast_grid_barrier(unsigned* bar, unsigned round, unsigned G) {
    asm volatile("s_waitcnt vmcnt(0)" ::: "memory");
    __syncthreads();
    if (threadIdx.x == 0) {
        __builtin_amdgcn_fence(__ATOMIC_RELEASE, "agent");
        asm volatile("s_waitcnt vmcnt(0)" ::: "memory");
        const unsigned g = blockIdx.x >> 4, ngroups = (G + 15u) >> 4, gsize = (G - g * 16u) < 16u ? (G - g * 16u) : 16u;
        unsigned* cnt = bar + 32u * (1u + g); unsigned* top = bar + 32u * 20u; unsigned* gen = bar + 32u * (24u + g);
        const unsigned old = __hip_atomic_fetch_add(cnt, 1u, __ATOMIC_RELAXED, __HIP_MEMORY_SCOPE_AGENT);
        if (old + 1u == round * gsize) {
            const unsigned t = __hip_atomic_fetch_add(top, 1u, __ATOMIC_RELAXED, __HIP_MEMORY_SCOPE_AGENT);
            if (t + 1u == round * ngroups) { for (unsigned q = 0; q < ngroups; ++q) __hip_atomic_store(bar + 32u * (24u + q), round, __ATOMIC_RELAXED, __HIP_MEMORY_SCOPE_AGENT); }
        }
        unsigned sp = 0u;
        while (__hip_atomic_load(gen, __ATOMIC_RELAXED, __HIP_MEMORY_SCOPE_AGENT) < round) { __builtin_amdgcn_s_sleep(1); if (++sp > (1u << 22)) break; }
        __builtin_amdgcn_fence(__ATOMIC_ACQUIRE, "agent");
        asm volatile("s_waitcnt vmcnt(0)" ::: "memory");
    }
    __syncthreads();
}

__global__ void __launch_bounds__(512, 2) hymba_fwd(Args A) {
    extern __shared__ __attribute__((aligned(16))) unsigned char lds_raw[];
    LAS unsigned char* lds = (LAS unsigned char*)lds_raw;
    cg::grid_group grid = cg::this_grid();
    const int tid = threadIdx.x, lane = tid & 63, wave = __builtin_amdgcn_readfirstlane(tid >> 6);
    const int G = gridDim.x, bx = blockIdx.x, gw = bx * 8 + wave, NGW = G * 8;
    const int lo = A.ph_lo, hi = A.ph_hi;
#define IN(k) (lo <= (k) && (k) < hi)
    unsigned* barcnt = (unsigned*)(A.ws + W_BAR); unsigned nbar = 0u;
#define SEAM(k) do { if (IN(k) && IN((k) + 1)) { ++nbar; fast_grid_barrier(barcnt, nbar, (unsigned)G); } } while (0)
    if (hi < 0) grid.sync();
    unsigned char* ws = A.ws; float* out = A.out;
    bf16_t* XN = (bf16_t*)(out + O_GDN_S);
    bf16_t* WT_IN = (bf16_t*)(out + O_RWKV_S);
    bf16_t* WT_O = (bf16_t*)(ws + W_WTO); bf16_t* WT_UP = (bf16_t*)(ws + W_WTUP); bf16_t* WT_DN = (bf16_t*)(ws + W_WTDN);
    bf16_t* PROJ = (bf16_t*)(ws + W_PROJ); bf16_t* MIXED = (bf16_t*)(ws + W_MIXED); bf16_t* XN2 = (bf16_t*)(ws + W_XN2);
    bf16_t* HB = (bf16_t*)(ws + W_H); bf16_t* ACT = (bf16_t*)(ws + W_ACT);
    float* X1 = out + O_Y; float* PART = (float*)(ws + W_PART);

    if (IN(0)) {
        LAS float* scr = (LAS float*)(lds + wave * 16384);
        constexpr int I_IN = 32 * (NINP / 64);
        for (int it = gw; it < I_IN; it += NGW) transpose_item(A.in[8], DM, NIN, WT_IN, scr, it, NINP / 64, lane);
        for (int i = bx * 512 + tid; i < 4096; i += G * 512) {
            int r = i; const float* W; bf16_t* WT; int K, j0;
            if (r < 1024) { W = A.in[15]; WT = (bf16_t*)((unsigned char*)out + OB_WBT); K = 64; j0 = 0; }
            else if (r < 2048) { r -= 1024; W = A.in[17]; WT = (bf16_t*)((unsigned char*)out + OB_ABT); K = 64; j0 = 0; }
            else { r -= 2048; W = A.in[18]; WT = (bf16_t*)((unsigned char*)out + OB_GBT); K = 128; j0 = (r >> 10) * 64; r &= 1023; }
            const int ch = r;
#pragma unroll
            for (int q = 0; q < 8; ++q) { float f[8];
#pragma unroll
                for (int e = 0; e < 8; ++e) f[e] = W[(size_t)(j0 + q * 8 + e) * 1024 + ch];
                uint4 o; o.x = pk2(f[0], f[1]); o.y = pk2(f[2], f[3]); o.z = pk2(f[4], f[5]); o.w = pk2(f[6], f[7]);
                *(uint4*)(WT + (size_t)ch * K + j0 + q * 8) = o; }
        }
        for (int m = gw; m < MTOK; m += NGW) { const float* xr = (m < MPR) ? A.in[0] + (size_t)m * DM : A.in[1] + (size_t)(m - MPR) * DM; rms_row_bf16(xr, A.in[7], XN + (size_t)m * DM, lane); }
        __syncthreads();
    }
    SEAM(0);
    if (IN(1)) {
        pg8::Gemm g{XN, WT_IN, MTOK, NINP, DM}; pg8::StaticOrder S; S.init(MTOK, NINP, DM, G, bx);
        pg8::EpiBf16P E{PROJ, NINP};
        pg8::gemm_phase<pg8::EpiBf16P, pg8::StaticOrder, true, true>(lds, g, S, E);
    }
    SEAM(1);
    if (IN(2)) { for (int tile = bx; tile < NTILES; tile += G) prep_tile(A, (LAS float*)lds, tile, tid); }
    SEAM(2);
    if (IN(3)) {
        LAS float* sl = (LAS float*)(lds + wave * 16384);
        const bf16_t* GQKV = (const bf16_t*)(ws + W_GQKV); const float* GA = (const float*)(ws + W_GAB); const float* GB = GA + MTOK * 8;
        const bf16_t* RS = (const bf16_t*)(ws + W_RS); const bf16_t* RV = (const bf16_t*)(ws + W_RV); const float* RW = (const float*)(ws + W_RW);
        float* yraw = out + O_Y;
        const bool heavy = (G == 256) && (bx >= 128);
        const int nshare = (G == 256) ? 3072 : NGW, share0 = (G == 256) ? (heavy ? 1024 + ((bx - 128) * 8 + wave) * 2 : gw) : gw, nsh = heavy ? 2 : 1;
        for (int task = gw; task < 2048; task += NGW) gdn_sample_cols(sl, GQKV, GA, GB, yraw, A.in[2], out + O_GDN_S, task, lane);
        for (int sh = 0; sh < nsh; ++sh) {
            rwkv_sample_loop(sl, RS, RV, RW, yraw, A.in[4], out + O_RWKV_S, share0 + sh, nshare, lane);
            constexpr int I_O = 32 * (DM / 64), I_UP = 32 * (DFF2 / 64), I_DN = (DFF / 64) * (DM / 64);
            for (int it = share0 + sh; it < I_O + I_UP + I_DN; it += nshare) {
                int r = it;
                if (r < I_O) { transpose_item(A.in[24], DM, DM, WT_O, sl, r, DM / 64, lane); continue; } r -= I_O;
                if (r < I_UP) { transpose_item(A.in[26], DM, DFF2, WT_UP, sl, r, DFF2 / 64, lane); continue; } r -= I_UP;
                transpose_item(A.in[28], DFF, DM, WT_DN, sl, r, DM / 64, lane);
            }
        }
        __syncthreads();
        for (int u = bx; u < 256; u += G) {
            if (u < 128) { const int bh = u >> 2, cq = u & 3;
                gdn_prompt_block((LAS float*)lds, GQKV, GA, GB, yraw, (bh >> 3) * 2048, 2048, bh & 7, cq * 32, out + O_GDN_P + (size_t)bh * 16384, tid, wave, lane); }
            else { const int uu = u - 128, bh = uu >> 1, hf = uu & 1;
                rwkv_prompt_block((LAS float*)lds, RS, RV, RW, yraw, (bh >> 4) * 2048, 2048, bh & 15, hf * 32, out + O_RWKV_P + (size_t)bh * 4096, tid, wave, lane); }
        }
        __syncthreads();
    }
    SEAM(3);
    if (IN(4)) {
        for (int tile = bx; tile < NTILES; tile += G) post_tile(A, (LAS float*)lds, tile, tid);
    }
    SEAM(4);
    if (IN(5)) {
        pg8::Gemm g{MIXED, WT_O, MTOK, DM, DM}; pg8::SplitOrder S; S.init(DM, bx);
        pg8::EpiResSplit E{A.in[0], X1, PART};
        pg8::gemm_phase<pg8::EpiResSplit, pg8::SplitOrder, true, true>(lds, g, S, E);
    }
    SEAM(5);
    if (IN(6)) {
        LAS float* scr = (LAS float*)(lds + wave * 16384);
        for (int m = gw; m < MTOK; m += NGW) {
            if (m >= MPR) { const float4* xs = (const float4*)(A.in[1] + (size_t)(m - MPR) * DM); float4* xo = (float4*)(X1 + (size_t)m * DM);
#pragma unroll
                for (int j = 0; j < 8; ++j) { float4 a = xs[lane + 64 * j];
#pragma unroll
                    for (int sg = 0; sg < 8; ++sg) { const uint2 b = ((const uint2*)((const bf16_t*)PART + ((size_t)sg * 1024 + (m - MPR)) * DM))[lane + 64 * j]; a.x += bf_lo(b.x); a.y += bf_hi(b.x); a.z += bf_lo(b.y); a.w += bf_hi(b.y); }
                    xo[lane + 64 * j] = a; } }
            rms_row_bf16(X1 + (size_t)m * DM, A.in[25], XN2 + (size_t)m * DM, lane);
        }
        __syncthreads();
    }
    SEAM(6);
    if (IN(7)) {
        pg8::Gemm g{XN2, WT_UP, MTOK, DFF2, DM}; pg8::StaticOrder S; S.init(MTOK, DFF2, DM, G, bx);
        pg8::EpiH E{HB, out + O_FFN_P, out + O_FFN_S};
        pg8::gemm_phase<pg8::EpiH, pg8::StaticOrder, true, true>(lds, g, S, E);
    }
    SEAM(7);
    if (IN(8)) { for (int it = gw; it < 11 * (MTOK / 9); it += NGW) act_item(A, it, lane); }
    SEAM(8);
    if (IN(9)) {
        pg8::Gemm g{ACT, WT_DN, MTOK, DM, DFF}; pg8::SplitOrder S; S.init(DFF, bx);
        pg8::EpiResSplit E{X1, X1, PART};
        pg8::gemm_phase<pg8::EpiResSplit, pg8::SplitOrder, true, true>(lds, g, S, E);
    }
    SEAM(9);
    if (IN(10)) { for (int m = gw; m < MTOK; m += NGW) {
            if (m >= MPR) { float4* xo = (float4*)(X1 + (size_t)m * DM);
#pragma unroll
                for (int j = 0; j < 8; ++j) { float4 a = xo[lane + 64 * j];
#pragma unroll
                    for (int sg = 0; sg < 8; ++sg) { const uint2 b = ((const uint2*)((const bf16_t*)PART + ((size_t)sg * 1024 + (m - MPR)) * DM))[lane + 64 * j]; a.x += bf_lo(b.x); a.y += bf_hi(b.x); a.z += bf_lo(b.y); a.w += bf_hi(b.y); }
                    xo[lane + 64 * j] = a; } }
            rms_row_f32_inplace(X1 + (size_t)m * DM, A.in[29], lane); } }
#undef IN
#undef SEAM
}

#ifndef N_LAUNCH_SPLIT
#define N_LAUNCH_SPLIT 0
#endif
extern "C" void kernel_launch(void* const* d_in, const int* in_sizes, int n_in, void* d_out, int out_size, void* d_ws, size_t ws_size, hipStream_t stream) {
    static int grid = 0;
    if (grid == 0) {
        int dev = 0, cus = 0, per_cu = 0;
        hipGetDevice(&dev);
        hipDeviceGetAttribute(&cus, hipDeviceAttributeMultiprocessorCount, dev);
        if (hipFuncSetAttribute((const void*)hymba_fwd, hipFuncAttributeMaxDynamicSharedMemorySize, LDS_BYTES) != hipSuccess) fprintf(stderr, "kernel_launch: hipFuncSetAttribute failed\n");
        if (hipOccupancyMaxActiveBlocksPerMultiprocessor(&per_cu, (const void*)hymba_fwd, 512, LDS_BYTES) != hipSuccess || per_cu < 1) { fprintf(stderr, "kernel_launch: occupancy query says %d\n", per_cu); per_cu = 1; }
        (void)hipGetLastError();
        grid = cus * 1;
        if (n_in != 30 || out_size != (int)O_END || ws_size < W_END4) fprintf(stderr, "kernel_launch: unexpected sizes n_in %d out %d ws %zu (need %zu)\n", n_in, out_size, ws_size, (size_t)W_END3);
    }
    if (hipMemsetAsync((char*)d_ws + W_BAR, 0, 8192, stream) != hipSuccess) fprintf(stderr, "kernel_launch: memset of the barrier word failed\n");
    Args a{};
    for (int i = 0; i < 30; ++i) a.in[i] = (const float*)d_in[i];
    a.out = (float*)d_out; a.ws = (unsigned char*)d_ws;
#if N_LAUNCH_SPLIT
    for (int p = 0; p <= 10; ++p) { a.ph_lo = p; a.ph_hi = p + 1; void* args[] = {&a};
        hipError_t e = hipLaunchCooperativeKernel((const void*)hymba_fwd, dim3(grid), dim3(512), args, LDS_BYTES, stream);
        if (e != hipSuccess) { fprintf(stderr, "kernel_launch: launch of phase %d failed: %s\n", p, hipGetErrorString(e)); break; } }
#else
    a.ph_lo = 0; a.ph_hi = 11; void* args[] = {&a};
    hipError_t e = hipLaunchCooperativeKernel((const void*)hymba_fwd, dim3(grid), dim3(512), args, LDS_BYTES, stream);
    if (e != hipSuccess) fprintf(stderr, "kernel_launch: cooperative launch failed: %s (grid %d)\n", hipGetErrorString(e), grid);
#endif
}
```

```cpp
#include <hip/hip_runtime.h>
#include <hip/hip_cooperative_groups.h>
#include <cstdio>
#include <cstdint>
namespace cg = cooperative_groups;
namespace pg8 {
#define PG8_LAS __attribute__((address_space(3)))
typedef unsigned short bf16_t;
typedef short bf16x8 __attribute__((ext_vector_type(8)));
typedef float f32x4 __attribute__((ext_vector_type(4)));
typedef unsigned u32x4 __attribute__((ext_vector_type(4)));
constexpr int BM = 256, BK = 64, HALF = 128, HTB = HALF * BK * 2  , STAGE_BYTES = 8 * HTB, NXCD = 8, WGM = 8;

__host__ __device__ __forceinline__ int lds_byte(int r, int c) { const int st = (r >> 4) * 2 + (c >> 5), rr = r & 15, cc = c & 31, ob = rr * 64 + cc * 2; return st * 1024 + (ob ^ (((ob >> 9) & 1) << 5)); }
__host__ __device__ __forceinline__ void stage_rc(int b, int& R, int& C) { const int st = b / 1024, sb = b % 1024, swz = sb ^ (((sb >> 9) & 1) << 5); R = (st >> 1) * 16 + swz / 64; C = (st & 1) * 32 + (swz % 64) / 2; }
__host__ __device__ __forceinline__ int perm32(int rho) { const int n = rho >> 4, i = rho & 15; return 8 * (i >> 2) + 4 * n + (i & 3); }

struct Unit { int pm, pn, k0, nt, seg; };
struct Gemm { const bf16_t* A; const bf16_t* Bt; int M, N, K; };

struct StaticOrder {
    int nM, nN, nwg, G, c, ntk;
    __host__ __device__ void init(int M, int N, int K, int G_, int c_) { nM = M / BM; nN = N / BM; nwg = nM * nN; G = G_; c = c_; ntk = K / BK; }
    __host__ __device__ bool next(int i, Unit& u) const {
        const long L = (long)i * G + c; if (L >= nwg) return false;
        int wgid = (int)L; { const int q = nwg / NXCD, r = nwg % NXCD, xcd = wgid % NXCD, off = wgid / NXCD; wgid = (xcd < r ? xcd * (q + 1) : r * (q + 1) + (xcd - r) * q) + off; }
        const int nig = WGM * nN, gid = wgid / nig, fm = gid * WGM, gsz = (nM - fm) < WGM ? (nM - fm) : WGM;
        u.pm = fm + ((wgid % nig) % gsz); u.pn = (wgid % nig) / gsz; u.k0 = 0; u.nt = ntk; u.seg = 0; return true;
    }
    __device__ __forceinline__ void a_ready(const Unit&) const {}
    __device__ __forceinline__ void done(const Unit&) const {}
};
__device__ __forceinline__ unsigned cvt_pk_bf16(float lo, float hi) { unsigned r; asm volatile("v_cvt_pk_bf16_f32 %0, %1, %2" : "=v"(r) : "v"(lo), "v"(hi)); return r; }
template <class Epi, class Sched, bool ALIGN_EPI = false, bool SP2 = false>
__device__ __forceinline__ void gemm_phase(PG8_LAS unsigned char* lds, const Gemm g, const Sched& S, const Epi& E) {
    const int tid = threadIdx.x, wid = __builtin_amdgcn_readfirstlane(tid >> 6), lane = tid & 63, wr = wid >> 2, wc = wid & 3, fr = lane & 15, fq = lane >> 4;
    const int K = g.K;
    unsigned voffA[2], voffB[2];
#pragma unroll
    for (int i = 0; i < 2; ++i) { int R, C; stage_rc(tid * 16 + i * 8192, R, C); const int Rb = Epi::PERM ? ((R & ~31) + perm32(R & 31)) : R;
        voffA[i] = (unsigned)(R * K + C) * 2u; voffB[i] = (unsigned)(Rb * K + C) * 2u; }
    const size_t kstep = (size_t)(BK * 2);
    const size_t hstep = (size_t)HALF * K * 2;
    const size_t tstep = 2 * hstep;
    const unsigned ldsw = (unsigned)wid * 1024u;
    const int aoff = lds_byte(wr * 64 + fr, fq * 8), boff = lds_byte(wc * 32 + fr, fq * 8);
#define PG8_SA(b, h) (((b) * 2 + (h)) * HTB)
#define PG8_SB(b, h) ((4 + (b) * 2 + (h)) * HTB)
#define PG8_STAGE(bufoff, gbase, voff) do { _Pragma("unroll") for (int _i = 0; _i < 2; ++_i) \
        __builtin_amdgcn_global_load_lds((const unsigned*)((const char*)(gbase) + (voff)[_i]), (PG8_LAS unsigned*)(lds + (bufoff) + ldsw + _i * 8192), 16, 0, 0); } while (0)
#define PG8_LDA(dst, b, h) do { _Pragma("unroll") for (int m = 0; m < 4; ++m) _Pragma("unroll") for (int k = 0; k < 2; ++k) dst[m][k] = *(const PG8_LAS bf16x8*)(lds + PG8_SA(b, h) + aoff + m * 2048 + k * 1024); } while (0)
#define PG8_LDB(dst, b, h) do { _Pragma("unroll") for (int n = 0; n < 2; ++n) _Pragma("unroll") for (int k = 0; k < 2; ++k) dst[n][k] = *(const PG8_LAS bf16x8*)(lds + PG8_SB(b, h) + boff + n * 2048 + k * 1024); } while (0)
#define PG8_MMA(ai, bj, At, Bt) do { __builtin_amdgcn_s_setprio(1); _Pragma("unroll") for (int m = 0; m < 4; ++m) _Pragma("unroll") for (int n = 0; n < 2; ++n) _Pragma("unroll") for (int k = 0; k < 2; ++k) \
        acc[ai][bj][m][n] = __builtin_amdgcn_mfma_f32_16x16x32_bf16(Bt[n][k], At[m][k], acc[ai][bj][m][n], 0, 0, 0); __builtin_amdgcn_s_setprio(0); } while (0)
#define PG8_WAIT_V(n) asm volatile("s_waitcnt vmcnt(" #n ")" ::: "memory")
#define PG8_WAIT_L(n) asm volatile("s_waitcnt lgkmcnt(" #n ")" ::: "memory")
#define PG8_BAR __builtin_amdgcn_s_barrier()
#define PG8_SCHED __builtin_amdgcn_sched_barrier(0)
    Unit cur, nxt; int ui = 0;
    if (!S.next(0, cur)) return;
    f32x4 acc[2][2][4][2];
#pragma unroll
    for (int a = 0; a < 2; ++a)
#pragma unroll
        for (int b = 0; b < 2; ++b)
#pragma unroll
            for (int m = 0; m < 4; ++m)
#pragma unroll
                for (int n = 0; n < 2; ++n) acc[a][b][m][n] = (f32x4){0.f, 0.f, 0.f, 0.f};
    bf16x8 At[4][2], B0[2][2], B1[2][2];
    const char* cA = (const char*)g.A + (size_t)cur.pm * tstep + (size_t)cur.k0 * kstep; const char* cB = (const char*)g.Bt + (size_t)cur.pn * tstep + (size_t)cur.k0 * kstep;
    S.a_ready(cur);
    if constexpr (SP2) {
        PG8_STAGE(PG8_SB(0, 0), cB, voffB); PG8_STAGE(PG8_SB(0, 1), cB + hstep, voffB); PG8_STAGE(PG8_SA(0, 0), cA, voffA); PG8_STAGE(PG8_SA(0, 1), cA + hstep, voffA);
        if (wr == 1) PG8_BAR;
        PG8_WAIT_V(2); PG8_BAR;
        PG8_STAGE(PG8_SB(1, 0), cB + kstep, voffB); PG8_STAGE(PG8_SA(1, 0), cA + kstep, voffA); PG8_STAGE(PG8_SB(1, 1), cB + hstep + kstep, voffB);
        PG8_WAIT_V(6); PG8_BAR;
    } else {
        PG8_STAGE(PG8_SB(0, 0), cB, voffB); PG8_STAGE(PG8_SA(0, 0), cA, voffA); PG8_STAGE(PG8_SB(0, 1), cB + hstep, voffB); PG8_STAGE(PG8_SA(0, 1), cA + hstep, voffA);
        if (wr == 1) PG8_BAR;
        PG8_WAIT_V(4); PG8_BAR;
        PG8_STAGE(PG8_SB(1, 0), cB + kstep, voffB); PG8_STAGE(PG8_SA(1, 0), cA + kstep, voffA); PG8_STAGE(PG8_SB(1, 1), cB + hstep + kstep, voffB);
        PG8_WAIT_V(6); PG8_BAR;
    }
    for (;;) {
        const bool has_next = S.next(ui + 1, nxt);
        const char* nA = has_next ? (const char*)g.A + (size_t)nxt.pm * tstep + (size_t)nxt.k0 * kstep : cA; const char* nB = has_next ? (const char*)g.Bt + (size_t)nxt.pn * tstep + (size_t)nxt.k0 * kstep : cB;
        const int nt = cur.nt;
        for (int t = 0; t < nt; t += 2) {
            const bool last = (t == nt - 2);
            const char* a1 = cA + (size_t)(t + 1) * kstep;
            const char* a2 = last ? nA : cA + (size_t)(t + 2) * kstep; const char* b2 = last ? nB : cB + (size_t)(t + 2) * kstep;
            const char* a3 = a2 + kstep; const char* b3 = b2 + kstep;
            if (last && has_next) S.a_ready(nxt);
            if constexpr (SP2) {
            PG8_LDB(B0, 0, 0); PG8_LDB(B1, 0, 1); PG8_SCHED; PG8_LDA(At, 0, 0); PG8_STAGE(PG8_SA(1, 1), a1 + hstep, voffA);
            PG8_WAIT_V(8); PG8_WAIT_L(0); PG8_BAR; PG8_MMA(0, 0, At, B0); PG8_MMA(0, 1, At, B1); PG8_BAR; PG8_SCHED;
            PG8_LDA(At, 0, 1); PG8_STAGE(PG8_SB(0, 0), b2, voffB); PG8_STAGE(PG8_SB(0, 1), b2 + hstep, voffB); PG8_STAGE(PG8_SA(0, 0), a2, voffA);
            PG8_WAIT_V(8); PG8_WAIT_L(0); PG8_BAR; PG8_MMA(1, 0, At, B0); PG8_MMA(1, 1, At, B1); PG8_BAR; PG8_SCHED;
            PG8_LDB(B0, 1, 0); PG8_LDB(B1, 1, 1); PG8_SCHED; PG8_LDA(At, 1, 0); PG8_STAGE(PG8_SA(0, 1), a2 + hstep, voffA);
            PG8_WAIT_V(8); PG8_WAIT_L(0); PG8_BAR; PG8_MMA(0, 0, At, B0); PG8_MMA(0, 1, At, B1); PG8_BAR; PG8_SCHED;
            PG8_LDA(At, 1, 1); PG8_STAGE(PG8_SB(1, 0), b3, voffB); PG8_STAGE(PG8_SB(1, 1), b3 + hstep, voffB); PG8_STAGE(PG8_SA(1, 0), a3, voffA);
            PG8_WAIT_V(8); PG8_WAIT_L(0); PG8_BAR; PG8_MMA(1, 0, At, B0); PG8_MMA(1, 1, At, B1); PG8_BAR; PG8_SCHED;
            } else {
            PG8_LDB(B0, 0, 0); PG8_SCHED; PG8_LDA(At, 0, 0); PG8_STAGE(PG8_SA(1, 1), a1 + hstep, voffA);
            PG8_WAIT_L(8); PG8_BAR; PG8_WAIT_L(0); PG8_MMA(0, 0, At, B0); PG8_BAR; PG8_SCHED;
            PG8_LDB(B1, 0, 1); PG8_STAGE(PG8_SB(0, 0), b2, voffB);
            PG8_BAR; PG8_WAIT_L(0); PG8_MMA(0, 1, At, B1); PG8_BAR;
            PG8_LDA(At, 0, 1); PG8_STAGE(PG8_SA(0, 0), a2, voffA);
            PG8_BAR; PG8_WAIT_L(0); PG8_MMA(1, 0, At, B0); PG8_BAR; PG8_SCHED;
            PG8_STAGE(PG8_SB(0, 1), b2 + hstep, voffB);
            PG8_WAIT_V(6); PG8_BAR; PG8_MMA(1, 1, At, B1); PG8_BAR;
            PG8_LDB(B0, 1, 0); PG8_SCHED; PG8_LDA(At, 1, 0); PG8_STAGE(PG8_SA(0, 1), a2 + hstep, voffA);
            PG8_WAIT_L(8); PG8_BAR; PG8_WAIT_L(0); PG8_MMA(0, 0, At, B0); PG8_BAR; PG8_SCHED;
            PG8_LDB(B1, 1, 1); PG8_STAGE(PG8_SB(1, 0), b3, voffB);
            PG8_BAR; PG8_WAIT_L(0); PG8_MMA(0, 1, At, B1); PG8_BAR;
            PG8_LDA(At, 1, 1); PG8_STAGE(PG8_SA(1, 0), a3, voffA);
            PG8_BAR; PG8_WAIT_L(0); PG8_MMA(1, 0, At, B0); PG8_BAR; PG8_SCHED;
            PG8_STAGE(PG8_SB(1, 1), b3 + hstep, voffB);
            PG8_WAIT_V(6); PG8_BAR; PG8_MMA(1, 1, At, B1); PG8_BAR;
            }
        }
        if constexpr (ALIGN_EPI) { if (wr == 0) PG8_BAR; }
        if constexpr (!Epi::AFTER_DRAIN) { E(acc, cur, wr, wc, fr, fq); S.done(cur); }
        if (!has_next) break;
#pragma unroll
        for (int a = 0; a < 2; ++a)
#pragma unroll
            for (int b = 0; b < 2; ++b)
#pragma unroll
                for (int m = 0; m < 4; ++m)
#pragma unroll
                    for (int n = 0; n < 2; ++n) acc[a][b][m][n] = (f32x4){0.f, 0.f, 0.f, 0.f};
        cur = nxt; cA = nA; cB = nB; ++ui;
        if constexpr (ALIGN_EPI) { if (wr == 1) PG8_BAR; }
    }
    PG8_WAIT_V(0);
    if constexpr (!ALIGN_EPI) { if (wr == 0) PG8_BAR; }
    PG8_BAR;
    if constexpr (Epi::AFTER_DRAIN) { E.fused(acc, cur, wr, wc, fr, fq, lds, wid, lane); S.done(cur); }
#undef PG8_SA
#undef PG8_SB
#undef PG8_STAGE
#undef PG8_LDA
#undef PG8_LDB
#undef PG8_MMA
#undef PG8_WAIT_V
#undef PG8_WAIT_L
#undef PG8_BAR
#undef PG8_SCHED
}
}

namespace pg8 {
struct EpiBf16P {
    static constexpr bool PERM = true, AFTER_DRAIN = false;
    bf16_t* O; int ldc;
    __device__ __forceinline__ void operator()(const f32x4 (&acc)[2][2][4][2], const Unit& u, int wr, int wc, int fr, int fq) const {
        const int row0 = u.pm * BM + wr * 64 + fr, col0 = u.pn * BM + wc * 32 + 8 * fq;
#pragma unroll
        for (int ai = 0; ai < 2; ++ai)
#pragma unroll
            for (int m = 0; m < 4; ++m) { bf16_t* rowp = O + (size_t)(row0 + ai * HALF + m * 16) * ldc + col0;
#pragma unroll
                for (int bj = 0; bj < 2; ++bj) { const f32x4 v0 = acc[ai][bj][m][0], v1 = acc[ai][bj][m][1];
                    u32x4 w; w.x = cvt_pk_bf16(v0[0], v0[1]); w.y = cvt_pk_bf16(v0[2], v0[3]); w.z = cvt_pk_bf16(v1[0], v1[1]); w.w = cvt_pk_bf16(v1[2], v1[3]);
                    *(u32x4*)(rowp + bj * HALF) = w; } }
    }
};
struct EpiH {
    static constexpr bool PERM = true, AFTER_DRAIN = false;
    bf16_t* O; float* ffn_p; float* ffn_s;
    __device__ __forceinline__ void operator()(const f32x4 (&acc)[2][2][4][2], const Unit& u, int wr, int wc, int fr, int fq) const {
        const int row0 = u.pm * BM + wr * 64 + fr, col0 = u.pn * BM + wc * 32 + 8 * fq;
#pragma unroll
        for (int ai = 0; ai < 2; ++ai)
#pragma unroll
            for (int m = 0; m < 4; ++m) { const int row = row0 + ai * HALF + m * 16; bf16_t* rowp = O + (size_t)row * 11264 + col0;
                float* tail = nullptr;
                if (row < 8192) { const int t = row & 2047; if (t >= 2046) tail = ffn_p + (size_t)((row >> 11) * 2 + (t - 2046)) * 11264 + col0; }
                else { const int r = row - 8192, t = r & 7; if (t >= 6) tail = ffn_s + (size_t)((r >> 3) * 2 + (t - 6)) * 11264 + col0; }
#pragma unroll
                for (int bj = 0; bj < 2; ++bj) { const f32x4 v0 = acc[ai][bj][m][0], v1 = acc[ai][bj][m][1];
                    u32x4 w; w.x = cvt_pk_bf16(v0[0], v0[1]); w.y = cvt_pk_bf16(v0[2], v0[3]); w.z = cvt_pk_bf16(v1[0], v1[1]); w.w = cvt_pk_bf16(v1[2], v1[3]);
                    *(u32x4*)(rowp + bj * HALF) = w;
                    if (tail) { *(f32x4*)(tail + bj * HALF) = v0; *(f32x4*)(tail + bj * HALF + 4) = v1; } } }
    }
};
struct EpiRes {
    static constexpr bool PERM = false, AFTER_DRAIN = false;
    const float* base_p; const float* base_s; float* out;
    __device__ __forceinline__ void operator()(const f32x4 (&acc)[2][2][4][2], const Unit& u, int wr, int wc, int fr, int fq) const {
        const int row0 = u.pm * BM + wr * 64 + fr, col0 = u.pn * BM + wc * 32 + 4 * fq;
        const float* base = (u.pm < 32) ? base_p : (base_s - (size_t)8192 * 2048);
#pragma unroll
        for (int ai = 0; ai < 2; ++ai)
#pragma unroll
            for (int m = 0; m < 4; ++m) { const size_t off = (size_t)(row0 + ai * HALF + m * 16) * 2048 + col0;
#pragma unroll
                for (int bj = 0; bj < 2; ++bj)
#pragma unroll
                    for (int n = 0; n < 2; ++n) { const f32x4 bs = *(const f32x4*)(base + off + bj * HALF + n * 16); *(f32x4*)(out + off + bj * HALF + n * 16) = bs + acc[ai][bj][m][n]; }
                asm volatile("" ::: "memory"); }
    }
};
struct SplitOrder {
    int c, ntk;
    __device__ void init(int K, int c_) { c = c_; ntk = K / BK; }
    __device__ bool next(int i, Unit& u) const {
        if (i == 0) { const int xcd = c & 7, j = c >> 3; u.pm = xcd * 4 + (j >> 3); u.pn = j & 7; u.k0 = 0; u.nt = ntk; u.seg = 0; return true; }
        if (i == 1) { const int uu = c >> 3, seg = c & 7, P = ntk >> 1, p0 = (seg * P) >> 3, p1 = ((seg + 1) * P) >> 3; u.pm = 32 + (uu >> 3); u.pn = uu & 7; u.k0 = 2 * p0; u.nt = 2 * (p1 - p0); u.seg = seg; return true; }
        return false;
    }
    __device__ __forceinline__ void a_ready(const Unit&) const {}
    __device__ __forceinline__ void done(const Unit&) const {}
};
struct EpiResSplit {
    static constexpr bool PERM = false, AFTER_DRAIN = false;
    const float* base_p; float* out_p; float* acc_s;
    __device__ __forceinline__ void operator()(const f32x4 (&acc)[2][2][4][2], const Unit& u, int wr, int wc, int fr, int fq) const {
        const int row0 = u.pm * BM + wr * 64 + fr, col0 = u.pn * BM + wc * 32 + 4 * fq;
        if (u.pm < 32) {
#pragma unroll
            for (int ai = 0; ai < 2; ++ai)
#pragma unroll
                for (int m = 0; m < 4; ++m) { const size_t off = (size_t)(row0 + ai * HALF + m * 16) * 2048 + col0;
#pragma unroll
                    for (int bj = 0; bj < 2; ++bj)
#pragma unroll
                        for (int n = 0; n < 2; ++n) { const f32x4 bs = *(const f32x4*)(base_p + off + bj * HALF + n * 16); *(f32x4*)(out_p + off + bj * HALF + n * 16) = bs + acc[ai][bj][m][n]; }
                    asm volatile("" ::: "memory"); }
        } else {
#pragma unroll
            for (int ai = 0; ai < 2; ++ai)
#pragma unroll
                for (int m = 0; m < 4; ++m) { float* p = acc_s + ((size_t)u.seg * 1024 + (size_t)(row0 - 8192 + ai * HALF + m * 16)) * 2048 + col0;
#pragma unroll
                    for (int bj = 0; bj < 2; ++bj)
#pragma unroll
                        for (int n = 0; n < 2; ++n) *(f32x4*)(p + bj * HALF + n * 16) = acc[ai][bj][m][n]; }
        }
    }
};
}

#define LAS __attribute__((address_space(3)))
typedef unsigned short bf16_t;
typedef float f32x4v __attribute__((ext_vector_type(4)));
typedef float f32x2v __attribute__((ext_vector_type(2)));
constexpr int MTOK = 9216, MPR = 8192, DM = 2048, NIN = 7440, NINP = 7680, DFF = 5632, DFF2 = 11264, RPROJ = 3328, OFFR = 4112;
constexpr int TT = 12, NTILES = MTOK / TT;
constexpr int LDS_BYTES = 131072;
constexpr size_t O_Y = 0, O_GDN_P = 18874368, O_GCONV_P = 19398656, O_RWKV_P = 19435520, O_SHIFT_P = 19697664, O_FFN_P = 19710976,
                 O_GDN_S = 19801088, O_GCONV_S = 36578304, O_RWKV_S = 37757952, O_SHIFT_S = 46146560, O_FFN_S = 46572544, O_END = 49456128;
constexpr size_t W_WTUP = 0, W_WTO = 46137344, W_PROJ = 54525952, W_GQKV = 196083712, W_GAB = 252706816, W_RS = 253296640, W_RV = 328794112, W_RW = 347668480, W_END1 = 385417216;
constexpr size_t W_PART = W_PROJ;
constexpr size_t W_MIXED = W_GQKV, W_H = W_WTO, W_WTDN = W_END1, W_ACT = W_H + (size_t)MTOK * DFF2 * 2 + (size_t)DM * DFF * 2, W_XN2 = W_ACT, W_END2 = W_ACT + (size_t)MTOK * DFF * 2, W_END3 = W_WTDN + (size_t)DM * DFF * 2;
static_assert(W_END2 <= W_END1 + 0, "late-phase overlay must fit");
static_assert(W_END3 == 408485888 && W_END2 == 380633088, "layout");
constexpr size_t W_BAR = W_END3, W_END4 = W_BAR + 8192;
constexpr size_t OB_WBT = O_FFN_S * 4, OB_ABT = OB_WBT + 1024 * 64 * 2, OB_GBT = OB_ABT + 1024 * 64 * 2;

struct Args { const float* in[30]; float* out; unsigned char* ws; int ph_lo, ph_hi; };

__device__ __forceinline__ float bf_lo(unsigned w) { return __uint_as_float(w << 16); }
__device__ __forceinline__ float bf_hi(unsigned w) { return __uint_as_float(w & 0xffff0000u); }
__device__ __forceinline__ unsigned pk2(float lo, float hi) { return pg8::cvt_pk_bf16(lo, hi); }
__device__ __forceinline__ unsigned pk2_safe(float lo, float hi) { unsigned r; asm volatile("s_nop 4\n\tv_cvt_pk_bf16_f32 %0, %1, %2" : "=v"(r) : "v"(lo), "v"(hi)); return r; }
__device__ __forceinline__ void unpack8(const uint4 w, float (&f)[8]) { f[0] = bf_lo(w.x); f[1] = bf_hi(w.x); f[2] = bf_lo(w.y); f[3] = bf_hi(w.y); f[4] = bf_lo(w.z); f[5] = bf_hi(w.z); f[6] = bf_lo(w.w); f[7] = bf_hi(w.w); }
__device__ __forceinline__ float wave_sum(float v) {
#pragma unroll
    for (int o = 1; o < 64; o <<= 1) v += __shfl_xor(v, o);
    return v;
}
__device__ __forceinline__ float half_sum32(float v) {
#pragma unroll
    for (int o = 1; o < 32; o <<= 1) v += __shfl_xor(v, o);
    return v;
}
__device__ __forceinline__ float sum16(float v) {
#pragma unroll
    for (int o = 1; o < 16; o <<= 1) v += __shfl_xor(v, o);
    return v;
}
template <int CTRL> __device__ __forceinline__ float dppf(float v) { return __int_as_float(__builtin_amdgcn_update_dpp(0, __float_as_int(v), CTRL, 0xF, 0xF, true)); }
__device__ __forceinline__ float reduce8(float v) {
    v += dppf<0xB1>(v);
    v += dppf<0x4E>(v);
    v += dppf<0x141>(v);
    return v;
}
__device__ __forceinline__ float sigmoidf_(float x) { return __builtin_amdgcn_rcpf(1.0f + __expf(-x)); }
__device__ __forceinline__ float siluf_(float x) { return x * __builtin_amdgcn_rcpf(1.0f + __expf(-x)); }
__device__ __forceinline__ float softplusf_(float x) { return fmaxf(x, 0.f) + __logf(1.0f + __expf(-fabsf(x))); }
__device__ __forceinline__ float tanhf_(float x) { const float e = __expf(-2.0f * fabsf(x)); const float r = (1.0f - e) * __builtin_amdgcn_rcpf(1.0f + e); return x < 0.f ? -r : r; }
__device__ __forceinline__ void rowinfo(int row, int& grp, int& b, int& t, int& T) {
    if (row < MPR) { grp = 0; b = row >> 11; t = row & 2047; T = 2048; } else { const int r = row - MPR; grp = 1; b = r >> 3; t = r & 7; T = 8; }
}
#define LDS_WAIT() asm volatile("s_waitcnt lgkmcnt(0)" ::: "memory")

__device__ __forceinline__ void transpose_item(const float* __restrict__ W, int K, int N, bf16_t* __restrict__ WT, LAS float* scr, int item, int nblk, int lane) {
    const int kb = item / nblk, nb = item - kb * nblk, k0 = 64 * kb, n0 = 64 * nb;
    const int r4 = lane >> 4, c4 = (lane & 15) * 4, n_in = n0 + c4;
    float4 v[16];
#pragma unroll
    for (int i = 0; i < 16; ++i) v[i] = (n_in < N) ? *(const float4*)(W + (size_t)(k0 + 4 * i + r4) * N + n_in) : make_float4(0.f, 0.f, 0.f, 0.f);
#pragma unroll
    for (int i = 0; i < 16; ++i) { const int k = 4 * i + r4; *(LAS f32x4v*)(scr + k * 64 + (c4 ^ (8 * ((k >> 3) & 7)))) = (f32x4v){v[i].x, v[i].y, v[i].z, v[i].w}; }
    LDS_WAIT();
    const int c = lane & 7;
#pragma unroll
    for (int j = 0; j < 8; ++j) { const int n = (lane >> 3) + 8 * j; const LAS float* sp = scr + (8 * c) * 64 + (n ^ (8 * c));
        uint4 o; o.x = pk2(sp[0], sp[64]); o.y = pk2(sp[128], sp[192]); o.z = pk2(sp[256], sp[320]); o.w = pk2(sp[384], sp[448]);
        *(uint4*)(WT + (size_t)(n0 + n) * K + k0 + 8 * c) = o; }
    LDS_WAIT();
}
__device__ __forceinline__ void rms_row_bf16(const float* __restrict__ xrow, const float* __restrict__ g, bf16_t* __restrict__ orow, int lane) {
    float4 v[8]; float ss = 0.f;
#pragma unroll
    for (int j = 0; j < 8; ++j) { v[j] = ((const float4*)xrow)[lane + 64 * j]; ss += (v[j].x * v[j].x + v[j].y * v[j].y) + (v[j].z * v[j].z + v[j].w * v[j].w); }
    const float rs = rsqrtf(wave_sum(ss) * (1.0f / DM) + 1e-6f);
#pragma unroll
    for (int j = 0; j < 8; ++j) { const float4 gg = ((const float4*)g)[lane + 64 * j];
        uint2 o; o.x = pk2(v[j].x * rs * gg.x, v[j].y * rs * gg.y); o.y = pk2(v[j].z * rs * gg.z, v[j].w * rs * gg.w);
        ((uint2*)orow)[lane + 64 * j] = o; }
}
__device__ __forceinline__ void rms_row_f32_inplace(float* xrow, const float* __restrict__ g, int lane) {
    float4 v[8]; float ss = 0.f;
#pragma unroll
    for (int j = 0; j < 8; ++j) { v[j] = ((const float4*)xrow)[lane + 64 * j]; ss += (v[j].x * v[j].x + v[j].y * v[j].y) + (v[j].z * v[j].z + v[j].w * v[j].w); }
    const float rs = rsqrtf(wave_sum(ss) * (1.0f / DM) + 1e-6f);
#pragma unroll
    for (int j = 0; j < 8; ++j) { const float4 gg = ((const float4*)g)[lane + 64 * j];
        float4 o; o.x = v[j].x * rs * gg.x; o.y = v[j].y * rs * gg.y; o.z = v[j].z * rs * gg.z; o.w = v[j].w * rs * gg.w;
        ((float4*)xrow)[lane + 64 * j] = o; }
}

__device__ __forceinline__ void prep_tile(const Args& A, LAS float* lw, int tile, int tid) {
    const bf16_t* PROJ = (const bf16_t*)(A.ws + W_PROJ);
    bf16_t* GQKV = (bf16_t*)(A.ws + W_GQKV); float* GA = (float*)(A.ws + W_GAB); float* GB = GA + MTOK * 8;
    bf16_t* RS = (bf16_t*)(A.ws + W_RS); bf16_t* RV = (bf16_t*)(A.ws + W_RV); float* RW = (float*)(A.ws + W_RW);
    const float* st_gconv = A.in[3]; const float* st_shift = A.in[5];
    const int row_base = tile * TT;
    const int c0 = tid * 2;
    unsigned pw[TT + 1][3];
#pragma unroll
    for (int i = 0; i < TT + 1; ++i) { int r = row_base - 1 + i; r = r < 0 ? 0 : r; const bf16_t* pr = PROJ + (size_t)r * NINP + OFFR + c0;
        pw[i][0] = *(const unsigned*)pr; pw[i][1] = *(const unsigned*)(pr + 1024); pw[i][2] = *(const unsigned*)(pr + 2048); }
    uint4 xr[TT + 3];
    { const int chx = (tid < 384 ? tid : 383) * 8;
#pragma unroll
      for (int i = 0; i < TT + 3; ++i) { int r = row_base - 3 + i; r = r < 0 ? 0 : r; xr[i] = *(const uint4*)(PROJ + (size_t)r * NINP + chx); } }
    {
        if (tid < 4 * 68) ((LAS unsigned*)lw)[TT * 68 + tid] = 0u;
        const float* mu = A.in[13];
#pragma unroll
        for (int i = 0; i < 2; ++i) { const int item = tid + 512 * i; if (item < TT * 64) { const int tk = item >> 6, jp = item & 63, row = row_base + tk; int grp, b, t, T; rowinfo(row, grp, b, t, T);
            const int col = 3072 + 2 * jp; const unsigned pw_ = *(const unsigned*)(PROJ + (size_t)row * NINP + OFFR + col);
            float q0, q1; if (t > 0) { const unsigned qw = *(const unsigned*)(PROJ + (size_t)(row - 1) * NINP + OFFR + col); q0 = bf_lo(qw); q1 = bf_hi(qw); }
            else if (grp) { const float2 sq = *(const float2*)(st_shift + (size_t)b * RPROJ + col); q0 = sq.x; q1 = sq.y; } else { q0 = 0.f; q1 = 0.f; }
            const float2 m2 = *(const float2*)(mu + col); const float p0 = bf_lo(pw_), p1 = bf_hi(pw_);
            float x0 = p0 + (q0 - p0) * m2.x, x1 = p1 + (q1 - p1) * m2.y;
            if (jp < 32) { x0 = tanhf_(x0); x1 = tanhf_(x1); }
            ((LAS unsigned*)lw)[tk * 68 + jp] = pk2_safe(x0, x1); } }
    }
    if (tid < 384) {
        const int ch = tid * 8, stream = tid >> 7;
        const float* cwp = A.in[9];
        float cw[4][8];
#pragma unroll
        for (int i = 0; i < 4; ++i) { const float4 a0 = *(const float4*)(cwp + i * 3072 + ch), a1 = *(const float4*)(cwp + i * 3072 + ch + 4);
            cw[i][0] = a0.x; cw[i][1] = a0.y; cw[i][2] = a0.z; cw[i][3] = a0.w; cw[i][4] = a1.x; cw[i][5] = a1.y; cw[i][6] = a1.z; cw[i][7] = a1.w; }
#pragma unroll
        for (int tk = 0; tk < TT; ++tk) {
            const int row = row_base + tk; int grp, b, t, T; rowinfo(row, grp, b, t, T);
            float y[8], xl[8];
#pragma unroll
            for (int e = 0; e < 8; ++e) y[e] = 0.f;
#pragma unroll
            for (int i = 0; i < 4; ++i) { const int tt = t - 3 + i; float x[8];
                if (tt >= 0) { unpack8(xr[tk + i], x); }
                else if (grp) { const float* sp = st_gconv + ((size_t)b * 3 + (t + i)) * 3072 + ch; const float4 a0 = *(const float4*)sp, a1 = *(const float4*)(sp + 4);
                    x[0] = a0.x; x[1] = a0.y; x[2] = a0.z; x[3] = a0.w; x[4] = a1.x; x[5] = a1.y; x[6] = a1.z; x[7] = a1.w; }
                else {
#pragma unroll
                    for (int e = 0; e < 8; ++e) x[e] = 0.f; }
#pragma unroll
                for (int e = 0; e < 8; ++e) { y[e] += cw[i][e] * x[e]; if (i == 3) xl[e] = x[e]; } }
            float ss = 0.f;
#pragma unroll
            for (int e = 0; e < 8; ++e) { y[e] = siluf_(y[e]); ss += y[e] * y[e]; }
            if (stream < 2) { ss = sum16(ss); const float sc = rsqrtf(ss + 1e-12f) * (stream == 0 ? 0.08838834764831845f : 1.0f);
#pragma unroll
                for (int e = 0; e < 8; ++e) y[e] *= sc; }
            uint4 o; o.x = pk2(y[0], y[1]); o.y = pk2(y[2], y[3]); o.z = pk2(y[4], y[5]); o.w = pk2(y[6], y[7]);
            *(uint4*)(GQKV + (size_t)row * 3072 + ch) = o;
            if (t >= T - 3) { float* gp = A.out + (grp ? O_GCONV_S : O_GCONV_P) + ((size_t)b * 3 + (t - (T - 3))) * 3072 + ch;
                *(float4*)gp = make_float4(xl[0], xl[1], xl[2], xl[3]); *(float4*)(gp + 4) = make_float4(xl[4], xl[5], xl[6], xl[7]); }
        }
    } else if (tid < 384 + TT * 8) {
        const int idx = tid - 384, tk = idx >> 3, h = idx & 7, row = row_base + tk;
        const float pb = bf_lo((unsigned)PROJ[(size_t)row * NINP + 4096 + h]), pa = bf_lo((unsigned)PROJ[(size_t)row * NINP + 4104 + h]);
        const float g = -__expf(A.in[10][h]) * softplusf_(pa + A.in[11][h]);
        GA[(size_t)row * 8 + h] = __expf(g); GB[(size_t)row * 8 + h] = sigmoidf_(pb);
    }
    __syncthreads();
    {
        const int wv_ = __builtin_amdgcn_readfirstlane(tid >> 6), ti = tid & 15, quad = (tid & 63) >> 4;
        LAS float* AWL = lw + 2048; LAS float* AAL = lw + 2048 + 13364;
        const LAS unsigned char* lb = (const LAS unsigned char*)lw + ti * 272 + quad * 16;
        pg8::bf16x8 bop[4];
#pragma unroll
        for (int ks = 0; ks < 4; ++ks) bop[ks] = *(const LAS pg8::bf16x8*)(lb + ks * 64);
#pragma unroll
        for (int which = 0; which < 2; ++which) {
            const bf16_t* WT = (const bf16_t*)((const unsigned char*)A.out + (which == 0 ? OB_WBT : OB_ABT)) + (size_t)(wv_ * 128 + ti) * 64 + quad * 8;
            const float* bias = A.in[which == 0 ? 14 : 16] + wv_ * 128 + quad * 4;
            LAS float* dst = (which == 0 ? AWL : AAL) + (ti < TT ? ti : TT) * 1028 + wv_ * 128 + quad * 4;
            pg8::bf16x8 aop[8][2];
#pragma unroll
            for (int t = 0; t < 8; ++t) { aop[t][0] = *(const pg8::bf16x8*)(WT + (size_t)t * 16 * 64); aop[t][1] = *(const pg8::bf16x8*)(WT + (size_t)t * 16 * 64 + 32); }
#pragma unroll
            for (int t = 0; t < 8; ++t) {
                pg8::f32x4 c = *(const pg8::f32x4*)(bias + t * 16);
                c = __builtin_amdgcn_mfma_f32_16x16x32_bf16(aop[t][0], bop[which * 2], c, 0, 0, 0);
                c = __builtin_amdgcn_mfma_f32_16x16x32_bf16(aop[t][1], bop[which * 2 + 1], c, 0, 0, 0);
                *(LAS f32x4v*)(dst + t * 16) = (f32x4v){c[0], c[1], c[2], c[3]};
            }
        }
    }
    __syncthreads();
    f32x2v aw[TT], aa[TT];
#pragma unroll
    for (int tk = 0; tk < TT; ++tk) { aw[tk] = *(const LAS f32x2v*)(lw + 2048 + tk * 1028 + c0); aa[tk] = *(const LAS f32x2v*)(lw + 2048 + 13364 + tk * 1028 + c0); }
    {
        const float* mu = A.in[13];
        const float2 mur = *(const float2*)(mu + c0), muk = *(const float2*)(mu + 1024 + c0), muv = *(const float2*)(mu + 2048 + c0);
        const float2 kkw = *(const float2*)(A.in[19] + c0), kaw = *(const float2*)(A.in[20] + c0);
#pragma unroll
        for (int tk = 0; tk < TT; ++tk) {
            const int row = row_base + tk; int grp, b, t, T; rowinfo(row, grp, b, t, T);
            const unsigned wr_ = pw[tk + 1][0], wk_ = pw[tk + 1][1], wv_ = pw[tk + 1][2];
            float r0 = bf_lo(wr_), r1 = bf_hi(wr_), k0 = bf_lo(wk_), k1 = bf_hi(wk_), v0 = bf_lo(wv_), v1 = bf_hi(wv_);
            float pr0, pr1, pk0, pk1, pv0, pv1;
            if (t > 0) { const unsigned a_ = pw[tk][0], b_ = pw[tk][1], c_ = pw[tk][2];
                pr0 = bf_lo(a_); pr1 = bf_hi(a_); pk0 = bf_lo(b_); pk1 = bf_hi(b_); pv0 = bf_lo(c_); pv1 = bf_hi(c_); }
            else if (grp) { const float* sp = st_shift + (size_t)b * RPROJ + c0; const float2 a_ = *(const float2*)sp, b_ = *(const float2*)(sp + 1024), c_ = *(const float2*)(sp + 2048);
                pr0 = a_.x; pr1 = a_.y; pk0 = b_.x; pk1 = b_.y; pv0 = c_.x; pv1 = c_.y; }
            else { pr0 = pr1 = pk0 = pk1 = pv0 = pv1 = 0.f; }
            r0 += (pr0 - r0) * mur.x; r1 += (pr1 - r1) * mur.y; k0 += (pk0 - k0) * muk.x; k1 += (pk1 - k1) * muk.y; v0 += (pv0 - v0) * muv.x; v1 += (pv1 - v1) * muv.y;
            const float w0_ = -softplusf_(-aw[tk].x) - 0.5f, w1_ = -softplusf_(-aw[tk].y) - 0.5f;
            const float d0 = __expf(-__expf(w0_)), d1 = __expf(-__expf(w1_));
            const float a0_ = sigmoidf_(aa[tk].x), a1_ = sigmoidf_(aa[tk].y);
            float q0 = k0 * kkw.x, q1 = k1 * kkw.y;
            const float inv = rsqrtf(half_sum32(q0 * q0 + q1 * q1) + 1e-12f);
            q0 *= inv; q1 *= inv;
            const float kp0 = k0 * (1.0f + (a0_ - 1.0f) * kaw.x), kp1 = k1 * (1.0f + (a1_ - 1.0f) * kaw.y);
            bf16_t* rs = RS + (size_t)row * 4096 + c0;
            *(unsigned*)rs = pk2(q0, q1); *(unsigned*)(rs + 1024) = pk2(q0 * a0_, q1 * a1_); *(unsigned*)(rs + 2048) = pk2(kp0, kp1); *(unsigned*)(rs + 3072) = pk2(r0, r1);
            *(unsigned*)(RV + (size_t)row * 1024 + c0) = pk2(v0, v1);
            *(float2*)(RW + (size_t)row * 1024 + c0) = make_float2(d0, d1);
        }
    }
    for (int tk = 0; tk < TT; ++tk) { const int row = row_base + tk; int grp, b, t, T; rowinfo(row, grp, b, t, T);
        if (t == T - 1) { float* sp = A.out + (grp ? O_SHIFT_S : O_SHIFT_P) + (size_t)b * RPROJ;
            for (int j = tid; j < RPROJ; j += 512) sp[j] = bf_lo((unsigned)PROJ[(size_t)row * NINP + OFFR + j]); } }
    __syncthreads();
}

constexpr int SCAN_LDS_PER_WAVE = 10752;
__device__ __forceinline__ void rwkv_sample_loop(LAS float* sl, const bf16_t* __restrict__ RS, const bf16_t* __restrict__ RV, const float* __restrict__ RW, float* __restrict__ yraw,
                                                 const float* __restrict__ st_in, float* __restrict__ st_out, int task0, int stride, int lane) {
    if (task0 >= 16384) return;
    const int part = lane & 7, rr = lane >> 3;
    LAS float* SB = sl; LAS float* WB = sl + 2048; LAS float* VB = sl + 2560;
    float4 nS0, nS1; uint4 nst[4]; float4 nsw[2]; uint4 nsv = make_uint4(0, 0, 0, 0);
#define RWS_LOAD(task_) do { const int bh_ = (task_) >> 3, v0_ = ((task_) & 7) * 8, h_ = bh_ & 15, row0_ = MPR + (bh_ >> 4) * 8; \
        const float* sp_ = st_in + (size_t)bh_ * 4096 + (size_t)(v0_ + rr) * 64 + part * 8; nS0 = *(const float4*)sp_; nS1 = *(const float4*)(sp_ + 4); \
        _Pragma("unroll") for (int i = 0; i < 4; ++i) { const int id = i * 64 + lane, step = id >> 5, s = (id >> 3) & 3, pc = id & 7; \
            nst[i] = *(const uint4*)(RS + (size_t)(row0_ + step) * 4096 + s * 1024 + h_ * 64 + pc * 8); } \
        _Pragma("unroll") for (int i = 0; i < 2; ++i) { const int id = i * 64 + lane, step = id >> 4, pc = id & 15; \
            nsw[i] = *(const float4*)(RW + (size_t)(row0_ + step) * 1024 + h_ * 64 + pc * 4); } \
        if (lane < 8) nsv = *(const uint4*)(RV + (size_t)(row0_ + lane) * 1024 + h_ * 64 + v0_); } while (0)
    RWS_LOAD(task0);
    for (int task = task0; task < 16384; task += stride) {
        const int bh = task >> 3, v0 = (task & 7) * 8, h = bh & 15, row0 = MPR + (bh >> 4) * 8;
        f32x2v S[4] = {(f32x2v){nS0.x, nS0.y}, (f32x2v){nS0.z, nS0.w}, (f32x2v){nS1.x, nS1.y}, (f32x2v){nS1.z, nS1.w}};
#pragma unroll
        for (int i = 0; i < 4; ++i) { const int id = i * 64 + lane, step = id >> 5, s = (id >> 3) & 3, pc = id & 7; float f[8]; unpack8(nst[i], f);
            LAS float* d = SB + (step * 4 + s) * 64 + pc * 8; *(LAS f32x4v*)d = (f32x4v){f[0], f[1], f[2], f[3]}; *(LAS f32x4v*)(d + 4) = (f32x4v){f[4], f[5], f[6], f[7]}; }
#pragma unroll
        for (int i = 0; i < 2; ++i) { const int id = i * 64 + lane, step = id >> 4, pc = id & 15; *(LAS f32x4v*)(WB + step * 64 + pc * 4) = (f32x4v){nsw[i].x, nsw[i].y, nsw[i].z, nsw[i].w}; }
        if (lane < 8) { float f[8]; unpack8(nsv, f); LAS float* d = VB + lane * 8; *(LAS f32x4v*)d = (f32x4v){f[0], f[1], f[2], f[3]}; *(LAS f32x4v*)(d + 4) = (f32x4v){f[4], f[5], f[6], f[7]}; }
        asm volatile("s_waitcnt lgkmcnt(0)" ::: "memory");
        __builtin_amdgcn_sched_barrier(0);
        if (task + stride < 16384) RWS_LOAD(task + stride);
        __builtin_amdgcn_sched_barrier(0);
        float ys[8];
        f32x4v kk0, kk1, ka0, ka1, kp0, kp1, r0, r1, w0, w1; float vv;
        f32x4v nkk0, nkk1, nka0, nka1, nkp0, nkp1, nr0, nr1, nw0, nw1; float nvv;
#define RW_OPS(s_) do { const LAS float* sb = SB + (s_) * 256 + part * 8; \
            nkk0 = *(const LAS f32x4v*)(sb); nkk1 = *(const LAS f32x4v*)(sb + 4); nka0 = *(const LAS f32x4v*)(sb + 64); nka1 = *(const LAS f32x4v*)(sb + 68); \
            nkp0 = *(const LAS f32x4v*)(sb + 128); nkp1 = *(const LAS f32x4v*)(sb + 132); nr0 = *(const LAS f32x4v*)(sb + 192); nr1 = *(const LAS f32x4v*)(sb + 196); \
            nw0 = *(const LAS f32x4v*)(WB + (s_) * 64 + part * 8); nw1 = *(const LAS f32x4v*)(WB + (s_) * 64 + part * 8 + 4); nvv = VB[(s_) * 8 + rr]; } while (0)
        RW_OPS(0);
#pragma unroll
        for (int s = 0; s < 8; ++s) {
            kk0 = nkk0; kk1 = nkk1; ka0 = nka0; ka1 = nka1; kp0 = nkp0; kp1 = nkp1; r0 = nr0; r1 = nr1; w0 = nw0; w1 = nw1; vv = nvv;
            if (s < 7) RW_OPS(s + 1);
            __builtin_amdgcn_sched_barrier(0);
            f32x2v acc = S[0] * kk0.lo, acc1 = S[1] * kk0.hi; acc = S[2] * kk1.lo + acc; acc1 = S[3] * kk1.hi + acc1; acc += acc1;
            const float sk = reduce8(acc.x + acc.y);
            const f32x2v nsk = (f32x2v){-sk, -sk}, vv2 = (f32x2v){vv, vv};
            S[0] = S[0] * w0.lo + (ka0.lo * nsk + kp0.lo * vv2);
            S[1] = S[1] * w0.hi + (ka0.hi * nsk + kp0.hi * vv2);
            S[2] = S[2] * w1.lo + (ka1.lo * nsk + kp1.lo * vv2);
            S[3] = S[3] * w1.hi + (ka1.hi * nsk + kp1.hi * vv2);
            f32x2v ya = S[0] * r0.lo, ya1 = S[1] * r0.hi; ya = S[2] * r1.lo + ya; ya1 = S[3] * r1.hi + ya1; ya += ya1;
            ys[s] = reduce8(ya.x + ya.y);
            __builtin_amdgcn_sched_barrier(0);
        }
#undef RW_OPS
        { float ysel = ys[0];
#pragma unroll
          for (int i = 1; i < 8; ++i) ysel = (part == i) ? ys[i] : ysel;
          yraw[(size_t)(row0 + part) * 2048 + 1024 + h * 64 + v0 + rr] = ysel; }
        { float* d = st_out + (size_t)bh * 4096 + (size_t)(v0 + rr) * 64 + part * 8; *(float4*)d = make_float4(S[0].x, S[0].y, S[1].x, S[1].y); *(float4*)(d + 4) = make_float4(S[2].x, S[2].y, S[3].x, S[3].y); }
        asm volatile("" ::: "memory");
    }
#undef RWS_LOAD
}
__device__ __forceinline__ void gdn_sample_loop(LAS float* sl, const bf16_t* __restrict__ GQKV, const float* __restrict__ GA, const float* __restrict__ GB, float* __restrict__ yraw,
                                                const float* __restrict__ st_in, float* __restrict__ st_out, int task0, int stride, int lane) {
    if (task0 >= 16384) return;
    const int part = lane & 7, cc = lane >> 3;
    LAS float* KB = sl; LAS float* QB = sl + 1056; LAS float* VB = sl + 2112; LAS float* AB = sl + 2176;
    const int rdoff = part * 16 + (part >> 2) * 4;
    float nS[16]; uint4 nst[4]; uint4 nsv = make_uint4(0, 0, 0, 0); float nsa = 0.f, nsb = 0.f;
#define GDS_LOAD(task_) do { const int bh_ = (task_) >> 4, j0_ = ((task_) & 15) * 8, h_ = bh_ & 7, row0_ = MPR + (bh_ >> 3) * 8; \
        const float* sp_ = st_in + (size_t)bh_ * 16384 + (size_t)(part * 16) * 128 + j0_ + cc; \
        _Pragma("unroll") for (int e = 0; e < 16; ++e) nS[e] = sp_[(size_t)e * 128]; \
        _Pragma("unroll") for (int i = 0; i < 4; ++i) { const int id = i * 64 + lane, s = id >> 7, step = (id >> 4) & 7, pc = id & 15; \
            nst[i] = *(const uint4*)(GQKV + (size_t)(row0_ + step) * 3072 + (s == 0 ? 1024 : 0) + h_ * 128 + pc * 8); } \
        if (lane < 8) { nsv = *(const uint4*)(GQKV + (size_t)(row0_ + lane) * 3072 + 2048 + h_ * 128 + j0_); \
            nsa = GA[(size_t)(row0_ + lane) * 8 + h_]; nsb = GB[(size_t)(row0_ + lane) * 8 + h_]; } } while (0)
    GDS_LOAD(task0);
    for (int task = task0; task < 16384; task += stride) {
        const int bh = task >> 4, j0 = (task & 15) * 8, h = bh & 7, row0 = MPR + (bh >> 3) * 8;
        f32x2v S[8];
#pragma unroll
        for (int e = 0; e < 8; ++e) S[e] = (f32x2v){nS[2 * e], nS[2 * e + 1]};
#pragma unroll
        for (int i = 0; i < 4; ++i) { const int id = i * 64 + lane, s = id >> 7, step = (id >> 4) & 7, pc = id & 15, pp = pc >> 1; float f[8]; unpack8(nst[i], f);
            LAS float* d = (s == 0 ? KB : QB) + step * 132 + pp * 16 + (pp >> 2) * 4 + (pc & 1) * 8; *(LAS f32x4v*)d = (f32x4v){f[0], f[1], f[2], f[3]}; *(LAS f32x4v*)(d + 4) = (f32x4v){f[4], f[5], f[6], f[7]}; }
        if (lane < 8) { float f[8]; unpack8(nsv, f); LAS float* d = VB + lane * 8; *(LAS f32x4v*)d = (f32x4v){f[0], f[1], f[2], f[3]}; *(LAS f32x4v*)(d + 4) = (f32x4v){f[4], f[5], f[6], f[7]};
            AB[lane * 2] = nsa; AB[lane * 2 + 1] = nsb; }
        asm volatile("s_waitcnt lgkmcnt(0)" ::: "memory");
        __builtin_amdgcn_sched_barrier(0);
        if (task + stride < 16384) GDS_LOAD(task + stride);
        __builtin_amdgcn_sched_barrier(0);
        float os[8];
        f32x4v k[4], q[4], nk[4], nq[4]; float v, a, beta, nv, na, nbeta;
#define GD_OPS(s_) do { const LAS float* kb = KB + (s_) * 132 + rdoff; const LAS float* qb = QB + (s_) * 132 + rdoff; \
            _Pragma("unroll") for (int i = 0; i < 4; ++i) { nk[i] = *(const LAS f32x4v*)(kb + 4 * i); nq[i] = *(const LAS f32x4v*)(qb + 4 * i); } \
            nv = VB[(s_) * 8 + cc]; na = AB[(s_) * 2]; nbeta = AB[(s_) * 2 + 1]; } while (0)
        GD_OPS(0);
#pragma unroll
        for (int s = 0; s < 8; ++s) {
#pragma unroll
            for (int i = 0; i < 4; ++i) { k[i] = nk[i]; q[i] = nq[i]; }
            v = nv; a = na; beta = nbeta;
            if (s < 7) GD_OPS(s + 1);
            __builtin_amdgcn_sched_barrier(0);
            f32x2v acc = S[0] * k[0].lo, acc1 = S[1] * k[0].hi;
#pragma unroll
            for (int i = 1; i < 4; ++i) { acc = S[2 * i] * k[i].lo + acc; acc1 = S[2 * i + 1] * k[i].hi + acc1; }
            acc += acc1;
            const float kS = reduce8(acc.x + acc.y);
            const float cf = beta * (v - a * kS);
            const f32x2v cf2 = (f32x2v){cf, cf}, a2 = (f32x2v){a, a};
#pragma unroll
            for (int i = 0; i < 4; ++i) { S[2 * i] = S[2 * i] * a2 + k[i].lo * cf2; S[2 * i + 1] = S[2 * i + 1] * a2 + k[i].hi * cf2; }
            f32x2v oa = S[0] * q[0].lo, oa1 = S[1] * q[0].hi;
#pragma unroll
            for (int i = 1; i < 4; ++i) { oa = S[2 * i] * q[i].lo + oa; oa1 = S[2 * i + 1] * q[i].hi + oa1; }
            oa += oa1;
            os[s] = reduce8(oa.x + oa.y);
            __builtin_amdgcn_sched_barrier(0);
        }
#undef GD_OPS
        { float osel = os[0];
#pragma unroll
          for (int i = 1; i < 8; ++i) osel = (part == i) ? os[i] : osel;
          yraw[(size_t)(row0 + part) * 2048 + h * 128 + j0 + cc] = osel; }
        { float* d = st_out + (size_t)bh * 16384 + (size_t)(part * 16) * 128 + j0 + cc;
#pragma unroll
          for (int e = 0; e < 8; ++e) { d[(size_t)(2 * e) * 128] = S[e].x; d[(size_t)(2 * e + 1) * 128] = S[e].y; } }
        asm volatile("" ::: "memory");
    }
#undef GDS_LOAD
}

__device__ __forceinline__ void gdn_sample_cols(LAS float* sl, const bf16_t* __restrict__ GQKV, const float* __restrict__ GA, const float* __restrict__ GB, float* __restrict__ yraw,
                                                const float* __restrict__ st_in, float* __restrict__ st_out, int task, int lane) {
    const int bh = task >> 1, j = (task & 1) * 64 + lane, h = bh & 7, row0 = MPR + (bh >> 3) * 8;
    LAS float* KB = sl; LAS float* QB = sl + 1024; LAS float* VB = sl + 2048; LAS float* AB = sl + 2560;
    f32x2v S[64];
    { const float* sp = st_in + (size_t)bh * 16384 + j;
#pragma unroll
      for (int i = 0; i < 64; ++i) { S[i] = (f32x2v){sp[0], sp[128]}; sp += 256; asm volatile("" : "+v"(sp)); } }
    {
        uint4 st[4];
#pragma unroll
        for (int i = 0; i < 4; ++i) { const int id = i * 64 + lane, s = id >> 7, step = (id >> 4) & 7, pc = id & 15;
            st[i] = *(const uint4*)(GQKV + (size_t)(row0 + step) * 3072 + (s == 0 ? 1024 : 0) + h * 128 + pc * 8); }
        unsigned short vv[8];
#pragma unroll
        for (int s = 0; s < 8; ++s) vv[s] = GQKV[(size_t)(row0 + s) * 3072 + 2048 + h * 128 + j];
        float sa = 0.f, sbt = 0.f;
        if (lane < 8) { sa = GA[(size_t)(row0 + lane) * 8 + h]; sbt = GB[(size_t)(row0 + lane) * 8 + h]; }
#pragma unroll
        for (int i = 0; i < 4; ++i) { const int id = i * 64 + lane, s = id >> 7, step = (id >> 4) & 7, pc = id & 15; float f[8]; unpack8(st[i], f);
            LAS float* d = (s == 0 ? KB : QB) + step * 128 + pc * 8; *(LAS f32x4v*)d = (f32x4v){f[0], f[1], f[2], f[3]}; *(LAS f32x4v*)(d + 4) = (f32x4v){f[4], f[5], f[6], f[7]}; }
#pragma unroll
        for (int s = 0; s < 8; ++s) VB[s * 64 + lane] = bf_lo((unsigned)vv[s]);
        if (lane < 8) { AB[lane * 2] = sa; AB[lane * 2 + 1] = sbt; }
        asm volatile("s_waitcnt lgkmcnt(0)" ::: "memory");
    }
#pragma unroll 1
    for (int s = 0; s < 8; ++s) {
        const LAS float* kb = KB + s * 128; const LAS float* qb = QB + s * 128;
        const float v = VB[s * 64 + lane], a = AB[s * 2], beta = AB[s * 2 + 1];
        f32x2v acc0 = (f32x2v){0.f, 0.f}, acc1 = (f32x2v){0.f, 0.f};
#pragma unroll
        for (int i = 0; i < 32; ++i) { const f32x4v kq = *(const LAS f32x4v*)(kb + 4 * i); acc0 = S[2 * i] * kq.lo + acc0; acc1 = S[2 * i + 1] * kq.hi + acc1; if ((i & 7) == 7) __builtin_amdgcn_sched_barrier(0); }
        acc0 += acc1;
        const float kS = acc0.x + acc0.y;
        const float cf = beta * (v - a * kS);
        const f32x2v cf2 = (f32x2v){cf, cf}, a2 = (f32x2v){a, a};
        f32x2v o0 = (f32x2v){0.f, 0.f}, o1 = (f32x2v){0.f, 0.f};
#pragma unroll
        for (int i = 0; i < 32; ++i) { const f32x4v kq = *(const LAS f32x4v*)(kb + 4 * i), qq = *(const LAS f32x4v*)(qb + 4 * i);
            S[2 * i] = S[2 * i] * a2 + kq.lo * cf2; S[2 * i + 1] = S[2 * i + 1] * a2 + kq.hi * cf2;
            o0 = S[2 * i] * qq.lo + o0; o1 = S[2 * i + 1] * qq.hi + o1; if ((i & 3) == 3) __builtin_amdgcn_sched_barrier(0); }
        o0 += o1;
        yraw[(size_t)(row0 + s) * 2048 + h * 128 + j] = o0.x + o0.y;
    }
    { float* dp = st_out + (size_t)bh * 16384 + j;
#pragma unroll
      for (int i = 0; i < 64; ++i) { dp[0] = S[i].x; dp[128] = S[i].y; dp += 256; asm volatile("" : "+v"(dp)); } }
    asm volatile("s_waitcnt lgkmcnt(0)" ::: "memory");
}

__device__ __forceinline__ float reduce16(float v) { v = reduce8(v); v += dppf<0x140>(v); return v; }
__device__ __forceinline__ void gdn_prompt_block(LAS float* L, const bf16_t* __restrict__ GQKV, const float* __restrict__ GA, const float* __restrict__ GB, float* __restrict__ yraw,
                                                 int row0, int T, int h, int jblk, float* __restrict__ s_out, int tid, int wave, int lane) {
    constexpr int BUF = 4768;
    const int part = lane & 15, cc = lane >> 4, j0 = jblk + wave * 4, rdoff = part * 8 + (part >> 3) * 4;
    f32x2v S[4];
#pragma unroll
    for (int e = 0; e < 4; ++e) S[e] = (f32x2v){0.f, 0.f};
    const int ss = tid >> 8, sstep = (tid >> 4) & 15, spc = tid & 15, vstep = (tid >> 2) & 15, vp = tid & 3, astep = tid & 15;
    uint4 st, sv = make_uint4(0, 0, 0, 0); float sa = 0.f, sbt = 0.f;
    const int nch = T >> 4;
#define GB_LOAD(c) do { const int t0_ = (c) * 16; st = *(const uint4*)(GQKV + (size_t)(row0 + t0_ + sstep) * 3072 + (ss == 0 ? 1024 : 0) + h * 128 + spc * 8); \
        if (tid < 64) sv = *(const uint4*)(GQKV + (size_t)(row0 + t0_ + vstep) * 3072 + 2048 + h * 128 + jblk + vp * 8); \
        else if (tid < 80) { sa = GA[(size_t)(row0 + t0_ + astep) * 8 + h]; sbt = GB[(size_t)(row0 + t0_ + astep) * 8 + h]; } } while (0)
#define GB_WRITE(b) do { LAS float* base = L + (b) * BUF; { float f[8]; unpack8(st, f); LAS float* d = base + ss * 2112 + sstep * 132 + spc * 8 + (spc >> 3) * 4; \
            *(LAS f32x4v*)d = (f32x4v){f[0], f[1], f[2], f[3]}; *(LAS f32x4v*)(d + 4) = (f32x4v){f[4], f[5], f[6], f[7]}; } \
        if (tid < 64) { float f[8]; unpack8(sv, f); LAS float* d = base + 4224 + vstep * 32 + vp * 8; *(LAS f32x4v*)d = (f32x4v){f[0], f[1], f[2], f[3]}; *(LAS f32x4v*)(d + 4) = (f32x4v){f[4], f[5], f[6], f[7]}; } \
        else if (tid < 80) { base[4736 + astep * 2] = sa; base[4736 + astep * 2 + 1] = sbt; } } while (0)
    GB_LOAD(0); GB_WRITE(0);
    __syncthreads();
    for (int c = 0; c < nch; ++c) {
        if (c + 1 < nch) GB_LOAD(c + 1);
        __builtin_amdgcn_sched_barrier(0);
        const LAS float* base = L + (c & 1) * BUF;
        float os[16];
        f32x2v k[4], q[4], nk[4], nq[4]; float v, a, beta, nv, na, nbeta;
#define GB_OPS(s_) do { const LAS float* kb = base + (s_) * 132 + rdoff; const LAS float* qb = base + 2112 + (s_) * 132 + rdoff; \
            _Pragma("unroll") for (int i = 0; i < 2; ++i) { const f32x4v t0 = *(const LAS f32x4v*)(kb + 4 * i), t1 = *(const LAS f32x4v*)(qb + 4 * i); \
                nk[2 * i] = t0.lo; nk[2 * i + 1] = t0.hi; nq[2 * i] = t1.lo; nq[2 * i + 1] = t1.hi; } \
            nv = base[4224 + (s_) * 32 + wave * 4 + cc]; na = base[4736 + (s_) * 2]; nbeta = base[4736 + (s_) * 2 + 1]; } while (0)
        GB_OPS(0);
#pragma unroll
        for (int s = 0; s < 16; ++s) {
#pragma unroll
            for (int i = 0; i < 4; ++i) { k[i] = nk[i]; q[i] = nq[i]; }
            v = nv; a = na; beta = nbeta;
            if (s < 15) GB_OPS(s + 1);
            __builtin_amdgcn_sched_barrier(0);
            f32x2v acc = S[0] * k[0], acc1 = S[1] * k[1]; acc = S[2] * k[2] + acc; acc1 = S[3] * k[3] + acc1; acc += acc1;
            const float kS = reduce16(acc.x + acc.y);
            const float cf = beta * (v - a * kS);
            const f32x2v cf2 = (f32x2v){cf, cf}, a2 = (f32x2v){a, a};
#pragma unroll
            for (int i = 0; i < 4; ++i) S[i] = S[i] * a2 + k[i] * cf2;
            f32x2v oa = S[0] * q[0], oa1 = S[1] * q[1]; oa = S[2] * q[2] + oa; oa1 = S[3] * q[3] + oa1; oa += oa1;
            os[s] = reduce16(oa.x + oa.y);
            __builtin_amdgcn_sched_barrier(0);
        }
#undef GB_OPS
        { float osel = os[0];
#pragma unroll
          for (int i = 1; i < 16; ++i) osel = (part == i) ? os[i] : osel;
          yraw[(size_t)(row0 + c * 16 + part) * 2048 + h * 128 + j0 + cc] = osel; }
        if (c + 1 < nch) GB_WRITE((c + 1) & 1);
        __syncthreads();
    }
#undef GB_LOAD
#undef GB_WRITE
#pragma unroll
    for (int e = 0; e < 4; ++e) { s_out[(size_t)(part * 8 + 2 * e) * 128 + j0 + cc] = S[e].x; s_out[(size_t)(part * 8 + 2 * e + 1) * 128 + j0 + cc] = S[e].y; }
}
__device__ __forceinline__ void rwkv_prompt_block(LAS float* L, const bf16_t* __restrict__ RS, const bf16_t* __restrict__ RV, const float* __restrict__ RW, float* __restrict__ yraw,
                                                  int row0, int T, int h, int vblk, float* __restrict__ s_out, int tid, int wave, int lane) {
    constexpr int BUF = 5632;
    const int part = lane & 15, rr = lane >> 4, v0 = vblk + wave * 4;
    f32x2v S[2] = {(f32x2v){0.f, 0.f}, (f32x2v){0.f, 0.f}};
    const int sstep = tid >> 5, ss = (tid >> 3) & 3, spc = tid & 7, wstep = (tid >> 4) & 15, wpc = tid & 15, vstep = (tid >> 2) & 15, vp = tid & 3;
    uint4 st, sv = make_uint4(0, 0, 0, 0); float4 sw = make_float4(0.f, 0.f, 0.f, 0.f);
    const int nch = T >> 4;
#define RB_LOAD(c) do { const int t0_ = (c) * 16; st = *(const uint4*)(RS + (size_t)(row0 + t0_ + sstep) * 4096 + ss * 1024 + h * 64 + spc * 8); \
        if (tid < 256) sw = *(const float4*)(RW + (size_t)(row0 + t0_ + wstep) * 1024 + h * 64 + wpc * 4); \
        else if (tid < 320) sv = *(const uint4*)(RV + (size_t)(row0 + t0_ + vstep) * 1024 + h * 64 + vblk + vp * 8); } while (0)
#define RB_WRITE(b) do { LAS float* base = L + (b) * BUF; { float f[8]; unpack8(st, f); LAS float* d = base + (sstep * 4 + ss) * 64 + spc * 8; \
            *(LAS f32x4v*)d = (f32x4v){f[0], f[1], f[2], f[3]}; *(LAS f32x4v*)(d + 4) = (f32x4v){f[4], f[5], f[6], f[7]}; } \
        if (tid < 256) *(LAS f32x4v*)(base + 4096 + wstep * 64 + wpc * 4) = (f32x4v){sw.x, sw.y, sw.z, sw.w}; \
        else if (tid < 320) { float f[8]; unpack8(sv, f); LAS float* d = base + 5120 + vstep * 32 + vp * 8; *(LAS f32x4v*)d = (f32x4v){f[0], f[1], f[2], f[3]}; *(LAS f32x4v*)(d + 4) = (f32x4v){f[4], f[5], f[6], f[7]}; } } while (0)
    RB_LOAD(0); RB_WRITE(0);
    __syncthreads();
    for (int c = 0; c < nch; ++c) {
        if (c + 1 < nch) RB_LOAD(c + 1);
        __builtin_amdgcn_sched_barrier(0);
        const LAS float* base = L + (c & 1) * BUF;
        float ys[16];
        f32x4v kk, ka, kp, r, w, nkk, nka, nkp, nr, nw; float vv, nvv;
#define RB_OPS(s_) do { const LAS float* sb = base + (s_) * 256 + part * 4; nkk = *(const LAS f32x4v*)(sb); nka = *(const LAS f32x4v*)(sb + 64); nkp = *(const LAS f32x4v*)(sb + 128); nr = *(const LAS f32x4v*)(sb + 192); \
            nw = *(const LAS f32x4v*)(base + 4096 + (s_) * 64 + part * 4); nvv = base[5120 + (s_) * 32 + wave * 4 + rr]; } while (0)
        RB_OPS(0);
#pragma unroll
        for (int s = 0; s < 16; ++s) {
            kk = nkk; ka = nka; kp = nkp; r = nr; w = nw; vv = nvv;
            if (s < 15) RB_OPS(s + 1);
            __builtin_amdgcn_sched_barrier(0);
            f32x2v acc = S[0] * kk.lo + S[1] * kk.hi;
            const float sk = reduce16(acc.x + acc.y);
            const f32x2v nsk = (f32x2v){-sk, -sk}, vv2 = (f32x2v){vv, vv};
            S[0] = S[0] * w.lo + (ka.lo * nsk + kp.lo * vv2);
            S[1] = S[1] * w.hi + (ka.hi * nsk + kp.hi * vv2);
            f32x2v ya = S[0] * r.lo + S[1] * r.hi;
            ys[s] = reduce16(ya.x + ya.y);
            __builtin_amdgcn_sched_barrier(0);
        }
#undef RB_OPS
        { float ysel = ys[0];
#pragma unroll
          for (int i = 1; i < 16; ++i) ysel = (part == i) ? ys[i] : ysel;
          yraw[(size_t)(row0 + c * 16 + part) * 2048 + 1024 + h * 64 + v0 + rr] = ysel; }
        if (c + 1 < nch) RB_WRITE((c + 1) & 1);
        __syncthreads();
    }
#undef RB_LOAD
#undef RB_WRITE
    *(float4*)(s_out + (size_t)(v0 + rr) * 64 + part * 4) = make_float4(S[0].x, S[0].y, S[1].x, S[1].y);
}

__device__ __forceinline__ void post_tile(const Args& A, LAS float* lg, int tile, int tid) {
    const bf16_t* PROJ = (const bf16_t*)(A.ws + W_PROJ);
    const bf16_t* RS = (const bf16_t*)(A.ws + W_RS); const bf16_t* RV = (const bf16_t*)(A.ws + W_RV);
    bf16_t* MIXED = (bf16_t*)(A.ws + W_MIXED);
    const float* yraw = A.out + O_Y; const float* st_shift = A.in[5];
    const int row_base = tile * TT;
    const int c0 = tid * 2;
    float2 yv[TT], ov[TT]; unsigned rwv[TT], kwv[TT], vwv[TT], zwv[TT];
#pragma unroll
    for (int tk = 0; tk < TT; ++tk) { const int row = row_base + tk;
        yv[tk] = *(const float2*)(yraw + (size_t)row * 2048 + 1024 + c0); ov[tk] = *(const float2*)(yraw + (size_t)row * 2048 + c0);
        rwv[tk] = *(const unsigned*)(RS + (size_t)row * 4096 + 3072 + c0); kwv[tk] = *(const unsigned*)(RS + (size_t)row * 4096 + 2048 + c0); vwv[tk] = *(const unsigned*)(RV + (size_t)row * 1024 + c0);
        zwv[tk] = *(const unsigned*)(PROJ + (size_t)row * NINP + 3072 + c0); }
    {
        if (tid < 4 * 68) ((LAS unsigned*)lg)[TT * 68 + tid] = 0u;
        const float* mu = A.in[13];
#pragma unroll
        for (int i = 0; i < 2; ++i) { const int item = tid + 512 * i; if (item < TT * 64) { const int tk = item >> 6, jp = item & 63, row = row_base + tk; int grp, b, t, T; rowinfo(row, grp, b, t, T);
            const int col = 3200 + 2 * jp; const unsigned pw_ = *(const unsigned*)(PROJ + (size_t)row * NINP + OFFR + col);
            float q0, q1; if (t > 0) { const unsigned qw = *(const unsigned*)(PROJ + (size_t)(row - 1) * NINP + OFFR + col); q0 = bf_lo(qw); q1 = bf_hi(qw); }
            else if (grp) { const float2 sq = *(const float2*)(st_shift + (size_t)b * RPROJ + col); q0 = sq.x; q1 = sq.y; } else { q0 = 0.f; q1 = 0.f; }
            const float2 m2 = *(const float2*)(mu + col); const float p0 = bf_lo(pw_), p1 = bf_hi(pw_);
            ((LAS unsigned*)lg)[tk * 68 + jp] = pk2_safe(sigmoidf_(p0 + (q0 - p0) * m2.x), sigmoidf_(p1 + (q1 - p1) * m2.y)); } }
    }
    __syncthreads();
    {
        const int wv_ = __builtin_amdgcn_readfirstlane(tid >> 6), ti = tid & 15, quad = (tid & 63) >> 4;
        const LAS unsigned char* lb = (const LAS unsigned char*)lg + ti * 272 + quad * 16;
        pg8::bf16x8 bop[4];
#pragma unroll
        for (int ks = 0; ks < 4; ++ks) bop[ks] = *(const LAS pg8::bf16x8*)(lb + ks * 64);
        const bf16_t* WT = (const bf16_t*)((const unsigned char*)A.out + OB_GBT) + (size_t)(wv_ * 128 + ti) * 128 + quad * 8;
        LAS float* dst = lg + 2048 + (ti < TT ? ti : TT) * 1028 + wv_ * 128 + quad * 4;
#pragma unroll
        for (int hh = 0; hh < 2; ++hh) {
            pg8::bf16x8 aop[4][4];
#pragma unroll
            for (int t = 0; t < 4; ++t)
#pragma unroll
                for (int ks = 0; ks < 4; ++ks) aop[t][ks] = *(const pg8::bf16x8*)(WT + (size_t)(hh * 4 + t) * 16 * 128 + ks * 32);
#pragma unroll
            for (int t = 0; t < 4; ++t) {
                pg8::f32x4 c = (pg8::f32x4){0.f, 0.f, 0.f, 0.f};
#pragma unroll
                for (int ks = 0; ks < 4; ++ks) c = __builtin_amdgcn_mfma_f32_16x16x32_bf16(aop[t][ks], bop[ks], c, 0, 0, 0);
                *(LAS f32x4v*)(dst + (hh * 4 + t) * 16) = (f32x4v){c[0], c[1], c[2], c[3]};
            }
        }
    }
    __syncthreads();
    f32x2v gate[TT];
#pragma unroll
    for (int tk = 0; tk < TT; ++tk) gate[tk] = *(const LAS f32x2v*)(lg + 2048 + tk * 1028 + c0);
    const float2 gnw = *(const float2*)(A.in[22] + c0), gnb = *(const float2*)(A.in[23] + c0), rk = *(const float2*)(A.in[21] + c0);
    const float2 ng = *(const float2*)(A.in[12] + (c0 & 127));
#pragma unroll
    for (int tk = 0; tk < TT; ++tk) {
        const int row = row_base + tk;
        {
            const float2 y = yv[tk];
            const float mean = half_sum32(y.x + y.y) * (1.0f / 64.0f);
            const float d0 = y.x - mean, d1 = y.y - mean;
            const float var = half_sum32(d0 * d0 + d1 * d1) * (1.0f / 64.0f);
            const float rs = rsqrtf(var + 64e-5f);
            const unsigned rw = rwv[tk], kw = kwv[tk], vw = vwv[tk];
            const float bon = half_sum32(bf_lo(rw) * bf_lo(kw) * rk.x + bf_hi(rw) * bf_hi(kw) * rk.y);
            const float o0 = (d0 * rs * gnw.x + gnb.x + bon * bf_lo(vw)) * gate[tk].x, o1 = (d1 * rs * gnw.y + gnb.y + bon * bf_hi(vw)) * gate[tk].y;
            *(unsigned*)(MIXED + (size_t)row * 2048 + 1024 + c0) = pk2(o0, o1);
        }
        {
            const float2 o = ov[tk];
            const float rs = rsqrtf(wave_sum(o.x * o.x + o.y * o.y) * (1.0f / 128.0f) + 1e-6f);
            const unsigned zw = zwv[tk];
            *(unsigned*)(MIXED + (size_t)row * 2048 + c0) = pk2(o.x * rs * ng.x * siluf_(bf_lo(zw)), o.y * rs * ng.y * siluf_(bf_hi(zw)));
        }
    }
    __syncthreads();
}

__device__ __forceinline__ void act_item(const Args& A, int item, int lane) {
    const bf16_t* H = (const bf16_t*)(A.ws + W_H); bf16_t* ACT = (bf16_t*)(A.ws + W_ACT);
    const float* cwp = A.in[27]; const float* st_ffn = A.in[6];
    const int cgp = item % 11, rg = item / 11, ch = (cgp * 64 + lane) * 8;
    float cg_[3][8], cu_[3][8];
#pragma unroll
    for (int i = 0; i < 3; ++i) { const float4 a0 = *(const float4*)(cwp + (size_t)i * DFF2 + ch), a1 = *(const float4*)(cwp + (size_t)i * DFF2 + ch + 4), b0 = *(const float4*)(cwp + (size_t)i * DFF2 + DFF + ch), b1 = *(const float4*)(cwp + (size_t)i * DFF2 + DFF + ch + 4);
        cg_[i][0] = a0.x; cg_[i][1] = a0.y; cg_[i][2] = a0.z; cg_[i][3] = a0.w; cg_[i][4] = a1.x; cg_[i][5] = a1.y; cg_[i][6] = a1.z; cg_[i][7] = a1.w;
        cu_[i][0] = b0.x; cu_[i][1] = b0.y; cu_[i][2] = b0.z; cu_[i][3] = b0.w; cu_[i][4] = b1.x; cu_[i][5] = b1.y; cu_[i][6] = b1.z; cu_[i][7] = b1.w; }
    uint4 hg[11], hu[11];
#pragma unroll
    for (int i = 0; i < 11; ++i) { int r = rg * 9 - 2 + i; r = r < 0 ? 0 : r; hg[i] = *(const uint4*)(H + (size_t)r * DFF2 + ch); hu[i] = *(const uint4*)(H + (size_t)r * DFF2 + DFF + ch); }
#pragma unroll
    for (int rI = 0; rI < 9; ++rI) {
        const int row = rg * 9 + rI; int grp, b, t, T; rowinfo(row, grp, b, t, T);
        float g[8], u[8];
#pragma unroll
        for (int e = 0; e < 8; ++e) { g[e] = 0.f; u[e] = 0.f; }
#pragma unroll
        for (int i = 0; i < 3; ++i) { const int tt = t - 2 + i; float xg[8], xu[8];
            if (tt >= 0) { unpack8(hg[rI + i], xg); unpack8(hu[rI + i], xu); }
            else if (grp) { const float* sp = st_ffn + ((size_t)b * 2 + (t + i)) * DFF2 + ch; const float4 a0 = *(const float4*)sp, a1 = *(const float4*)(sp + 4), b0 = *(const float4*)(sp + DFF), b1 = *(const float4*)(sp + DFF + 4);
                xg[0] = a0.x; xg[1] = a0.y; xg[2] = a0.z; xg[3] = a0.w; xg[4] = a1.x; xg[5] = a1.y; xg[6] = a1.z; xg[7] = a1.w;
                xu[0] = b0.x; xu[1] = b0.y; xu[2] = b0.z; xu[3] = b0.w; xu[4] = b1.x; xu[5] = b1.y; xu[6] = b1.z; xu[7] = b1.w; }
            else {
#pragma unroll
                for (int e = 0; e < 8; ++e) { xg[e] = 0.f; xu[e] = 0.f; } }
#pragma unroll
            for (int e = 0; e < 8; ++e) { g[e] += cg_[i][e] * xg[e]; u[e] += cu_[i][e] * xu[e]; } }
        float o[8];
#pragma unroll
        for (int e = 0; e < 8; ++e) o[e] = siluf_(g[e]) * u[e];
        uint4 w; w.x = pk2(o[0], o[1]); w.y = pk2(o[2], o[3]); w.z = pk2(o[4], o[5]); w.w = pk2(o[6], o[7]);
        *(uint4*)(ACT + (size_t)row * DFF + ch) = w;
    }
}

__device__ __forceinline__ void fast_grid_barrier(unsigned* bar, unsigned round, unsigned G) {
    asm volatile("s_waitcnt vmcnt(0)" ::: "memory");
    __syncthreads();
    if (threadIdx.x == 0) {
        __builtin_amdgcn_fence(__ATOMIC_RELEASE, "agent");
        asm volatile("s_waitcnt vmcnt(0)" ::: "memory");
        const unsigned g = blockIdx.x >> 4, ngroups = (G + 15u) >> 4, gsize = (G - g * 16u) < 16u ? (G - g * 16u) : 16u;
        unsigned* cnt = bar + 32u * (1u + g); unsigned* top = bar + 32u * 20u; unsigned* gen = bar + 32u * (24u + g);
        const unsigned old = __hip_atomic_fetch_add(cnt, 1u, __ATOMIC_RELAXED, __HIP_MEMORY_SCOPE_AGENT);
        if (old + 1u == round * gsize) {
            const unsigned t = __hip_atomic_fetch_add(top, 1u, __ATOMIC_RELAXED, __HIP_MEMORY_SCOPE_AGENT);
            if (t + 1u == round * ngroups) { for (unsigned q = 0; q < ngroups; ++q) __hip_atomic_store(bar + 32u * (24u + q), round, __ATOMIC_RELAXED, __HIP_MEMORY_SCOPE_AGENT); }
        }
        unsigned sp = 0u;
        while (__hip_atomic_load(gen, __ATOMIC_RELAXED, __HIP_MEMORY_SCOPE_AGENT) < round) { __builtin_amdgcn_s_sleep(1); if (++sp > (1u << 22)) break; }
        __builtin_amdgcn_fence(__ATOMIC_ACQUIRE, "agent");
        asm volatile("s_waitcnt vmcnt(0)" ::: "memory");
    }
    __syncthreads();
}

__global__ void __launch_bounds__(512, 2) hymba_fwd(Args A) {
    extern __shared__ __attribute__((aligned(16))) unsigned char lds_raw[];
    LAS unsigned char* lds = (LAS unsigned char*)lds_raw;
    cg::grid_group grid = cg::this_grid();
    const int tid = threadIdx.x, lane = tid & 63, wave = __builtin_amdgcn_readfirstlane(tid >> 6);
    const int G = gridDim.x, bx = blockIdx.x, gw = bx * 8 + wave, NGW = G * 8;
    const int lo = A.ph_lo, hi = A.ph_hi;
#define IN(k) (lo <= (k) && (k) < hi)
    unsigned* barcnt = (unsigned*)(A.ws + W_BAR); unsigned nbar = 0u;
#define SEAM(k) do { if (IN(k) && IN((k) + 1)) { ++nbar; fast_grid_barrier(barcnt, nbar, (unsigned)G); } } while (0)
    if (hi < 0) grid.sync();
    unsigned char* ws = A.ws; float* out = A.out;
    bf16_t* XN = (bf16_t*)(out + O_GDN_S);
    bf16_t* WT_IN = (bf16_t*)(out + O_RWKV_S);
    bf16_t* WT_O = (bf16_t*)(ws + W_WTO); bf16_t* WT_UP = (bf16_t*)(ws + W_WTUP); bf16_t* WT_DN = (bf16_t*)(ws + W_WTDN);
    bf16_t* PROJ = (bf16_t*)(ws + W_PROJ); bf16_t* MIXED = (bf16_t*)(ws + W_MIXED); bf16_t* XN2 = (bf16_t*)(ws + W_XN2);
    bf16_t* HB = (bf16_t*)(ws + W_H); bf16_t* ACT = (bf16_t*)(ws + W_ACT);
    float* X1 = out + O_Y; float* PART = (float*)(ws + W_PART);

    if (IN(0)) {
        LAS float* scr = (LAS float*)(lds + wave * 16384);
        constexpr int I_IN = 32 * (NINP / 64);
        for (int it = gw; it < I_IN; it += NGW) transpose_item(A.in[8], DM, NIN, WT_IN, scr, it, NINP / 64, lane);
        for (int i = bx * 512 + tid; i < 4096 * 8; i += G * 512) {
            int r = (i >> 9) * 64 + (i & 63); const int q = (i >> 6) & 7; const float* W; bf16_t* WT; int K, j0;
            if (r < 1024) { W = A.in[15]; WT = (bf16_t*)((unsigned char*)out + OB_WBT); K = 64; j0 = 0; }
            else if (r < 2048) { r -= 1024; W = A.in[17]; WT = (bf16_t*)((unsigned char*)out + OB_ABT); K = 64; j0 = 0; }
            else { r -= 2048; W = A.in[18]; WT = (bf16_t*)((unsigned char*)out + OB_GBT); K = 128; j0 = (r >> 10) * 64; r &= 1023; }
            const int ch = r;
            float f[8];
#pragma unroll
            for (int e = 0; e < 8; ++e) f[e] = W[(size_t)(j0 + q * 8 + e) * 1024 + ch];
            uint4 o; o.x = pk2(f[0], f[1]); o.y = pk2(f[2], f[3]); o.z = pk2(f[4], f[5]); o.w = pk2(f[6], f[7]);
            *(uint4*)(WT + (size_t)ch * K + j0 + q * 8) = o;
        }
        for (int m = gw; m < MTOK; m += NGW) { const float* xr = (m < MPR) ? A.in[0] + (size_t)m * DM : A.in[1] + (size_t)(m - MPR) * DM; rms_row_bf16(xr, A.in[7], XN + (size_t)m * DM, lane); }
        __syncthreads();
    }
    SEAM(0);
    if (IN(1)) {
        pg8::Gemm g{XN, WT_IN, MTOK, NINP, DM}; pg8::StaticOrder S; S.init(MTOK, NINP, DM, G, bx);
        pg8::EpiBf16P E{PROJ, NINP};
        pg8::gemm_phase<pg8::EpiBf16P, pg8::StaticOrder, true, true>(lds, g, S, E);
    }
    SEAM(1);
    if (IN(2)) { for (int tile = bx; tile < NTILES; tile += G) prep_tile(A, (LAS float*)lds, tile, tid); }
    SEAM(2);
    if (IN(3)) {
        LAS float* sl = (LAS float*)(lds + wave * 16384);
        const bf16_t* GQKV = (const bf16_t*)(ws + W_GQKV); const float* GA = (const float*)(ws + W_GAB); const float* GB = GA + MTOK * 8;
        const bf16_t* RS = (const bf16_t*)(ws + W_RS); const bf16_t* RV = (const bf16_t*)(ws + W_RV); const float* RW = (const float*)(ws + W_RW);
        float* yraw = out + O_Y;
        const bool heavy = (G == 256) && (bx >= 128);
        const int nshare = (G == 256) ? 3072 : NGW, share0 = (G == 256) ? (heavy ? 1024 + ((bx - 128) * 8 + wave) * 2 : gw) : gw, nsh = heavy ? 2 : 1;
        for (int task = gw; task < 2048; task += NGW) gdn_sample_cols(sl, GQKV, GA, GB, yraw, A.in[2], out + O_GDN_S, task, lane);
        for (int sh = 0; sh < nsh; ++sh) {
            rwkv_sample_loop(sl, RS, RV, RW, yraw, A.in[4], out + O_RWKV_S, share0 + sh, nshare, lane);
            constexpr int I_O = 32 * (DM / 64), I_UP = 32 * (DFF2 / 64), I_DN = (DFF / 64) * (DM / 64);
            for (int it = share0 + sh; it < I_O + I_UP + I_DN; it += nshare) {
                int r = it;
                if (r < I_O) { transpose_item(A.in[24], DM, DM, WT_O, sl, r, DM / 64, lane); continue; } r -= I_O;
                if (r < I_UP) { transpose_item(A.in[26], DM, DFF2, WT_UP, sl, r, DFF2 / 64, lane); continue; } r -= I_UP;
                transpose_item(A.in[28], DFF, DM, WT_DN, sl, r, DM / 64, lane);
            }
        }
        __syncthreads();
        for (int u = bx; u < 256; u += G) {
            if (u < 128) { const int bh = u >> 2, cq = u & 3;
                gdn_prompt_block((LAS float*)lds, GQKV, GA, GB, yraw, (bh >> 3) * 2048, 2048, bh & 7, cq * 32, out + O_GDN_P + (size_t)bh * 16384, tid, wave, lane); }
            else { const int uu = u - 128, bh = uu >> 1, hf = uu & 1;
                rwkv_prompt_block((LAS float*)lds, RS, RV, RW, yraw, (bh >> 4) * 2048, 2048, bh & 15, hf * 32, out + O_RWKV_P + (size_t)bh * 4096, tid, wave, lane); }
        }
        __syncthreads();
    }
    SEAM(3);
    if (IN(4)) {
        for (int tile = bx; tile < NTILES; tile += G) post_tile(A, (LAS float*)lds, tile, tid);
    }
    SEAM(4);
    if (IN(5)) {
        pg8::Gemm g{MIXED, WT_O, MTOK, DM, DM}; pg8::SplitOrder S; S.init(DM, bx);
        pg8::EpiResSplit E{A.in[0], X1, PART};
        pg8::gemm_phase<pg8::EpiResSplit, pg8::SplitOrder, true, true>(lds, g, S, E);
    }
    SEAM(5);
    if (IN(6)) {
        LAS float* scr = (LAS float*)(lds + wave * 16384);
        for (int m = gw; m < MTOK; m += NGW) {
            if (m >= MPR) { const float4* xs = (const float4*)(A.in[1] + (size_t)(m - MPR) * DM); float4* xo = (float4*)(X1 + (size_t)m * DM);
#pragma unroll
                for (int j = 0; j < 8; ++j) { float4 a = xs[lane + 64 * j];
#pragma unroll
                    for (int sg = 0; sg < 8; ++sg) { const float4 b = ((const float4*)(PART + ((size_t)sg * 1024 + (m - MPR)) * DM))[lane + 64 * j]; a.x += b.x; a.y += b.y; a.z += b.z; a.w += b.w; }
                    xo[lane + 64 * j] = a; } }
            rms_row_bf16(X1 + (size_t)m * DM, A.in[25], XN2 + (size_t)m * DM, lane);
        }
        __syncthreads();
    }
    SEAM(6);
    if (IN(7)) {
        pg8::Gemm g{XN2, WT_UP, MTOK, DFF2, DM}; pg8::StaticOrder S; S.init(MTOK, DFF2, DM, G, bx);
        pg8::EpiH E{HB, out + O_FFN_P, out + O_FFN_S};
        pg8::gemm_phase<pg8::EpiH, pg8::StaticOrder, true, true>(lds, g, S, E);
    }
    SEAM(7);
    if (IN(8)) { for (int it = gw; it < 11 * (MTOK / 9); it += NGW) act_item(A, it, lane); }
    SEAM(8);
    if (IN(9)) {
        pg8::Gemm g{ACT, WT_DN, MTOK, DM, DFF}; pg8::SplitOrder S; S.init(DFF, bx);
        pg8::EpiResSplit E{X1, X1, PART};
        pg8::gemm_phase<pg8::EpiResSplit, pg8::SplitOrder, true, true>(lds, g, S, E);
    }
    SEAM(9);
    if (IN(10)) { for (int m = gw; m < MTOK; m += NGW) {
            if (m >= MPR) { float4* xo = (float4*)(X1 + (size_t)m * DM);
#pragma unroll
                for (int j = 0; j < 8; ++j) { float4 a = xo[lane + 64 * j];
#pragma unroll
                    for (int sg = 0; sg < 8; ++sg) { const float4 b = ((const float4*)(PART + ((size_t)sg * 1024 + (m - MPR)) * DM))[lane + 64 * j]; a.x += b.x; a.y += b.y; a.z += b.z; a.w += b.w; }
                    xo[lane + 64 * j] = a; } }
            rms_row_f32_inplace(X1 + (size_t)m * DM, A.in[29], lane); } }
#undef IN
#undef SEAM
}

#ifndef N_LAUNCH_SPLIT
#define N_LAUNCH_SPLIT 0
#endif
extern "C" void kernel_launch(void* const* d_in, const int* in_sizes, int n_in, void* d_out, int out_size, void* d_ws, size_t ws_size, hipStream_t stream) {
    static int grid = 0;
    if (grid == 0) {
        int dev = 0, cus = 0, per_cu = 0;
        hipGetDevice(&dev);
        hipDeviceGetAttribute(&cus, hipDeviceAttributeMultiprocessorCount, dev);
        if (hipFuncSetAttribute((const void*)hymba_fwd, hipFuncAttributeMaxDynamicSharedMemorySize, LDS_BYTES) != hipSuccess) fprintf(stderr, "kernel_launch: hipFuncSetAttribute failed\n");
        if (hipOccupancyMaxActiveBlocksPerMultiprocessor(&per_cu, (const void*)hymba_fwd, 512, LDS_BYTES) != hipSuccess || per_cu < 1) { fprintf(stderr, "kernel_launch: occupancy query says %d\n", per_cu); per_cu = 1; }
        (void)hipGetLastError();
        grid = cus * 1;
        if (n_in != 30 || out_size != (int)O_END || ws_size < W_END4) fprintf(stderr, "kernel_launch: unexpected sizes n_in %d out %d ws %zu (need %zu)\n", n_in, out_size, ws_size, (size_t)W_END3);
    }
    if (hipMemsetAsync((char*)d_ws + W_BAR, 0, 8192, stream) != hipSuccess) fprintf(stderr, "kernel_launch: memset of the barrier word failed\n");
    Args a{};
    for (int i = 0; i < 30; ++i) a.in[i] = (const float*)d_in[i];
    a.out = (float*)d_out; a.ws = (unsigned char*)d_ws;
#if N_LAUNCH_SPLIT
    for (int p = 0; p <= 10; ++p) { a.ph_lo = p; a.ph_hi = p + 1; void* args[] = {&a};
        hipError_t e = hipLaunchCooperativeKernel((const void*)hymba_fwd, dim3(grid), dim3(512), args, LDS_BYTES, stream);
        if (e != hipSuccess) { fprintf(stderr, "kernel_launch: launch of phase %d failed: %s\n", p, hipGetErrorString(e)); break; } }
#else
    a.ph_lo = 0; a.ph_hi = 11; void* args[] = {&a};
    hipError_t e = hipLaunchCooperativeKernel((const void*)hymba_fwd, dim3(grid), dim3(512), args, LDS_BYTES, stream);
    if (e != hipSuccess) fprintf(stderr, "kernel_launch: cooperative launch failed: %s (grid %d)\n", hipGetErrorString(e), grid);
#endif
}
```

```cpp
#include <hip/hip_runtime.h>
#include <hip/hip_cooperative_groups.h>
#include <cstdio>
#include <cstdint>
namespace cg = cooperative_groups;
namespace pg8 {
#define PG8_LAS __attribute__((address_space(3)))
typedef unsigned short bf16_t;
typedef short bf16x8 __attribute__((ext_vector_type(8)));
typedef float f32x4 __attribute__((ext_vector_type(4)));
typedef unsigned u32x4 __attribute__((ext_vector_type(4)));
constexpr int BM = 256, BK = 64, HALF = 128, HTB = HALF * BK * 2  , STAGE_BYTES = 8 * HTB, NXCD = 8, WGM = 8;

__host__ __device__ __forceinline__ int lds_byte(int r, int c) { const int st = (r >> 4) * 2 + (c >> 5), rr = r & 15, cc = c & 31, ob = rr * 64 + cc * 2; return st * 1024 + (ob ^ (((ob >> 9) & 1) << 5)); }
__host__ __device__ __forceinline__ void stage_rc(int b, int& R, int& C) { const int st = b / 1024, sb = b % 1024, swz = sb ^ (((sb >> 9) & 1) << 5); R = (st >> 1) * 16 + swz / 64; C = (st & 1) * 32 + (swz % 64) / 2; }
__host__ __device__ __forceinline__ int perm32(int rho) { const int n = rho >> 4, i = rho & 15; return 8 * (i >> 2) + 4 * n + (i & 3); }

struct Unit { int pm, pn, k0, nt, seg; };
struct Gemm { const bf16_t* A; const bf16_t* Bt; int M, N, K; };

struct StaticOrder {
    int nM, nN, nwg, G, c, ntk;
    __host__ __device__ void init(int M, int N, int K, int G_, int c_) { nM = M / BM; nN = N / BM; nwg = nM * nN; G = G_; c = c_; ntk = K / BK; }
    __host__ __device__ bool next(int i, Unit& u) const {
        const long L = (long)i * G + c; if (L >= nwg) return false;
        int wgid = (int)L; { const int q = nwg / NXCD, r = nwg % NXCD, xcd = wgid % NXCD, off = wgid / NXCD; wgid = (xcd < r ? xcd * (q + 1) : r * (q + 1) + (xcd - r) * q) + off; }
        const int nig = WGM * nN, gid = wgid / nig, fm = gid * WGM, gsz = (nM - fm) < WGM ? (nM - fm) : WGM;
        u.pm = fm + ((wgid % nig) % gsz); u.pn = (wgid % nig) / gsz; u.k0 = 0; u.nt = ntk; u.seg = 0; return true;
    }
    __device__ __forceinline__ void a_ready(const Unit&) const {}
    __device__ __forceinline__ void done(const Unit&) const {}
};
__device__ __forceinline__ unsigned cvt_pk_bf16(float lo, float hi) { unsigned r; asm volatile("s_nop 1\n\tv_cvt_pk_bf16_f32 %0, %1, %2" : "=v"(r) : "v"(lo), "v"(hi)); return r; }
template <class Epi, class Sched, bool ALIGN_EPI = false, bool SP2 = false>
__device__ __forceinline__ void gemm_phase(PG8_LAS unsigned char* lds, const Gemm g, const Sched& S, const Epi& E) {
    const int tid = threadIdx.x, wid = __builtin_amdgcn_readfirstlane(tid >> 6), lane = tid & 63, wr = wid >> 2, wc = wid & 3, fr = lane & 15, fq = lane >> 4;
    const int K = g.K;
    unsigned voffA[2], voffB[2];
#pragma unroll
    for (int i = 0; i < 2; ++i) { int R, C; stage_rc(tid * 16 + i * 8192, R, C); const int Rb = Epi::PERM ? ((R & ~31) + perm32(R & 31)) : R;
        voffA[i] = (unsigned)(R * K + C) * 2u; voffB[i] = (unsigned)(Rb * K + C) * 2u; }
    const size_t kstep = (size_t)(BK * 2);
    const size_t hstep = (size_t)HALF * K * 2;
    const size_t tstep = 2 * hstep;
    const unsigned ldsw = (unsigned)wid * 1024u;
    const int aoff = lds_byte(wr * 64 + fr, fq * 8), boff = lds_byte(wc * 32 + fr, fq * 8);
#define PG8_SA(b, h) (((b) * 2 + (h)) * HTB)
#define PG8_SB(b, h) ((4 + (b) * 2 + (h)) * HTB)
#define PG8_STAGE(bufoff, gbase, voff) do { _Pragma("unroll") for (int _i = 0; _i < 2; ++_i) \
        __builtin_amdgcn_global_load_lds((const unsigned*)((const char*)(gbase) + (voff)[_i]), (PG8_LAS unsigned*)(lds + (bufoff) + ldsw + _i * 8192), 16, 0, 0); } while (0)
#define PG8_LDA(dst, b, h) do { _Pragma("unroll") for (int m = 0; m < 4; ++m) _Pragma("unroll") for (int k = 0; k < 2; ++k) dst[m][k] = *(const PG8_LAS bf16x8*)(lds + PG8_SA(b, h) + aoff + m * 2048 + k * 1024); } while (0)
#define PG8_LDB(dst, b, h) do { _Pragma("unroll") for (int n = 0; n < 2; ++n) _Pragma("unroll") for (int k = 0; k < 2; ++k) dst[n][k] = *(const PG8_LAS bf16x8*)(lds + PG8_SB(b, h) + boff + n * 2048 + k * 1024); } while (0)
#define PG8_MMA(ai, bj, At, Bt) do { __builtin_amdgcn_s_setprio(1); _Pragma("unroll") for (int m = 0; m < 4; ++m) _Pragma("unroll") for (int n = 0; n < 2; ++n) _Pragma("unroll") for (int k = 0; k < 2; ++k) \
        acc[ai][bj][m][n] = __builtin_amdgcn_mfma_f32_16x16x32_bf16(Bt[n][k], At[m][k], acc[ai][bj][m][n], 0, 0, 0); __builtin_amdgcn_s_setprio(0); } while (0)
#define PG8_WAIT_V(n) asm volatile("s_waitcnt vmcnt(" #n ")" ::: "memory")
#define PG8_WAIT_L(n) asm volatile("s_waitcnt lgkmcnt(" #n ")" ::: "memory")
#define PG8_BAR __builtin_amdgcn_s_barrier()
#define PG8_SCHED __builtin_amdgcn_sched_barrier(0)
    Unit cur, nxt; int ui = 0;
    if (!S.next(0, cur)) return;
    f32x4 acc[2][2][4][2];
#pragma unroll
    for (int a = 0; a < 2; ++a)
#pragma unroll
        for (int b = 0; b < 2; ++b)
#pragma unroll
            for (int m = 0; m < 4; ++m)
#pragma unroll
                for (int n = 0; n < 2; ++n) acc[a][b][m][n] = (f32x4){0.f, 0.f, 0.f, 0.f};
    bf16x8 At[4][2], B0[2][2], B1[2][2];
    const char* cA = (const char*)g.A + (size_t)cur.pm * tstep + (size_t)cur.k0 * kstep; const char* cB = (const char*)g.Bt + (size_t)cur.pn * tstep + (size_t)cur.k0 * kstep;
    S.a_ready(cur);
    if constexpr (SP2) {
        PG8_STAGE(PG8_SB(0, 0), cB, voffB); PG8_STAGE(PG8_SB(0, 1), cB + hstep, voffB); PG8_STAGE(PG8_SA(0, 0), cA, voffA); PG8_STAGE(PG8_SA(0, 1), cA + hstep, voffA);
        if (wr == 1) PG8_BAR;
        PG8_WAIT_V(2); PG8_BAR;
        PG8_STAGE(PG8_SB(1, 0), cB + kstep, voffB); PG8_STAGE(PG8_SA(1, 0), cA + kstep, voffA); PG8_STAGE(PG8_SB(1, 1), cB + hstep + kstep, voffB);
        PG8_WAIT_V(6); PG8_BAR;
    } else {
        PG8_STAGE(PG8_SB(0, 0), cB, voffB); PG8_STAGE(PG8_SA(0, 0), cA, voffA); PG8_STAGE(PG8_SB(0, 1), cB + hstep, voffB); PG8_STAGE(PG8_SA(0, 1), cA + hstep, voffA);
        if (wr == 1) PG8_BAR;
        PG8_WAIT_V(4); PG8_BAR;
        PG8_STAGE(PG8_SB(1, 0), cB + kstep, voffB); PG8_STAGE(PG8_SA(1, 0), cA + kstep, voffA); PG8_STAGE(PG8_SB(1, 1), cB + hstep + kstep, voffB);
        PG8_WAIT_V(6); PG8_BAR;
    }
    for (;;) {
        const bool has_next = S.next(ui + 1, nxt);
        const char* nA = has_next ? (const char*)g.A + (size_t)nxt.pm * tstep + (size_t)nxt.k0 * kstep : cA; const char* nB = has_next ? (const char*)g.Bt + (size_t)nxt.pn * tstep + (size_t)nxt.k0 * kstep : cB;
        const int nt = cur.nt;
        for (int t = 0; t < nt; t += 2) {
            const bool last = (t == nt - 2);
            const char* a1 = cA + (size_t)(t + 1) * kstep;
            const char* a2 = last ? nA : cA + (size_t)(t + 2) * kstep; const char* b2 = last ? nB : cB + (size_t)(t + 2) * kstep;
            const char* a3 = a2 + kstep; const char* b3 = b2 + kstep;
            if (last && has_next) S.a_ready(nxt);
            if constexpr (SP2) {
            PG8_LDB(B0, 0, 0); PG8_LDB(B1, 0, 1); PG8_SCHED; PG8_LDA(At, 0, 0); PG8_STAGE(PG8_SA(1, 1), a1 + hstep, voffA);
            PG8_WAIT_V(8); PG8_WAIT_L(0); PG8_BAR; PG8_MMA(0, 0, At, B0); PG8_MMA(0, 1, At, B1); PG8_BAR; PG8_SCHED;
            PG8_LDA(At, 0, 1); PG8_STAGE(PG8_SB(0, 0), b2, voffB); PG8_STAGE(PG8_SB(0, 1), b2 + hstep, voffB); PG8_STAGE(PG8_SA(0, 0), a2, voffA);
            PG8_WAIT_V(8); PG8_WAIT_L(0); PG8_BAR; PG8_MMA(1, 0, At, B0); PG8_MMA(1, 1, At, B1); PG8_BAR; PG8_SCHED;
            PG8_LDB(B0, 1, 0); PG8_LDB(B1, 1, 1); PG8_SCHED; PG8_LDA(At, 1, 0); PG8_STAGE(PG8_SA(0, 1), a2 + hstep, voffA);
            PG8_WAIT_V(8); PG8_WAIT_L(0); PG8_BAR; PG8_MMA(0, 0, At, B0); PG8_MMA(0, 1, At, B1); PG8_BAR; PG8_SCHED;
            PG8_LDA(At, 1, 1); PG8_STAGE(PG8_SB(1, 0), b3, voffB); PG8_STAGE(PG8_SB(1, 1), b3 + hstep, voffB); PG8_STAGE(PG8_SA(1, 0), a3, voffA);
            PG8_WAIT_V(8); PG8_WAIT_L(0); PG8_BAR; PG8_MMA(1, 0, At, B0); PG8_MMA(1, 1, At, B1); PG8_BAR; PG8_SCHED;
            } else {
            PG8_LDB(B0, 0, 0); PG8_SCHED; PG8_LDA(At, 0, 0); PG8_STAGE(PG8_SA(1, 1), a1 + hstep, voffA);
            PG8_WAIT_L(8); PG8_BAR; PG8_WAIT_L(0); PG8_MMA(0, 0, At, B0); PG8_BAR; PG8_SCHED;
            PG8_LDB(B1, 0, 1); PG8_STAGE(PG8_SB(0, 0), b2, voffB);
            PG8_BAR; PG8_WAIT_L(0); PG8_MMA(0, 1, At, B1); PG8_BAR;
            PG8_LDA(At, 0, 1); PG8_STAGE(PG8_SA(0, 0), a2, voffA);
            PG8_BAR; PG8_WAIT_L(0); PG8_MMA(1, 0, At, B0); PG8_BAR; PG8_SCHED;
            PG8_STAGE(PG8_SB(0, 1), b2 + hstep, voffB);
            PG8_WAIT_V(6); PG8_BAR; PG8_MMA(1, 1, At, B1); PG8_BAR;
            PG8_LDB(B0, 1, 0); PG8_SCHED; PG8_LDA(At, 1, 0); PG8_STAGE(PG8_SA(0, 1), a2 + hstep, voffA);
            PG8_WAIT_L(8); PG8_BAR; PG8_WAIT_L(0); PG8_MMA(0, 0, At, B0); PG8_BAR; PG8_SCHED;
            PG8_LDB(B1, 1, 1); PG8_STAGE(PG8_SB(1, 0), b3, voffB);
            PG8_BAR; PG8_WAIT_L(0); PG8_MMA(0, 1, At, B1); PG8_BAR;
            PG8_LDA(At, 1, 1); PG8_STAGE(PG8_SA(1, 0), a3, voffA);
            PG8_BAR; PG8_WAIT_L(0); PG8_MMA(1, 0, At, B0); PG8_BAR; PG8_SCHED;
            PG8_STAGE(PG8_SB(1, 1), b3 + hstep, voffB);
            PG8_WAIT_V(6); PG8_BAR; PG8_MMA(1, 1, At, B1); PG8_BAR;
            }
        }
        if constexpr (ALIGN_EPI) { if (wr == 0) PG8_BAR; }
        if constexpr (!Epi::AFTER_DRAIN) { E(acc, cur, wr, wc, fr, fq); S.done(cur); }
        if (!has_next) break;
#pragma unroll
        for (int a = 0; a < 2; ++a)
#pragma unroll
            for (int b = 0; b < 2; ++b)
#pragma unroll
                for (int m = 0; m < 4; ++m)
#pragma unroll
                    for (int n = 0; n < 2; ++n) acc[a][b][m][n] = (f32x4){0.f, 0.f, 0.f, 0.f};
        cur = nxt; cA = nA; cB = nB; ++ui;
        if constexpr (ALIGN_EPI) { if (wr == 1) PG8_BAR; }
    }
    PG8_WAIT_V(0);
    if constexpr (!ALIGN_EPI) { if (wr == 0) PG8_BAR; }
    PG8_BAR;
    if constexpr (Epi::AFTER_DRAIN) { E.fused(acc, cur, wr, wc, fr, fq, lds, wid, lane); S.done(cur); }
#undef PG8_SA
#undef PG8_SB
#undef PG8_STAGE
#undef PG8_LDA
#undef PG8_LDB
#undef PG8_MMA
#undef PG8_WAIT_V
#undef PG8_WAIT_L
#undef PG8_BAR
#undef PG8_SCHED
}
}

namespace pg8 {
struct EpiBf16P {
    static constexpr bool PERM = true, AFTER_DRAIN = false;
    bf16_t* O; int ldc;
    __device__ __forceinline__ void operator()(const f32x4 (&acc)[2][2][4][2], const Unit& u, int wr, int wc, int fr, int fq) const {
        const int row0 = u.pm * BM + wr * 64 + fr, col0 = u.pn * BM + wc * 32 + 8 * fq;
#pragma unroll
        for (int ai = 0; ai < 2; ++ai)
#pragma unroll
            for (int m = 0; m < 4; ++m) { bf16_t* rowp = O + (size_t)(row0 + ai * HALF + m * 16) * ldc + col0;
#pragma unroll
                for (int bj = 0; bj < 2; ++bj) { const f32x4 v0 = acc[ai][bj][m][0], v1 = acc[ai][bj][m][1];
                    u32x4 w; w.x = cvt_pk_bf16(v0[0], v0[1]); w.y = cvt_pk_bf16(v0[2], v0[3]); w.z = cvt_pk_bf16(v1[0], v1[1]); w.w = cvt_pk_bf16(v1[2], v1[3]);
                    *(u32x4*)(rowp + bj * HALF) = w; } }
    }
};
struct EpiH {
    static constexpr bool PERM = true, AFTER_DRAIN = false;
    bf16_t* O; float* ffn_p; float* ffn_s;
    __device__ __forceinline__ void operator()(const f32x4 (&acc)[2][2][4][2], const Unit& u, int wr, int wc, int fr, int fq) const {
        const int row0 = u.pm * BM + wr * 64 + fr, col0 = u.pn * BM + wc * 32 + 8 * fq;
#pragma unroll
        for (int ai = 0; ai < 2; ++ai)
#pragma unroll
            for (int m = 0; m < 4; ++m) { const int row = row0 + ai * HALF + m * 16; bf16_t* rowp = O + (size_t)row * 11264 + col0;
                float* tail = nullptr;
                if (row < 8192) { const int t = row & 2047; if (t >= 2046) tail = ffn_p + (size_t)((row >> 11) * 2 + (t - 2046)) * 11264 + col0; }
                else { const int r = row - 8192, t = r & 7; if (t >= 6) tail = ffn_s + (size_t)((r >> 3) * 2 + (t - 6)) * 11264 + col0; }
#pragma unroll
                for (int bj = 0; bj < 2; ++bj) { const f32x4 v0 = acc[ai][bj][m][0], v1 = acc[ai][bj][m][1];
                    u32x4 w; w.x = cvt_pk_bf16(v0[0], v0[1]); w.y = cvt_pk_bf16(v0[2], v0[3]); w.z = cvt_pk_bf16(v1[0], v1[1]); w.w = cvt_pk_bf16(v1[2], v1[3]);
                    *(u32x4*)(rowp + bj * HALF) = w;
                    if (tail) { *(f32x4*)(tail + bj * HALF) = v0; *(f32x4*)(tail + bj * HALF + 4) = v1; } } }
    }
};
struct EpiRes {
    static constexpr bool PERM = false, AFTER_DRAIN = false;
    const float* base_p; const float* base_s; float* out;
    __device__ __forceinline__ void operator()(const f32x4 (&acc)[2][2][4][2], const Unit& u, int wr, int wc, int fr, int fq) const {
        const int row0 = u.pm * BM + wr * 64 + fr, col0 = u.pn * BM + wc * 32 + 4 * fq;
        const float* base = (u.pm < 32) ? base_p : (base_s - (size_t)8192 * 2048);
#pragma unroll
        for (int ai = 0; ai < 2; ++ai)
#pragma unroll
            for (int m = 0; m < 4; ++m) { const size_t off = (size_t)(row0 + ai * HALF + m * 16) * 2048 + col0;
#pragma unroll
                for (int bj = 0; bj < 2; ++bj)
#pragma unroll
                    for (int n = 0; n < 2; ++n) { const f32x4 bs = *(const f32x4*)(base + off + bj * HALF + n * 16); *(f32x4*)(out + off + bj * HALF + n * 16) = bs + acc[ai][bj][m][n]; }
                asm volatile("" ::: "memory"); }
    }
};
struct SplitOrder {
    int c, ntk;
    __device__ void init(int K, int c_) { c = c_; ntk = K / BK; }
    __device__ bool next(int i, Unit& u) const {
        if (i == 0) { const int xcd = c & 7, j = c >> 3; u.pm = xcd * 4 + (j >> 3); u.pn = j & 7; u.k0 = 0; u.nt = ntk; u.seg = 0; return true; }
        if (i == 1) { const int uu = c >> 3, seg = c & 7, P = ntk >> 1, p0 = (seg * P) >> 3, p1 = ((seg + 1) * P) >> 3; u.pm = 32 + (uu >> 3); u.pn = uu & 7; u.k0 = 2 * p0; u.nt = 2 * (p1 - p0); u.seg = seg; return true; }
        return false;
    }
    __device__ __forceinline__ void a_ready(const Unit&) const {}
    __device__ __forceinline__ void done(const Unit&) const {}
};
struct EpiResSplit {
    static constexpr bool PERM = false, AFTER_DRAIN = false;
    const float* base_p; float* out_p; float* acc_s;
    __device__ __forceinline__ void operator()(const f32x4 (&acc)[2][2][4][2], const Unit& u, int wr, int wc, int fr, int fq) const {
        const int row0 = u.pm * BM + wr * 64 + fr, col0 = u.pn * BM + wc * 32 + 4 * fq;
        if (u.pm < 32) {
#pragma unroll
            for (int ai = 0; ai < 2; ++ai)
#pragma unroll
                for (int m = 0; m < 4; ++m) { const size_t off = (size_t)(row0 + ai * HALF + m * 16) * 2048 + col0;
#pragma unroll
                    for (int bj = 0; bj < 2; ++bj)
#pragma unroll
                        for (int n = 0; n < 2; ++n) { const f32x4 bs = *(const f32x4*)(base_p + off + bj * HALF + n * 16); *(f32x4*)(out_p + off + bj * HALF + n * 16) = bs + acc[ai][bj][m][n]; }
                    asm volatile("" ::: "memory"); }
        } else {
#pragma unroll
            for (int ai = 0; ai < 2; ++ai)
#pragma unroll
                for (int m = 0; m < 4; ++m) { float* p = acc_s + ((size_t)u.seg * 1024 + (size_t)(row0 - 8192 + ai * HALF + m * 16)) * 2048 + col0;
#pragma unroll
                    for (int bj = 0; bj < 2; ++bj)
#pragma unroll
                        for (int n = 0; n < 2; ++n) *(f32x4*)(p + bj * HALF + n * 16) = acc[ai][bj][m][n]; }
        }
    }
};
}

#define LAS __attribute__((address_space(3)))
typedef unsigned short bf16_t;
typedef float f32x4v __attribute__((ext_vector_type(4)));
typedef float f32x2v __attribute__((ext_vector_type(2)));
constexpr int MTOK = 9216, MPR = 8192, DM = 2048, NIN = 7440, NINP = 7680, DFF = 5632, DFF2 = 11264, RPROJ = 3328, OFFR = 4112;
constexpr int TT = 12, NTILES = MTOK / TT;
constexpr int LDS_BYTES = 131072;
constexpr size_t O_Y = 0, O_GDN_P = 18874368, O_GCONV_P = 19398656, O_RWKV_P = 19435520, O_SHIFT_P = 19697664, O_FFN_P = 19710976,
                 O_GDN_S = 19801088, O_GCONV_S = 36578304, O_RWKV_S = 37757952, O_SHIFT_S = 46146560, O_FFN_S = 46572544, O_END = 49456128;
constexpr size_t W_WTUP = 0, W_WTO = 46137344, W_PROJ = 54525952, W_GQKV = 196083712, W_GAB = 252706816, W_RS = 253296640, W_RV = 328794112, W_RW = 347668480, W_END1 = 385417216;
constexpr size_t W_PART = W_PROJ;
constexpr size_t W_MIXED = W_GQKV, W_H = W_WTO, W_WTDN = W_END1, W_ACT = W_H + (size_t)MTOK * DFF2 * 2 + (size_t)DM * DFF * 2, W_XN2 = W_ACT, W_END2 = W_ACT + (size_t)MTOK * DFF * 2, W_END3 = W_WTDN + (size_t)DM * DFF * 2;
static_assert(W_END2 <= W_END1 + 0, "late-phase overlay must fit");
static_assert(W_END3 == 408485888 && W_END2 == 380633088, "layout");
constexpr size_t W_BAR = W_END3, W_END4 = W_BAR + 8192;
constexpr size_t OB_WBT = O_FFN_S * 4, OB_ABT = OB_WBT + 1024 * 64 * 2, OB_GBT = OB_ABT + 1024 * 64 * 2;

struct Args { const float* in[30]; float* out; unsigned char* ws; int ph_lo, ph_hi; };

__device__ __forceinline__ float bf_lo(unsigned w) { return __uint_as_float(w << 16); }
__device__ __forceinline__ float bf_hi(unsigned w) { return __uint_as_float(w & 0xffff0000u); }
__device__ __forceinline__ unsigned pk2(float lo, float hi) { return pg8::cvt_pk_bf16(lo, hi); }
__device__ __forceinline__ unsigned pk2_safe(float lo, float hi) { unsigned r; asm volatile("s_nop 4\n\tv_cvt_pk_bf16_f32 %0, %1, %2" : "=v"(r) : "v"(lo), "v"(hi)); return r; }
__device__ __forceinline__ void unpack8(const uint4 w, float (&f)[8]) { f[0] = bf_lo(w.x); f[1] = bf_hi(w.x); f[2] = bf_lo(w.y); f[3] = bf_hi(w.y); f[4] = bf_lo(w.z); f[5] = bf_hi(w.z); f[6] = bf_lo(w.w); f[7] = bf_hi(w.w); }
__device__ __forceinline__ float wave_sum(float v) {
#pragma unroll
    for (int o = 1; o < 64; o <<= 1) v += __shfl_xor(v, o);
    return v;
}
__device__ __forceinline__ float half_sum32(float v) {
#pragma unroll
    for (int o = 1; o < 32; o <<= 1) v += __shfl_xor(v, o);
    return v;
}
__device__ __forceinline__ float sum16(float v) {
#pragma unroll
    for (int o = 1; o < 16; o <<= 1) v += __shfl_xor(v, o);
    return v;
}
template <int CTRL> __device__ __forceinline__ float dppf(float v) { return __int_as_float(__builtin_amdgcn_update_dpp(0, __float_as_int(v), CTRL, 0xF, 0xF, true)); }
__device__ __forceinline__ float reduce8(float v) {
    v += dppf<0xB1>(v);
    v += dppf<0x4E>(v);
    v += dppf<0x141>(v);
    return v;
}
__device__ __forceinline__ float sigmoidf_(float x) { return __builtin_amdgcn_rcpf(1.0f + __expf(-x)); }
__device__ __forceinline__ float siluf_(float x) { return x * __builtin_amdgcn_rcpf(1.0f + __expf(-x)); }
__device__ __forceinline__ float softplusf_(float x) { return fmaxf(x, 0.f) + __logf(1.0f + __expf(-fabsf(x))); }
__device__ __forceinline__ float tanhf_(float x) { const float e = __expf(-2.0f * fabsf(x)); const float r = (1.0f - e) * __builtin_amdgcn_rcpf(1.0f + e); return x < 0.f ? -r : r; }
__device__ __forceinline__ void rowinfo(int row, int& grp, int& b, int& t, int& T) {
    if (row < MPR) { grp = 0; b = row >> 11; t = row & 2047; T = 2048; } else { const int r = row - MPR; grp = 1; b = r >> 3; t = r & 7; T = 8; }
}
#define LDS_WAIT() asm volatile("s_waitcnt lgkmcnt(0)" ::: "memory")

__device__ __forceinline__ void transpose_item(const float* __restrict__ W, int K, int N, bf16_t* __restrict__ WT, LAS float* scr, int item, int nblk, int lane) {
    const int kb = item / nblk, nb = item - kb * nblk, k0 = 64 * kb, n0 = 64 * nb;
    const int r4 = lane >> 4, c4 = (lane & 15) * 4, n_in = n0 + c4;
    float4 v[16];
#pragma unroll
    for (int i = 0; i < 16; ++i) v[i] = (n_in < N) ? *(const float4*)(W + (size_t)(k0 + 4 * i + r4) * N + n_in) : make_float4(0.f, 0.f, 0.f, 0.f);
#pragma unroll
    for (int i = 0; i < 16; ++i) { const int k = 4 * i + r4; *(LAS f32x4v*)(scr + k * 64 + (c4 ^ (8 * ((k >> 3) & 7)))) = (f32x4v){v[i].x, v[i].y, v[i].z, v[i].w}; }
    LDS_WAIT();
    const int c = lane & 7;
#pragma unroll
    for (int j = 0; j < 8; ++j) { const int n = (lane >> 3) + 8 * j; const LAS float* sp = scr + (8 * c) * 64 + (n ^ (8 * c));
        uint4 o; o.x = pk2(sp[0], sp[64]); o.y = pk2(sp[128], sp[192]); o.z = pk2(sp[256], sp[320]); o.w = pk2(sp[384], sp[448]);
        *(uint4*)(WT + (size_t)(n0 + n) * K + k0 + 8 * c) = o; }
    LDS_WAIT();
}
__device__ __forceinline__ void rms_row_bf16(const float* __restrict__ xrow, const float* __restrict__ g, bf16_t* __restrict__ orow, int lane) {
    float4 v[8]; float ss = 0.f;
#pragma unroll
    for (int j = 0; j < 8; ++j) { v[j] = ((const float4*)xrow)[lane + 64 * j]; ss += (v[j].x * v[j].x + v[j].y * v[j].y) + (v[j].z * v[j].z + v[j].w * v[j].w); }
    const float rs = rsqrtf(wave_sum(ss) * (1.0f / DM) + 1e-6f);
#pragma unroll
    for (int j = 0; j < 8; ++j) { const float4 gg = ((const float4*)g)[lane + 64 * j];
        uint2 o; o.x = pk2(v[j].x * rs * gg.x, v[j].y * rs * gg.y); o.y = pk2(v[j].z * rs * gg.z, v[j].w * rs * gg.w);
        ((uint2*)orow)[lane + 64 * j] = o; }
}
__device__ __forceinline__ void rms_row_f32_inplace(float* xrow, const float* __restrict__ g, int lane) {
    float4 v[8]; float ss = 0.f;
#pragma unroll
    for (int j = 0; j < 8; ++j) { v[j] = ((const float4*)xrow)[lane + 64 * j]; ss += (v[j].x * v[j].x + v[j].y * v[j].y) + (v[j].z * v[j].z + v[j].w * v[j].w); }
    const float rs = rsqrtf(wave_sum(ss) * (1.0f / DM) + 1e-6f);
#pragma unroll
    for (int j = 0; j < 8; ++j) { const float4 gg = ((const float4*)g)[lane + 64 * j];
        float4 o; o.x = v[j].x * rs * gg.x; o.y = v[j].y * rs * gg.y; o.z = v[j].z * rs * gg.z; o.w = v[j].w * rs * gg.w;
        ((float4*)xrow)[lane + 64 * j] = o; }
}

__device__ __forceinline__ void prep_tile(const Args& A, LAS float* lw, int tile, int tid) {
    const bf16_t* PROJ = (const bf16_t*)(A.ws + W_PROJ);
    bf16_t* GQKV = (bf16_t*)(A.ws + W_GQKV); float* GA = (float*)(A.ws + W_GAB); float* GB = GA + MTOK * 8;
    bf16_t* RS = (bf16_t*)(A.ws + W_RS); bf16_t* RV = (bf16_t*)(A.ws + W_RV); float* RW = (float*)(A.ws + W_RW);
    const float* st_gconv = A.in[3]; const float* st_shift = A.in[5];
    const int row_base = tile * TT;
    const int c0 = tid * 2;
    unsigned pw[TT + 1][3];
#pragma unroll
    for (int i = 0; i < TT + 1; ++i) { int r = row_base - 1 + i; r = r < 0 ? 0 : r; const bf16_t* pr = PROJ + (size_t)r * NINP + OFFR + c0;
        pw[i][0] = *(const unsigned*)pr; pw[i][1] = *(const unsigned*)(pr + 1024); pw[i][2] = *(const unsigned*)(pr + 2048); }
    uint4 xr[TT + 3];
    { const int chx = (tid < 384 ? tid : 383) * 8;
#pragma unroll
      for (int i = 0; i < TT + 3; ++i) { int r = row_base - 3 + i; r = r < 0 ? 0 : r; xr[i] = *(const uint4*)(PROJ + (size_t)r * NINP + chx); } }
    {
        if (tid < 4 * 68) ((LAS unsigned*)lw)[TT * 68 + tid] = 0u;
        const float* mu = A.in[13];
#pragma unroll
        for (int i = 0; i < 2; ++i) { const int item = tid + 512 * i; if (item < TT * 64) { const int tk = item >> 6, jp = item & 63, row = row_base + tk; int grp, b, t, T; rowinfo(row, grp, b, t, T);
            const int col = 3072 + 2 * jp; const unsigned pw_ = *(const unsigned*)(PROJ + (size_t)row * NINP + OFFR + col);
            float q0, q1; if (t > 0) { const unsigned qw = *(const unsigned*)(PROJ + (size_t)(row - 1) * NINP + OFFR + col); q0 = bf_lo(qw); q1 = bf_hi(qw); }
            else if (grp) { const float2 sq = *(const float2*)(st_shift + (size_t)b * RPROJ + col); q0 = sq.x; q1 = sq.y; } else { q0 = 0.f; q1 = 0.f; }
            const float2 m2 = *(const float2*)(mu + col); const float p0 = bf_lo(pw_), p1 = bf_hi(pw_);
            float x0 = p0 + (q0 - p0) * m2.x, x1 = p1 + (q1 - p1) * m2.y;
            if (jp < 32) { x0 = tanhf_(x0); x1 = tanhf_(x1); }
            ((LAS unsigned*)lw)[tk * 68 + jp] = pk2_safe(x0, x1); } }
    }
    if (tid < 384) {
        const int ch = tid * 8, stream = tid >> 7;
        const float* cwp = A.in[9];
        float cw[4][8];
#pragma unroll
        for (int i = 0; i < 4; ++i) { const float4 a0 = *(const float4*)(cwp + i * 3072 + ch), a1 = *(const float4*)(cwp + i * 3072 + ch + 4);
            cw[i][0] = a0.x; cw[i][1] = a0.y; cw[i][2] = a0.z; cw[i][3] = a0.w; cw[i][4] = a1.x; cw[i][5] = a1.y; cw[i][6] = a1.z; cw[i][7] = a1.w; }
#pragma unroll
        for (int tk = 0; tk < TT; ++tk) {
            const int row = row_base + tk; int grp, b, t, T; rowinfo(row, grp, b, t, T);
            float y[8], xl[8];
#pragma unroll
            for (int e = 0; e < 8; ++e) y[e] = 0.f;
#pragma unroll
            for (int i = 0; i < 4; ++i) { const int tt = t - 3 + i; float x[8];
                if (tt >= 0) { unpack8(xr[tk + i], x); }
                else if (grp) { const float* sp = st_gconv + ((size_t)b * 3 + (t + i)) * 3072 + ch; const float4 a0 = *(const float4*)sp, a1 = *(const float4*)(sp + 4);
                    x[0] = a0.x; x[1] = a0.y; x[2] = a0.z; x[3] = a0.w; x[4] = a1.x; x[5] = a1.y; x[6] = a1.z; x[7] = a1.w; }
                else {
#pragma unroll
                    for (int e = 0; e < 8; ++e) x[e] = 0.f; }
#pragma unroll
                for (int e = 0; e < 8; ++e) { y[e] += cw[i][e] * x[e]; if (i == 3) xl[e] = x[e]; } }
            float ss = 0.f;
#pragma unroll
            for (int e = 0; e < 8; ++e) { y[e] = siluf_(y[e]); ss += y[e] * y[e]; }
            if (stream < 2) { ss = sum16(ss); const float sc = rsqrtf(ss + 1e-12f) * (stream == 0 ? 0.08838834764831845f : 1.0f);
#pragma unroll
                for (int e = 0; e < 8; ++e) y[e] *= sc; }
            uint4 o; o.x = pk2(y[0], y[1]); o.y = pk2(y[2], y[3]); o.z = pk2(y[4], y[5]); o.w = pk2(y[6], y[7]);
            *(uint4*)(GQKV + (size_t)row * 3072 + ch) = o;
            if (t >= T - 3) { float* gp = A.out + (grp ? O_GCONV_S : O_GCONV_P) + ((size_t)b * 3 + (t - (T - 3))) * 3072 + ch;
                *(float4*)gp = make_float4(xl[0], xl[1], xl[2], xl[3]); *(float4*)(gp + 4) = make_float4(xl[4], xl[5], xl[6], xl[7]); }
        }
    } else if (tid < 384 + TT * 8) {
        const int idx = tid - 384, tk = idx >> 3, h = idx & 7, row = row_base + tk;
        const float pb = bf_lo((unsigned)PROJ[(size_t)row * NINP + 4096 + h]), pa = bf_lo((unsigned)PROJ[(size_t)row * NINP + 4104 + h]);
        const float g = -__expf(A.in[10][h]) * softplusf_(pa + A.in[11][h]);
        GA[(size_t)row * 8 + h] = __expf(g); GB[(size_t)row * 8 + h] = sigmoidf_(pb);
    }
    __syncthreads();
    {
        const int wv_ = __builtin_amdgcn_readfirstlane(tid >> 6), ti = tid & 15, quad = (tid & 63) >> 4;
        LAS float* AWL = lw + 2048; LAS float* AAL = lw + 2048 + 13364;
        const LAS unsigned char* lb = (const LAS unsigned char*)lw + ti * 272 + quad * 16;
        pg8::bf16x8 bop[4];
#pragma unroll
        for (int ks = 0; ks < 4; ++ks) bop[ks] = *(const LAS pg8::bf16x8*)(lb + ks * 64);
#pragma unroll
        for (int which = 0; which < 2; ++which) {
            const bf16_t* WT = (const bf16_t*)((const unsigned char*)A.out + (which == 0 ? OB_WBT : OB_ABT)) + (size_t)(wv_ * 128 + ti) * 64 + quad * 8;
            const float* bias = A.in[which == 0 ? 14 : 16] + wv_ * 128 + quad * 4;
            LAS float* dst = (which == 0 ? AWL : AAL) + (ti < TT ? ti : TT) * 1028 + wv_ * 128 + quad * 4;
            pg8::bf16x8 aop[8][2];
#pragma unroll
            for (int t = 0; t < 8; ++t) { aop[t][0] = *(const pg8::bf16x8*)(WT + (size_t)t * 16 * 64); aop[t][1] = *(const pg8::bf16x8*)(WT + (size_t)t * 16 * 64 + 32); }
#pragma unroll
            for (int t = 0; t < 8; ++t) {
                pg8::f32x4 c = *(const pg8::f32x4*)(bias + t * 16);
                c = __builtin_amdgcn_mfma_f32_16x16x32_bf16(aop[t][0], bop[which * 2], c, 0, 0, 0);
                c = __builtin_amdgcn_mfma_f32_16x16x32_bf16(aop[t][1], bop[which * 2 + 1], c, 0, 0, 0);
                *(LAS f32x4v*)(dst + t * 16) = (f32x4v){c[0], c[1], c[2], c[3]};
            }
        }
    }
    __syncthreads();
    f32x2v aw[TT], aa[TT];
#pragma unroll
    for (int tk = 0; tk < TT; ++tk) { aw[tk] = *(const LAS f32x2v*)(lw + 2048 + tk * 1028 + c0); aa[tk] = *(const LAS f32x2v*)(lw + 2048 + 13364 + tk * 1028 + c0); }
    {
        const float* mu = A.in[13];
        const float2 mur = *(const float2*)(mu + c0), muk = *(const float2*)(mu + 1024 + c0), muv = *(const float2*)(mu + 2048 + c0);
        const float2 kkw = *(const float2*)(A.in[19] + c0), kaw = *(const float2*)(A.in[20] + c0);
#pragma unroll
        for (int tk = 0; tk < TT; ++tk) {
            const int row = row_base + tk; int grp, b, t, T; rowinfo(row, grp, b, t, T);
            const unsigned wr_ = pw[tk + 1][0], wk_ = pw[tk + 1][1], wv_ = pw[tk + 1][2];
            float r0 = bf_lo(wr_), r1 = bf_hi(wr_), k0 = bf_lo(wk_), k1 = bf_hi(wk_), v0 = bf_lo(wv_), v1 = bf_hi(wv_);
            float pr0, pr1, pk0, pk1, pv0, pv1;
            if (t > 0) { const unsigned a_ = pw[tk][0], b_ = pw[tk][1], c_ = pw[tk][2];
                pr0 = bf_lo(a_); pr1 = bf_hi(a_); pk0 = bf_lo(b_); pk1 = bf_hi(b_); pv0 = bf_lo(c_); pv1 = bf_hi(c_); }
            else if (grp) { const float* sp = st_shift + (size_t)b * RPROJ + c0; const float2 a_ = *(const float2*)sp, b_ = *(const float2*)(sp + 1024), c_ = *(const float2*)(sp + 2048);
                pr0 = a_.x; pr1 = a_.y; pk0 = b_.x; pk1 = b_.y; pv0 = c_.x; pv1 = c_.y; }
            else { pr0 = pr1 = pk0 = pk1 = pv0 = pv1 = 0.f; }
            r0 += (pr0 - r0) * mur.x; r1 += (pr1 - r1) * mur.y; k0 += (pk0 - k0) * muk.x; k1 += (pk1 - k1) * muk.y; v0 += (pv0 - v0) * muv.x; v1 += (pv1 - v1) * muv.y;
            const float w0_ = -softplusf_(-aw[tk].x) - 0.5f, w1_ = -softplusf_(-aw[tk].y) - 0.5f;
            const float d0 = __expf(-__expf(w0_)), d1 = __expf(-__expf(w1_));
            const float a0_ = sigmoidf_(aa[tk].x), a1_ = sigmoidf_(aa[tk].y);
            float q0 = k0 * kkw.x, q1 = k1 * kkw.y;
            const float inv = rsqrtf(half_sum32(q0 * q0 + q1 * q1) + 1e-12f);
            q0 *= inv; q1 *= inv;
            const float kp0 = k0 * (1.0f + (a0_ - 1.0f) * kaw.x), kp1 = k1 * (1.0f + (a1_ - 1.0f) * kaw.y);
            bf16_t* rs = RS + (size_t)row * 4096 + c0;
            *(unsigned*)rs = pk2(q0, q1); *(unsigned*)(rs + 1024) = pk2(q0 * a0_, q1 * a1_); *(unsigned*)(rs + 2048) = pk2(kp0, kp1); *(unsigned*)(rs + 3072) = pk2(r0, r1);
            *(unsigned*)(RV + (size_t)row * 1024 + c0) = pk2(v0, v1);
            *(float2*)(RW + (size_t)row * 1024 + c0) = make_float2(d0, d1);
        }
    }
    for (int tk = 0; tk < TT; ++tk) { const int row = row_base + tk; int grp, b, t, T; rowinfo(row, grp, b, t, T);
        if (t == T - 1) { float* sp = A.out + (grp ? O_SHIFT_S : O_SHIFT_P) + (size_t)b * RPROJ;
            for (int j = tid; j < RPROJ; j += 512) sp[j] = bf_lo((unsigned)PROJ[(size_t)row * NINP + OFFR + j]); } }
    __syncthreads();
}

constexpr int SCAN_LDS_PER_WAVE = 10752;
__device__ __forceinline__ void rwkv_sample_loop(LAS float* sl, const bf16_t* __restrict__ RS, const bf16_t* __restrict__ RV, const float* __restrict__ RW, float* __restrict__ yraw,
                                                 const float* __restrict__ st_in, float* __restrict__ st_out, int task0, int stride, int lane) {
    if (task0 >= 16384) return;
    const int part = lane & 7, rr = lane >> 3;
    LAS float* SB = sl; LAS float* WB = sl + 2048; LAS float* VB = sl + 2560;
    float4 nS0, nS1; uint4 nst[4]; float4 nsw[2]; uint4 nsv = make_uint4(0, 0, 0, 0);
#define RWS_LOAD(task_) do { const int bh_ = (task_) >> 3, v0_ = ((task_) & 7) * 8, h_ = bh_ & 15, row0_ = MPR + (bh_ >> 4) * 8; \
        const float* sp_ = st_in + (size_t)bh_ * 4096 + (size_t)(v0_ + rr) * 64 + part * 8; nS0 = *(const float4*)sp_; nS1 = *(const float4*)(sp_ + 4); \
        _Pragma("unroll") for (int i = 0; i < 4; ++i) { const int id = i * 64 + lane, step = id >> 5, s = (id >> 3) & 3, pc = id & 7; \
            nst[i] = *(const uint4*)(RS + (size_t)(row0_ + step) * 4096 + s * 1024 + h_ * 64 + pc * 8); } \
        _Pragma("unroll") for (int i = 0; i < 2; ++i) { const int id = i * 64 + lane, step = id >> 4, pc = id & 15; \
            nsw[i] = *(const float4*)(RW + (size_t)(row0_ + step) * 1024 + h_ * 64 + pc * 4); } \
        if (lane < 8) nsv = *(const uint4*)(RV + (size_t)(row0_ + lane) * 1024 + h_ * 64 + v0_); } while (0)
    RWS_LOAD(task0);
    for (int task = task0; task < 16384; task += stride) {
        const int bh = task >> 3, v0 = (task & 7) * 8, h = bh & 15, row0 = MPR + (bh >> 4) * 8;
        f32x2v S[4] = {(f32x2v){nS0.x, nS0.y}, (f32x2v){nS0.z, nS0.w}, (f32x2v){nS1.x, nS1.y}, (f32x2v){nS1.z, nS1.w}};
#pragma unroll
        for (int i = 0; i < 4; ++i) { const int id = i * 64 + lane, step = id >> 5, s = (id >> 3) & 3, pc = id & 7; float f[8]; unpack8(nst[i], f);
            LAS float* d = SB + (step * 4 + s) * 64 + pc * 8; *(LAS f32x4v*)d = (f32x4v){f[0], f[1], f[2], f[3]}; *(LAS f32x4v*)(d + 4) = (f32x4v){f[4], f[5], f[6], f[7]}; }
#pragma unroll
        for (int i = 0; i < 2; ++i) { const int id = i * 64 + lane, step = id >> 4, pc = id & 15; *(LAS f32x4v*)(WB + step * 64 + pc * 4) = (f32x4v){nsw[i].x, nsw[i].y, nsw[i].z, nsw[i].w}; }
        if (lane < 8) { float f[8]; unpack8(nsv, f); LAS float* d = VB + lane * 8; *(LAS f32x4v*)d = (f32x4v){f[0], f[1], f[2], f[3]}; *(LAS f32x4v*)(d + 4) = (f32x4v){f[4], f[5], f[6], f[7]}; }
        asm volatile("s_waitcnt lgkmcnt(0)" ::: "memory");
        __builtin_amdgcn_sched_barrier(0);
        if (task + stride < 16384) RWS_LOAD(task + stride);
        __builtin_amdgcn_sched_barrier(0);
        float ys[8];
        f32x4v kk0, kk1, ka0, ka1, kp0, kp1, r0, r1, w0, w1; float vv;
        f32x4v nkk0, nkk1, nka0, nka1, nkp0, nkp1, nr0, nr1, nw0, nw1; float nvv;
#define RW_OPS(s_) do { const LAS float* sb = SB + (s_) * 256 + part * 8; \
            nkk0 = *(const LAS f32x4v*)(sb); nkk1 = *(const LAS f32x4v*)(sb + 4); nka0 = *(const LAS f32x4v*)(sb + 64); nka1 = *(const LAS f32x4v*)(sb + 68); \
            nkp0 = *(const LAS f32x4v*)(sb + 128); nkp1 = *(const LAS f32x4v*)(sb + 132); nr0 = *(const LAS f32x4v*)(sb + 192); nr1 = *(const LAS f32x4v*)(sb + 196); \
            nw0 = *(const LAS f32x4v*)(WB + (s_) * 64 + part * 8); nw1 = *(const LAS f32x4v*)(WB + (s_) * 64 + part * 8 + 4); nvv = VB[(s_) * 8 + rr]; } while (0)
        RW_OPS(0);
#pragma unroll
        for (int s = 0; s < 8; ++s) {
            kk0 = nkk0; kk1 = nkk1; ka0 = nka0; ka1 = nka1; kp0 = nkp0; kp1 = nkp1; r0 = nr0; r1 = nr1; w0 = nw0; w1 = nw1; vv = nvv;
            if (s < 7) RW_OPS(s + 1);
            __builtin_amdgcn_sched_barrier(0);
            f32x2v acc = S[0] * kk0.lo, acc1 = S[1] * kk0.hi; acc = S[2] * kk1.lo + acc; acc1 = S[3] * kk1.hi + acc1; acc += acc1;
            const float sk = reduce8(acc.x + acc.y);
            const f32x2v nsk = (f32x2v){-sk, -sk}, vv2 = (f32x2v){vv, vv};
            S[0] = S[0] * w0.lo + (ka0.lo * nsk + kp0.lo * vv2);
            S[1] = S[1] * w0.hi + (ka0.hi * nsk + kp0.hi * vv2);
            S[2] = S[2] * w1.lo + (ka1.lo * nsk + kp1.lo * vv2);
            S[3] = S[3] * w1.hi + (ka1.hi * nsk + kp1.hi * vv2);
            f32x2v ya = S[0] * r0.lo, ya1 = S[1] * r0.hi; ya = S[2] * r1.lo + ya; ya1 = S[3] * r1.hi + ya1; ya += ya1;
            ys[s] = reduce8(ya.x + ya.y);
            __builtin_amdgcn_sched_barrier(0);
        }
#undef RW_OPS
        { float ysel = ys[0];
#pragma unroll
          for (int i = 1; i < 8; ++i) ysel = (part == i) ? ys[i] : ysel;
          yraw[(size_t)(row0 + part) * 2048 + 1024 + h * 64 + v0 + rr] = ysel; }
        { float* d = st_out + (size_t)bh * 4096 + (size_t)(v0 + rr) * 64 + part * 8; *(float4*)d = make_float4(S[0].x, S[0].y, S[1].x, S[1].y); *(float4*)(d + 4) = make_float4(S[2].x, S[2].y, S[3].x, S[3].y); }
        asm volatile("" ::: "memory");
    }
#undef RWS_LOAD
}
__device__ __forceinline__ void gdn_sample_loop(LAS float* sl, const bf16_t* __restrict__ GQKV, const float* __restrict__ GA, const float* __restrict__ GB, float* __restrict__ yraw,
                                                const float* __restrict__ st_in, float* __restrict__ st_out, int task0, int stride, int lane) {
    if (task0 >= 16384) return;
    const int part = lane & 7, cc = lane >> 3;
    LAS float* KB = sl; LAS float* QB = sl + 1056; LAS float* VB = sl + 2112; LAS float* AB = sl + 2176;
    const int rdoff = part * 16 + (part >> 2) * 4;
    float nS[16]; uint4 nst[4]; uint4 nsv = make_uint4(0, 0, 0, 0); float nsa = 0.f, nsb = 0.f;
#define GDS_LOAD(task_) do { const int bh_ = (task_) >> 4, j0_ = ((task_) & 15) * 8, h_ = bh_ & 7, row0_ = MPR + (bh_ >> 3) * 8; \
        const float* sp_ = st_in + (size_t)bh_ * 16384 + (size_t)(part * 16) * 128 + j0_ + cc; \
        _Pragma("unroll") for (int e = 0; e < 16; ++e) nS[e] = sp_[(size_t)e * 128]; \
        _Pragma("unroll") for (int i = 0; i < 4; ++i) { const int id = i * 64 + lane, s = id >> 7, step = (id >> 4) & 7, pc = id & 15; \
            nst[i] = *(const uint4*)(GQKV + (size_t)(row0_ + step) * 3072 + (s == 0 ? 1024 : 0) + h_ * 128 + pc * 8); } \
        if (lane < 8) { nsv = *(const uint4*)(GQKV + (size_t)(row0_ + lane) * 3072 + 2048 + h_ * 128 + j0_); \
            nsa = GA[(size_t)(row0_ + lane) * 8 + h_]; nsb = GB[(size_t)(row0_ + lane) * 8 + h_]; } } while (0)
    GDS_LOAD(task0);
    for (int task = task0; task < 16384; task += stride) {
        const int bh = task >> 4, j0 = (task & 15) * 8, h = bh & 7, row0 = MPR + (bh >> 3) * 8;
        f32x2v S[8];
#pragma unroll
        for (int e = 0; e < 8; ++e) S[e] = (f32x2v){nS[2 * e], nS[2 * e + 1]};
#pragma unroll
        for (int i = 0; i < 4; ++i) { const int id = i * 64 + lane, s = id >> 7, step = (id >> 4) & 7, pc = id & 15, pp = pc >> 1; float f[8]; unpack8(nst[i], f);
            LAS float* d = (s == 0 ? KB : QB) + step * 132 + pp * 16 + (pp >> 2) * 4 + (pc & 1) * 8; *(LAS f32x4v*)d = (f32x4v){f[0], f[1], f[2], f[3]}; *(LAS f32x4v*)(d + 4) = (f32x4v){f[4], f[5], f[6], f[7]}; }
        if (lane < 8) { float f[8]; unpack8(nsv, f); LAS float* d = VB + lane * 8; *(LAS f32x4v*)d = (f32x4v){f[0], f[1], f[2], f[3]}; *(LAS f32x4v*)(d + 4) = (f32x4v){f[4], f[5], f[6], f[7]};
            AB[lane * 2] = nsa; AB[lane * 2 + 1] = nsb; }
        asm volatile("s_waitcnt lgkmcnt(0)" ::: "memory");
        __builtin_amdgcn_sched_barrier(0);
        if (task + stride < 16384) GDS_LOAD(task + stride);
        __builtin_amdgcn_sched_barrier(0);
        float os[8];
        f32x4v k[4], q[4], nk[4], nq[4]; float v, a, beta, nv, na, nbeta;
#define GD_OPS(s_) do { const LAS float* kb = KB + (s_) * 132 + rdoff; const LAS float* qb = QB + (s_) * 132 + rdoff; \
            _Pragma("unroll") for (int i = 0; i < 4; ++i) { nk[i] = *(const LAS f32x4v*)(kb + 4 * i); nq[i] = *(const LAS f32x4v*)(qb + 4 * i); } \
            nv = VB[(s_) * 8 + cc]; na = AB[(s_) * 2]; nbeta = AB[(s_) * 2 + 1]; } while (0)
        GD_OPS(0);
#pragma unroll
        for (int s = 0; s < 8; ++s) {
#pragma unroll
            for (int i = 0; i < 4; ++i) { k[i] = nk[i]; q[i] = nq[i]; }
            v = nv; a = na; beta = nbeta;
            if (s < 7) GD_OPS(s + 1);
            __builtin_amdgcn_sched_barrier(0);
            f32x2v acc = S[0] * k[0].lo, acc1 = S[1] * k[0].hi;
#pragma unroll
            for (int i = 1; i < 4; ++i) { acc = S[2 * i] * k[i].lo + acc; acc1 = S[2 * i + 1] * k[i].hi + acc1; }
            acc += acc1;
            const float kS = reduce8(acc.x + acc.y);
            const float cf = beta * (v - a * kS);
            const f32x2v cf2 = (f32x2v){cf, cf}, a2 = (f32x2v){a, a};
#pragma unroll
            for (int i = 0; i < 4; ++i) { S[2 * i] = S[2 * i] * a2 + k[i].lo * cf2; S[2 * i + 1] = S[2 * i + 1] * a2 + k[i].hi * cf2; }
            f32x2v oa = S[0] * q[0].lo, oa1 = S[1] * q[0].hi;
#pragma unroll
            for (int i = 1; i < 4; ++i) { oa = S[2 * i] * q[i].lo + oa; oa1 = S[2 * i + 1] * q[i].hi + oa1; }
            oa += oa1;
            os[s] = reduce8(oa.x + oa.y);
            __builtin_amdgcn_sched_barrier(0);
        }
#undef GD_OPS
        { float osel = os[0];
#pragma unroll
          for (int i = 1; i < 8; ++i) osel = (part == i) ? os[i] : osel;
          yraw[(size_t)(row0 + part) * 2048 + h * 128 + j0 + cc] = osel; }
        { float* d = st_out + (size_t)bh * 16384 + (size_t)(part * 16) * 128 + j0 + cc;
#pragma unroll
          for (int e = 0; e < 8; ++e) { d[(size_t)(2 * e) * 128] = S[e].x; d[(size_t)(2 * e + 1) * 128] = S[e].y; } }
        asm volatile("" ::: "memory");
    }
#undef GDS_LOAD
}

__device__ __forceinline__ void gdn_sample_cols(LAS float* sl, const bf16_t* __restrict__ GQKV, const float* __restrict__ GA, const float* __restrict__ GB, float* __restrict__ yraw,
                                                const float* __restrict__ st_in, float* __restrict__ st_out, int task, int lane) {
    const int bh = task >> 1, j = (task & 1) * 64 + lane, h = bh & 7, row0 = MPR + (bh >> 3) * 8;
    LAS float* KB = sl; LAS float* QB = sl + 1024; LAS float* VB = sl + 2048; LAS float* AB = sl + 2560;
    f32x2v S[64];
    { const float* sp = st_in + (size_t)bh * 16384 + j;
#pragma unroll
      for (int i = 0; i < 64; ++i) { S[i] = (f32x2v){sp[0], sp[128]}; sp += 256; asm volatile("" : "+v"(sp)); } }
    {
        uint4 st[4];
#pragma unroll
        for (int i = 0; i < 4; ++i) { const int id = i * 64 + lane, s = id >> 7, step = (id >> 4) & 7, pc = id & 15;
            st[i] = *(const uint4*)(GQKV + (size_t)(row0 + step) * 3072 + (s == 0 ? 1024 : 0) + h * 128 + pc * 8); }
        unsigned short vv[8];
#pragma unroll
        for (int s = 0; s < 8; ++s) vv[s] = GQKV[(size_t)(row0 + s) * 3072 + 2048 + h * 128 + j];
        float sa = 0.f, sbt = 0.f;
        if (lane < 8) { sa = GA[(size_t)(row0 + lane) * 8 + h]; sbt = GB[(size_t)(row0 + lane) * 8 + h]; }
#pragma unroll
        for (int i = 0; i < 4; ++i) { const int id = i * 64 + lane, s = id >> 7, step = (id >> 4) & 7, pc = id & 15; float f[8]; unpack8(st[i], f);
            LAS float* d = (s == 0 ? KB : QB) + step * 128 + pc * 8; *(LAS f32x4v*)d = (f32x4v){f[0], f[1], f[2], f[3]}; *(LAS f32x4v*)(d + 4) = (f32x4v){f[4], f[5], f[6], f[7]}; }
#pragma unroll
        for (int s = 0; s < 8; ++s) VB[s * 64 + lane] = bf_lo((unsigned)vv[s]);
        if (lane < 8) { AB[lane * 2] = sa; AB[lane * 2 + 1] = sbt; }
        asm volatile("s_waitcnt lgkmcnt(0)" ::: "memory");
    }
#pragma unroll 1
    for (int s = 0; s < 8; ++s) {
        const LAS float* kb = KB + s * 128; const LAS float* qb = QB + s * 128;
        const float v = VB[s * 64 + lane], a = AB[s * 2], beta = AB[s * 2 + 1];
        f32x2v acc0 = (f32x2v){0.f, 0.f}, acc1 = (f32x2v){0.f, 0.f};
#pragma unroll
        for (int i = 0; i < 32; ++i) { const f32x4v kq = *(const LAS f32x4v*)(kb + 4 * i); acc0 = S[2 * i] * kq.lo + acc0; acc1 = S[2 * i + 1] * kq.hi + acc1; if ((i & 7) == 7) __builtin_amdgcn_sched_barrier(0); }
        acc0 += acc1;
        const float kS = acc0.x + acc0.y;
        const float cf = beta * (v - a * kS);
        const f32x2v cf2 = (f32x2v){cf, cf}, a2 = (f32x2v){a, a};
        f32x2v o0 = (f32x2v){0.f, 0.f}, o1 = (f32x2v){0.f, 0.f};
#pragma unroll
        for (int i = 0; i < 32; ++i) { const f32x4v kq = *(const LAS f32x4v*)(kb + 4 * i), qq = *(const LAS f32x4v*)(qb + 4 * i);
            S[2 * i] = S[2 * i] * a2 + kq.lo * cf2; S[2 * i + 1] = S[2 * i + 1] * a2 + kq.hi * cf2;
            o0 = S[2 * i] * qq.lo + o0; o1 = S[2 * i + 1] * qq.hi + o1; if ((i & 3) == 3) __builtin_amdgcn_sched_barrier(0); }
        o0 += o1;
        yraw[(size_t)(row0 + s) * 2048 + h * 128 + j] = o0.x + o0.y;
    }
    { float* dp = st_out + (size_t)bh * 16384 + j;
#pragma unroll
      for (int i = 0; i < 64; ++i) { dp[0] = S[i].x; dp[128] = S[i].y; dp += 256; asm volatile("" : "+v"(dp)); } }
    asm volatile("s_waitcnt lgkmcnt(0)" ::: "memory");
}

__device__ __forceinline__ float reduce16(float v) { v = reduce8(v); v += dppf<0x140>(v); return v; }
__device__ __forceinline__ void gdn_prompt_block(LAS float* L, const bf16_t* __restrict__ GQKV, const float* __restrict__ GA, const float* __restrict__ GB, float* __restrict__ yraw,
                                                 int row0, int T, int h, int jblk, float* __restrict__ s_out, int tid, int wave, int lane) {
    constexpr int BUF = 4768;
    const int part = lane & 15, cc = lane >> 4, j0 = jblk + wave * 4, rdoff = part * 8 + (part >> 3) * 4;
    f32x2v S[4];
#pragma unroll
    for (int e = 0; e < 4; ++e) S[e] = (f32x2v){0.f, 0.f};
    const int ss = tid >> 8, sstep = (tid >> 4) & 15, spc = tid & 15, vstep = (tid >> 2) & 15, vp = tid & 3, astep = tid & 15;
    uint4 st, sv = make_uint4(0, 0, 0, 0); float sa = 0.f, sbt = 0.f;
    const int nch = T >> 4;
#define GB_LOAD(c) do { const int t0_ = (c) * 16; st = *(const uint4*)(GQKV + (size_t)(row0 + t0_ + sstep) * 3072 + (ss == 0 ? 1024 : 0) + h * 128 + spc * 8); \
        if (tid < 64) sv = *(const uint4*)(GQKV + (size_t)(row0 + t0_ + vstep) * 3072 + 2048 + h * 128 + jblk + vp * 8); \
        else if (tid < 80) { sa = GA[(size_t)(row0 + t0_ + astep) * 8 + h]; sbt = GB[(size_t)(row0 + t0_ + astep) * 8 + h]; } } while (0)
#define GB_WRITE(b) do { LAS float* base = L + (b) * BUF; { float f[8]; unpack8(st, f); LAS float* d = base + ss * 2112 + sstep * 132 + spc * 8 + (spc >> 3) * 4; \
            *(LAS f32x4v*)d = (f32x4v){f[0], f[1], f[2], f[3]}; *(LAS f32x4v*)(d + 4) = (f32x4v){f[4], f[5], f[6], f[7]}; } \
        if (tid < 64) { float f[8]; unpack8(sv, f); LAS float* d = base + 4224 + vstep * 32 + vp * 8; *(LAS f32x4v*)d = (f32x4v){f[0], f[1], f[2], f[3]}; *(LAS f32x4v*)(d + 4) = (f32x4v){f[4], f[5], f[6], f[7]}; } \
        else if (tid < 80) { base[4736 + astep * 2] = sa; base[4736 + astep * 2 + 1] = sbt; } } while (0)
    GB_LOAD(0); GB_WRITE(0);
    __syncthreads();
    for (int c = 0; c < nch; ++c) {
        if (c + 1 < nch) GB_LOAD(c + 1);
        __builtin_amdgcn_sched_barrier(0);
        const LAS float* base = L + (c & 1) * BUF;
        float os[16];
        f32x2v k[4], q[4], nk[4], nq[4]; float v, a, beta, nv, na, nbeta;
#define GB_OPS(s_) do { const LAS float* kb = base + (s_) * 132 + rdoff; const LAS float* qb = base + 2112 + (s_) * 132 + rdoff; \
            _Pragma("unroll") for (int i = 0; i < 2; ++i) { const f32x4v t0 = *(const LAS f32x4v*)(kb + 4 * i), t1 = *(const LAS f32x4v*)(qb + 4 * i); \
                nk[2 * i] = t0.lo; nk[2 * i + 1] = t0.hi; nq[2 * i] = t1.lo; nq[2 * i + 1] = t1.hi; } \
            nv = base[4224 + (s_) * 32 + wave * 4 + cc]; na = base[4736 + (s_) * 2]; nbeta = base[4736 + (s_) * 2 + 1]; } while (0)
        GB_OPS(0);
#pragma unroll
        for (int s = 0; s < 16; ++s) {
#pragma unroll
            for (int i = 0; i < 4; ++i) { k[i] = nk[i]; q[i] = nq[i]; }
            v = nv; a = na; beta = nbeta;
            if (s < 15) GB_OPS(s + 1);
            __builtin_amdgcn_sched_barrier(0);
            f32x2v acc = S[0] * k[0], acc1 = S[1] * k[1]; acc = S[2] * k[2] + acc; acc1 = S[3] * k[3] + acc1; acc += acc1;
            const float kS = reduce16(acc.x + acc.y);
            const float cf = beta * (v - a * kS);
            const f32x2v cf2 = (f32x2v){cf, cf}, a2 = (f32x2v){a, a};
#pragma unroll
            for (int i = 0; i < 4; ++i) S[i] = S[i] * a2 + k[i] * cf2;
            f32x2v oa = S[0] * q[0], oa1 = S[1] * q[1]; oa = S[2] * q[2] + oa; oa1 = S[3] * q[3] + oa1; oa += oa1;
            os[s] = reduce16(oa.x + oa.y);
            __builtin_amdgcn_sched_barrier(0);
        }
#undef GB_OPS
        { float osel = os[0];
#pragma unroll
          for (int i = 1; i < 16; ++i) osel = (part == i) ? os[i] : osel;
          yraw[(size_t)(row0 + c * 16 + part) * 2048 + h * 128 + j0 + cc] = osel; }
        if (c + 1 < nch) GB_WRITE((c + 1) & 1);
        __syncthreads();
    }
#undef GB_LOAD
#undef GB_WRITE
#pragma unroll
    for (int e = 0; e < 4; ++e) { s_out[(size_t)(part * 8 + 2 * e) * 128 + j0 + cc] = S[e].x; s_out[(size_t)(part * 8 + 2 * e + 1) * 128 + j0 + cc] = S[e].y; }
}
__device__ __forceinline__ void rwkv_prompt_block(LAS float* L, const bf16_t* __restrict__ RS, const bf16_t* __restrict__ RV, const float* __restrict__ RW, float* __restrict__ yraw,
                                                  int row0, int T, int h, int vblk, float* __restrict__ s_out, int tid, int wave, int lane) {
    constexpr int BUF = 5632;
    const int part = lane & 15, rr = lane >> 4, v0 = vblk + wave * 4;
    f32x2v S[2] = {(f32x2v){0.f, 0.f}, (f32x2v){0.f, 0.f}};
    const int sstep = tid >> 5, ss = (tid >> 3) & 3, spc = tid & 7, wstep = (tid >> 4) & 15, wpc = tid & 15, vstep = (tid >> 2) & 15, vp = tid & 3;
    uint4 st, sv = make_uint4(0, 0, 0, 0); float4 sw = make_float4(0.f, 0.f, 0.f, 0.f);
    const int nch = T >> 4;
#define RB_LOAD(c) do { const int t0_ = (c) * 16; st = *(const uint4*)(RS + (size_t)(row0 + t0_ + sstep) * 4096 + ss * 1024 + h * 64 + spc * 8); \
        if (tid < 256) sw = *(const float4*)(RW + (size_t)(row0 + t0_ + wstep) * 1024 + h * 64 + wpc * 4); \
        else if (tid < 320) sv = *(const uint4*)(RV + (size_t)(row0 + t0_ + vstep) * 1024 + h * 64 + vblk + vp * 8); } while (0)
#define RB_WRITE(b) do { LAS float* base = L + (b) * BUF; { float f[8]; unpack8(st, f); LAS float* d = base + (sstep * 4 + ss) * 64 + spc * 8; \
            *(LAS f32x4v*)d = (f32x4v){f[0], f[1], f[2], f[3]}; *(LAS f32x4v*)(d + 4) = (f32x4v){f[4], f[5], f[6], f[7]}; } \
        if (tid < 256) *(LAS f32x4v*)(base + 4096 + wstep * 64 + wpc * 4) = (f32x4v){sw.x, sw.y, sw.z, sw.w}; \
        else if (tid < 320) { float f[8]; unpack8(sv, f); LAS float* d = base + 5120 + vstep * 32 + vp * 8; *(LAS f32x4v*)d = (f32x4v){f[0], f[1], f[2], f[3]}; *(LAS f32x4v*)(d + 4) = (f32x4v){f[4], f[5], f[6], f[7]}; } } while (0)
    RB_LOAD(0); RB_WRITE(0);
    __syncthreads();
    for (int c = 0; c < nch; ++c) {
        if (c + 1 < nch) RB_LOAD(c + 1);
        __builtin_amdgcn_sched_barrier(0);
        const LAS float* base = L + (c & 1) * BUF;
        float ys[16];
        f32x4v kk, ka, kp, r, w, nkk, nka, nkp, nr, nw; float vv, nvv;
#define RB_OPS(s_) do { const LAS float* sb = base + (s_) * 256 + part * 4; nkk = *(const LAS f32x4v*)(sb); nka = *(const LAS f32x4v*)(sb + 64); nkp = *(const LAS f32x4v*)(sb + 128); nr = *(const LAS f32x4v*)(sb + 192); \
            nw = *(const LAS f32x4v*)(base + 4096 + (s_) * 64 + part * 4); nvv = base[5120 + (s_) * 32 + wave * 4 + rr]; } while (0)
        RB_OPS(0);
#pragma unroll
        for (int s = 0; s < 16; ++s) {
            kk = nkk; ka = nka; kp = nkp; r = nr; w = nw; vv = nvv;
            if (s < 15) RB_OPS(s + 1);
            __builtin_amdgcn_sched_barrier(0);
            f32x2v acc = S[0] * kk.lo + S[1] * kk.hi;
            const float sk = reduce16(acc.x + acc.y);
            const f32x2v nsk = (f32x2v){-sk, -sk}, vv2 = (f32x2v){vv, vv};
            S[0] = S[0] * w.lo + (ka.lo * nsk + kp.lo * vv2);
            S[1] = S[1] * w.hi + (ka.hi * nsk + kp.hi * vv2);
            f32x2v ya = S[0] * r.lo + S[1] * r.hi;
            ys[s] = reduce16(ya.x + ya.y);
            __builtin_amdgcn_sched_barrier(0);
        }
#undef RB_OPS
        { float ysel = ys[0];
#pragma unroll
          for (int i = 1; i < 16; ++i) ysel = (part == i) ? ys[i] : ysel;
          yraw[(size_t)(row0 + c * 16 + part) * 2048 + 1024 + h * 64 + v0 + rr] = ysel; }
        if (c + 1 < nch) RB_WRITE((c + 1) & 1);
        __syncthreads();
    }
#undef RB_LOAD
#undef RB_WRITE
    *(float4*)(s_out + (size_t)(v0 + rr) * 64 + part * 4) = make_float4(S[0].x, S[0].y, S[1].x, S[1].y);
}

__device__ __forceinline__ void post_tile(const Args& A, LAS float* lg, int tile, int tid) {
    const bf16_t* PROJ = (const bf16_t*)(A.ws + W_PROJ);
    const bf16_t* RS = (const bf16_t*)(A.ws + W_RS); const bf16_t* RV = (const bf16_t*)(A.ws + W_RV);
    bf16_t* MIXED = (bf16_t*)(A.ws + W_MIXED);
    const float* yraw = A.out + O_Y; const float* st_shift = A.in[5];
    const int row_base = tile * TT;
    const int c0 = tid * 2;
    float2 yv[TT], ov[TT]; unsigned rwv[TT], kwv[TT], vwv[TT], zwv[TT];
#pragma unroll
    for (int tk = 0; tk < TT; ++tk) { const int row = row_base + tk;
        yv[tk] = *(const float2*)(yraw + (size_t)row * 2048 + 1024 + c0); ov[tk] = *(const float2*)(yraw + (size_t)row * 2048 + c0);
        rwv[tk] = *(const unsigned*)(RS + (size_t)row * 4096 + 3072 + c0); kwv[tk] = *(const unsigned*)(RS + (size_t)row * 4096 + 2048 + c0); vwv[tk] = *(const unsigned*)(RV + (size_t)row * 1024 + c0);
        zwv[tk] = *(const unsigned*)(PROJ + (size_t)row * NINP + 3072 + c0); }
    {
        if (tid < 4 * 68) ((LAS unsigned*)lg)[TT * 68 + tid] = 0u;
        const float* mu = A.in[13];
#pragma unroll
        for (int i = 0; i < 2; ++i) { const int item = tid + 512 * i; if (item < TT * 64) { const int tk = item >> 6, jp = item & 63, row = row_base + tk; int grp, b, t, T; rowinfo(row, grp, b, t, T);
            const int col = 3200 + 2 * jp; const unsigned pw_ = *(const unsigned*)(PROJ + (size_t)row * NINP + OFFR + col);
            float q0, q1; if (t > 0) { const unsigned qw = *(const unsigned*)(PROJ + (size_t)(row - 1) * NINP + OFFR + col); q0 = bf_lo(qw); q1 = bf_hi(qw); }
            else if (grp) { const float2 sq = *(const float2*)(st_shift + (size_t)b * RPROJ + col); q0 = sq.x; q1 = sq.y; } else { q0 = 0.f; q1 = 0.f; }
            const float2 m2 = *(const float2*)(mu + col); const float p0 = bf_lo(pw_), p1 = bf_hi(pw_);
            ((LAS unsigned*)lg)[tk * 68 + jp] = pk2_safe(sigmoidf_(p0 + (q0 - p0) * m2.x), sigmoidf_(p1 + (q1 - p1) * m2.y)); } }
    }
    __syncthreads();
    {
        const int wv_ = __builtin_amdgcn_readfirstlane(tid >> 6), ti = tid & 15, quad = (tid & 63) >> 4;
        const LAS unsigned char* lb = (const LAS unsigned char*)lg + ti * 272 + quad * 16;
        pg8::bf16x8 bop[4];
#pragma unroll
        for (int ks = 0; ks < 4; ++ks) bop[ks] = *(const LAS pg8::bf16x8*)(lb + ks * 64);
        const bf16_t* WT = (const bf16_t*)((const unsigned char*)A.out + OB_GBT) + (size_t)(wv_ * 128 + ti) * 128 + quad * 8;
        LAS float* dst = lg + 2048 + (ti < TT ? ti : TT) * 1028 + wv_ * 128 + quad * 4;
#pragma unroll
        for (int hh = 0; hh < 2; ++hh) {
            pg8::bf16x8 aop[4][4];
#pragma unroll
            for (int t = 0; t < 4; ++t)
#pragma unroll
                for (int ks = 0; ks < 4; ++ks) aop[t][ks] = *(const pg8::bf16x8*)(WT + (size_t)(hh * 4 + t) * 16 * 128 + ks * 32);
#pragma unroll
            for (int t = 0; t < 4; ++t) {
                pg8::f32x4 c = (pg8::f32x4){0.f, 0.f, 0.f, 0.f};
#pragma unroll
                for (int ks = 0; ks < 4; ++ks) c = __builtin_amdgcn_mfma_f32_16x16x32_bf16(aop[t][ks], bop[ks], c, 0, 0, 0);
                *(LAS f32x4v*)(dst + (hh * 4 + t) * 16) = (f32x4v){c[0], c[1], c[2], c[3]};
            }
        }
    }
    __syncthreads();
    f32x2v gate[TT];
#pragma unroll
    for (int tk = 0; tk < TT; ++tk) gate[tk] = *(const LAS f32x2v*)(lg + 2048 + tk * 1028 + c0);
    const float2 gnw = *(const float2*)(A.in[22] + c0), gnb = *(const float2*)(A.in[23] + c0), rk = *(const float2*)(A.in[21] + c0);
    const float2 ng = *(const float2*)(A.in[12] + (c0 & 127));
#pragma unroll
    for (int tk = 0; tk < TT; ++tk) {
        const int row = row_base + tk;
        {
            const float2 y = yv[tk];
            const float mean = half_sum32(y.x + y.y) * (1.0f / 64.0f);
            const float d0 = y.x - mean, d1 = y.y - mean;
            const float var = half_sum32(d0 * d0 + d1 * d1) * (1.0f / 64.0f);
            const float rs = rsqrtf(var + 64e-5f);
            const unsigned rw = rwv[tk], kw = kwv[tk], vw = vwv[tk];
            const float bon = half_sum32(bf_lo(rw) * bf_lo(kw) * rk.x + bf_hi(rw) * bf_hi(kw) * rk.y);
            const float o0 = (d0 * rs * gnw.x + gnb.x + bon * bf_lo(vw)) * gate[tk].x, o1 = (d1 * rs * gnw.y + gnb.y + bon * bf_hi(vw)) * gate[tk].y;
            *(unsigned*)(MIXED + (size_t)row * 2048 + 1024 + c0) = pk2(o0, o1);
        }
        {
            const float2 o = ov[tk];
            const float rs = rsqrtf(wave_sum(o.x * o.x + o.y * o.y) * (1.0f / 128.0f) + 1e-6f);
            const unsigned zw = zwv[tk];
            *(unsigned*)(MIXED + (size_t)row * 2048 + c0) = pk2(o.x * rs * ng.x * siluf_(bf_lo(zw)), o.y * rs * ng.y * siluf_(bf_hi(zw)));
        }
    }
    __syncthreads();
}

__device__ __forceinline__ void act_item(const Args& A, int item, int lane) {
    const bf16_t* H = (const bf16_t*)(A.ws + W_H); bf16_t* ACT = (bf16_t*)(A.ws + W_ACT);
    const float* cwp = A.in[27]; const float* st_ffn = A.in[6];
    const int cgp = item % 11, rg = item / 11, ch = (cgp * 64 + lane) * 8;
    float cg_[3][8], cu_[3][8];
#pragma unroll
    for (int i = 0; i < 3; ++i) { const float4 a0 = *(const float4*)(cwp + (size_t)i * DFF2 + ch), a1 = *(const float4*)(cwp + (size_t)i * DFF2 + ch + 4), b0 = *(const float4*)(cwp + (size_t)i * DFF2 + DFF + ch), b1 = *(const float4*)(cwp + (size_t)i * DFF2 + DFF + ch + 4);
        cg_[i][0] = a0.x; cg_[i][1] = a0.y; cg_[i][2] = a0.z; cg_[i][3] = a0.w; cg_[i][4] = a1.x; cg_[i][5] = a1.y; cg_[i][6] = a1.z; cg_[i][7] = a1.w;
        cu_[i][0] = b0.x; cu_[i][1] = b0.y; cu_[i][2] = b0.z; cu_[i][3] = b0.w; cu_[i][4] = b1.x; cu_[i][5] = b1.y; cu_[i][6] = b1.z; cu_[i][7] = b1.w; }
    uint4 hg[11], hu[11];
#pragma unroll
    for (int i = 0; i < 11; ++i) { int r = rg * 9 - 2 + i; r = r < 0 ? 0 : r; hg[i] = *(const uint4*)(H + (size_t)r * DFF2 + ch); hu[i] = *(const uint4*)(H + (size_t)r * DFF2 + DFF + ch); }
#pragma unroll
    for (int rI = 0; rI < 9; ++rI) {
        const int row = rg * 9 + rI; int grp, b, t, T; rowinfo(row, grp, b, t, T);
        float g[8], u[8];
#pragma unroll
        for (int e = 0; e < 8; ++e) { g[e] = 0.f; u[e] = 0.f; }
#pragma unroll
        for (int i = 0; i < 3; ++i) { const int tt = t - 2 + i; float xg[8], xu[8];
            if (tt >= 0) { unpack8(hg[rI + i], xg); unpack8(hu[rI + i], xu); }
            else if (grp) { const float* sp = st_ffn + ((size_t)b * 2 + (t + i)) * DFF2 + ch; const float4 a0 = *(const float4*)sp, a1 = *(const float4*)(sp + 4), b0 = *(const float4*)(sp + DFF), b1 = *(const float4*)(sp + DFF + 4);
                xg[0] = a0.x; xg[1] = a0.y; xg[2] = a0.z; xg[3] = a0.w; xg[4] = a1.x; xg[5] = a1.y; xg[6] = a1.z; xg[7] = a1.w;
                xu[0] = b0.x; xu[1] = b0.y; xu[2] = b0.z; xu[3] = b0.w; xu[4] = b1.x; xu[5] = b1.y; xu[6] = b1.z; xu[7] = b1.w; }
            else {
#pragma unroll
                for (int e = 0; e < 8; ++e) { xg[e] = 0.f; xu[e] = 0.f; } }
#pragma unroll
            for (int e = 0; e < 8; ++e) { g[e] += cg_[i][e] * xg[e]; u[e] += cu_[i][e] * xu[e]; } }
        float o[8];
#pragma unroll
        for (int e = 0; e < 8; ++e) o[e] = siluf_(g[e]) * u[e];
        uint4 w; w.x = pk2(o[0], o[1]); w.y = pk2(o[2], o[3]); w.z = pk2(o[4], o[5]); w.w = pk2(o[6], o[7]);
        *(uint4*)(ACT + (size_t)row * DFF + ch) = w;
    }
}

__device__ __forceinline__ void fast_grid_barrier(unsigned* bar, unsigned round, unsigned G) {
    asm volatile("s_waitcnt vmcnt(0)" ::: "memory");
    __syncthreads();
    if (threadIdx.x == 0) {
        __builtin_amdgcn_fence(__ATOMIC_RELEASE, "agent");
        asm volatile("s_waitcnt vmcnt(0)" ::: "memory");
        const unsigned g = blockIdx.x >> 4, ngroups = (G + 15u) >> 4, gsize = (G - g * 16u) < 16u ? (G - g * 16u) : 16u;
        unsigned* cnt = bar + 32u * (1u + g); unsigned* top = bar + 32u * 20u; unsigned* gen = bar + 32u * (24u + g);
        const unsigned old = __hip_atomic_fetch_add(cnt, 1u, __ATOMIC_RELAXED, __HIP_MEMORY_SCOPE_AGENT);
        if (old + 1u == round * gsize) {
            const unsigned t = __hip_atomic_fetch_add(top, 1u, __ATOMIC_RELAXED, __HIP_MEMORY_SCOPE_AGENT);
            if (t + 1u == round * ngroups) { for (unsigned q = 0; q < ngroups; ++q) __hip_atomic_store(bar + 32u * (24u + q), round, __ATOMIC_RELAXED, __HIP_MEMORY_SCOPE_AGENT); }
        }
        unsigned sp = 0u;
        while (__hip_atomic_load(gen, __ATOMIC_RELAXED, __HIP_MEMORY_SCOPE_AGENT) < round) { __builtin_amdgcn_s_sleep(1); if (++sp > (1u << 22)) break; }
        __builtin_amdgcn_fence(__ATOMIC_ACQUIRE, "agent");
        asm volatile("s_waitcnt vmcnt(0)" ::: "memory");
    }
    __syncthreads();
}

__global__ void __launch_bounds__(512, 2) hymba_fwd(Args A) {
    extern __shared__ __attribute__((aligned(16))) unsigned char lds_raw[];
    LAS unsigned char* lds = (LAS unsigned char*)lds_raw;
    cg::grid_group grid = cg::this_grid();
    const int tid = threadIdx.x, lane = tid & 63, wave = __builtin_amdgcn_readfirstlane(tid >> 6);
    const int G = gridDim.x, bx = blockIdx.x, gw = bx * 8 + wave, NGW = G * 8;
    const int lo = A.ph_lo, hi = A.ph_hi;
#define IN(k) (lo <= (k) && (k) < hi)
    unsigned* barcnt = (unsigned*)(A.ws + W_BAR); unsigned nbar = 0u;
#define SEAM(k) do { if (IN(k) && IN((k) + 1)) { ++nbar; fast_grid_barrier(barcnt, nbar, (unsigned)G); } } while (0)
    if (hi < 0) grid.sync();
    unsigned char* ws = A.ws; float* out = A.out;
    bf16_t* XN = (bf16_t*)(out + O_GDN_S);
    bf16_t* WT_IN = (bf16_t*)(out + O_RWKV_S);
    bf16_t* WT_O = (bf16_t*)(ws + W_WTO); bf16_t* WT_UP = (bf16_t*)(ws + W_WTUP); bf16_t* WT_DN = (bf16_t*)(ws + W_WTDN);
    bf16_t* PROJ = (bf16_t*)(ws + W_PROJ); bf16_t* MIXED = (bf16_t*)(ws + W_MIXED); bf16_t* XN2 = (bf16_t*)(ws + W_XN2);
    bf16_t* HB = (bf16_t*)(ws + W_H); bf16_t* ACT = (bf16_t*)(ws + W_ACT);
    float* X1 = out + O_Y; float* PART = (float*)(ws + W_PART);

    if (IN(0)) {
        LAS float* scr = (LAS float*)(lds + wave * 16384);
        constexpr int I_IN = 32 * (NINP / 64);
        for (int it = gw; it < I_IN; it += NGW) transpose_item(A.in[8], DM, NIN, WT_IN, scr, it, NINP / 64, lane);
        for (int i = bx * 512 + tid; i < 4096 * 8; i += G * 512) {
            int r = (i >> 9) * 64 + (i & 63); const int q = (i >> 6) & 7; const float* W; bf16_t* WT; int K, j0;
            if (r < 1024) { W = A.in[15]; WT = (bf16_t*)((unsigned char*)out + OB_WBT); K = 64; j0 = 0; }
            else if (r < 2048) { r -= 1024; W = A.in[17]; WT = (bf16_t*)((unsigned char*)out + OB_ABT); K = 64; j0 = 0; }
            else { r -= 2048; W = A.in[18]; WT = (bf16_t*)((unsigned char*)out + OB_GBT); K = 128; j0 = (r >> 10) * 64; r &= 1023; }
            const int ch = r;
            float f[8];
#pragma unroll
            for (int e = 0; e < 8; ++e) f[e] = W[(size_t)(j0 + q * 8 + e) * 1024 + ch];
            uint4 o; o.x = pk2(f[0], f[1]); o.y = pk2(f[2], f[3]); o.z = pk2(f[4], f[5]); o.w = pk2(f[6], f[7]);
            *(uint4*)(WT + (size_t)ch * K + j0 + q * 8) = o;
        }
        for (int m = gw; m < MTOK; m += NGW) { const float* xr = (m < MPR) ? A.in[0] + (size_t)m * DM : A.in[1] + (size_t)(m - MPR) * DM; rms_row_bf16(xr, A.in[7], XN + (size_t)m * DM, lane); }
        __syncthreads();
    }
    SEAM(0);
    if (IN(1)) {
        pg8::Gemm g{XN, WT_IN, MTOK, NINP, DM}; pg8::StaticOrder S; S.init(MTOK, NINP, DM, G, bx);
        pg8::EpiBf16P E{PROJ, NINP};
        pg8::gemm_phase<pg8::EpiBf16P, pg8::StaticOrder, true, true>(lds, g, S, E);
    }
    SEAM(1);
    if (IN(2)) { for (int tile = bx; tile < NTILES; tile += G) prep_tile(A, (LAS float*)lds, tile, tid); }
    SEAM(2);
    if (IN(3)) {
        LAS float* sl = (LAS float*)(lds + wave * 16384);
        const bf16_t* GQKV = (const bf16_t*)(ws + W_GQKV); const float* GA = (const float*)(ws + W_GAB); const float* GB = GA + MTOK * 8;
        const bf16_t* RS = (const bf16_t*)(ws + W_RS); const bf16_t* RV = (const bf16_t*)(ws + W_RV); const float* RW = (const float*)(ws + W_RW);
        float* yraw = out + O_Y;
        const bool heavy = (G == 256) && (bx >= 128);
        const int nshare = (G == 256) ? 3072 : NGW, share0 = (G == 256) ? (heavy ? 1024 + ((bx - 128) * 8 + wave) * 2 : gw) : gw, nsh = heavy ? 2 : 1;
        for (int task = gw; task < 2048; task += NGW) gdn_sample_cols(sl, GQKV, GA, GB, yraw, A.in[2], out + O_GDN_S, task, lane);
        for (int sh = 0; sh < nsh; ++sh) {
            rwkv_sample_loop(sl, RS, RV, RW, yraw, A.in[4], out + O_RWKV_S, share0 + sh, nshare, lane);
            constexpr int I_O = 32 * (DM / 64), I_UP = 32 * (DFF2 / 64), I_DN = (DFF / 64) * (DM / 64);
            for (int it = share0 + sh; it < I_O + I_UP + I_DN; it += nshare) {
                int r = it;
                if (r < I_O) { transpose_item(A.in[24], DM, DM, WT_O, sl, r, DM / 64, lane); continue; } r -= I_O;
                if (r < I_UP) { transpose_item(A.in[26], DM, DFF2, WT_UP, sl, r, DFF2 / 64, lane); continue; } r -= I_UP;
                transpose_item(A.in[28], DFF, DM, WT_DN, sl, r, DM / 64, lane);
            }
        }
        __syncthreads();
        for (int u = bx; u < 256; u += G) {
            if (u < 128) { const int bh = u >> 2, cq = u & 3;
                gdn_prompt_block((LAS float*)lds, GQKV, GA, GB, yraw, (bh >> 3) * 2048, 2048, bh & 7, cq * 32, out + O_GDN_P + (size_t)bh * 16384, tid, wave, lane); }
            else { const int uu = u - 128, bh = uu >> 1, hf = uu & 1;
                rwkv_prompt_block((LAS float*)lds, RS, RV, RW, yraw, (bh >> 4) * 2048, 2048, bh & 15, hf * 32, out + O_RWKV_P + (size_t)bh * 4096, tid, wave, lane); }
        }
        __syncthreads();
    }
    SEAM(3);
    if (IN(4)) {
        for (int tile = bx; tile < NTILES; tile += G) post_tile(A, (LAS float*)lds, tile, tid);
    }
    SEAM(4);
    if (IN(5)) {
        pg8::Gemm g{MIXED, WT_O, MTOK, DM, DM}; pg8::SplitOrder S; S.init(DM, bx);
        pg8::EpiResSplit E{A.in[0], X1, PART};
        pg8::gemm_phase<pg8::EpiResSplit, pg8::SplitOrder, true, true>(lds, g, S, E);
    }
    SEAM(5);
    if (IN(6)) {
        LAS float* scr = (LAS float*)(lds + wave * 16384);
        for (int m = gw; m < MTOK; m += NGW) {
            if (m >= MPR) { const float4* xs = (const float4*)(A.in[1] + (size_t)(m - MPR) * DM); float4* xo = (float4*)(X1 + (size_t)m * DM);
#pragma unroll
                for (int j = 0; j < 8; ++j) { float4 a = xs[lane + 64 * j];
#pragma unroll
                    for (int sg = 0; sg < 8; ++sg) { const float4 b = ((const float4*)(PART + ((size_t)sg * 1024 + (m - MPR)) * DM))[lane + 64 * j]; a.x += b.x; a.y += b.y; a.z += b.z; a.w += b.w; }
                    xo[lane + 64 * j] = a; } }
            rms_row_bf16(X1 + (size_t)m * DM, A.in[25], XN2 + (size_t)m * DM, lane);
        }
        __syncthreads();
    }
    SEAM(6);
    if (IN(7)) {
        pg8::Gemm g{XN2, WT_UP, MTOK, DFF2, DM}; pg8::StaticOrder S; S.init(MTOK, DFF2, DM, G, bx);
        pg8::EpiH E{HB, out + O_FFN_P, out + O_FFN_S};
        pg8::gemm_phase<pg8::EpiH, pg8::StaticOrder, true, true>(lds, g, S, E);
    }
    SEAM(7);
    if (IN(8)) { for (int it = gw; it < 11 * (MTOK / 9); it += NGW) act_item(A, it, lane); }
    SEAM(8);
    if (IN(9)) {
        pg8::Gemm g{ACT, WT_DN, MTOK, DM, DFF}; pg8::SplitOrder S; S.init(DFF, bx);
        pg8::EpiResSplit E{X1, X1, PART};
        pg8::gemm_phase<pg8::EpiResSplit, pg8::SplitOrder, true, true>(lds, g, S, E);
    }
    SEAM(9);
    if (IN(10)) { for (int m = gw; m < MTOK; m += NGW) {
            if (m >= MPR) { float4* xo = (float4*)(X1 + (size_t)m * DM);
#pragma unroll
                for (int j = 0; j < 8; ++j) { float4 a = xo[lane + 64 * j];
#pragma unroll
                    for (int sg = 0; sg < 8; ++sg) { const float4 b = ((const float4*)(PART + ((size_t)sg * 1024 + (m - MPR)) * DM))[lane + 64 * j]; a.x += b.x; a.y += b.y; a.z += b.z; a.w += b.w; }
                    xo[lane + 64 * j] = a; } }
            rms_row_f32_inplace(X1 + (size_t)m * DM, A.in[29], lane); } }
#undef IN
#undef SEAM
}

#ifndef N_LAUNCH_SPLIT
#define N_LAUNCH_SPLIT 0
#endif
extern "C" void kernel_launch(void* const* d_in, const int* in_sizes, int n_in, void* d_out, int out_size, void* d_ws, size_t ws_size, hipStream_t stream) {
    static int grid = 0;
    if (grid == 0) {
        int dev = 0, cus = 0, per_cu = 0;
        hipGetDevice(&dev);
        hipDeviceGetAttribute(&cus, hipDeviceAttributeMultiprocessorCount, dev);
        if (hipFuncSetAttribute((const void*)hymba_fwd, hipFuncAttributeMaxDynamicSharedMemorySize, LDS_BYTES) != hipSuccess) fprintf(stderr, "kernel_launch: hipFuncSetAttribute failed\n");
        if (hipOccupancyMaxActiveBlocksPerMultiprocessor(&per_cu, (const void*)hymba_fwd, 512, LDS_BYTES) != hipSuccess || per_cu < 1) { fprintf(stderr, "kernel_launch: occupancy query says %d\n", per_cu); per_cu = 1; }
        (void)hipGetLastError();
        grid = cus * 1;
        if (n_in != 30 || out_size != (int)O_END || ws_size < W_END4) fprintf(stderr, "kernel_launch: unexpected sizes n_in %d out %d ws %zu (need %zu)\n", n_in, out_size, ws_size, (size_t)W_END3);
    }
    if (hipMemsetAsync((char*)d_ws + W_BAR, 0, 8192, stream) != hipSuccess) fprintf(stderr, "kernel_launch: memset of the barrier word failed\n");
    Args a{};
    for (int i = 0; i < 30; ++i) a.in[i] = (const float*)d_in[i];
    a.out = (float*)d_out; a.ws = (unsigned char*)d_ws;
#if N_LAUNCH_SPLIT
    for (int p = 0; p <= 10; ++p) { a.ph_lo = p; a.ph_hi = p + 1; void* args[] = {&a};
        hipError_t e = hipLaunchCooperativeKernel((const void*)hymba_fwd, dim3(grid), dim3(512), args, LDS_BYTES, stream);
        if (e != hipSuccess) { fprintf(stderr, "kernel_launch: launch of phase %d failed: %s\n", p, hipGetErrorString(e)); break; } }
#else
    a.ph_lo = 0; a.ph_hi = 11; void* args[] = {&a};
    hipError_t e = hipLaunchCooperativeKernel((const void*)hymba_fwd, dim3(grid), dim3(512), args, LDS_BYTES, stream);
    if (e != hipSuccess) fprintf(stderr, "kernel_launch: cooperative launch failed: %s (grid %d)\n", hipGetErrorString(e), grid);
#endif
}
```

```cpp
#include <hip/hip_runtime.h>
#include <hip/hip_cooperative_groups.h>
#include <cstdio>
#include <cstdint>
namespace cg = cooperative_groups;
namespace pg8 {
#define PG8_LAS __attribute__((address_space(3)))
typedef unsigned short bf16_t;
typedef short bf16x8 __attribute__((ext_vector_type(8)));
typedef float f32x4 __attribute__((ext_vector_type(4)));
typedef unsigned u32x4 __attribute__((ext_vector_type(4)));
constexpr int BM = 256, BK = 64, HALF = 128, HTB = HALF * BK * 2  , STAGE_BYTES = 8 * HTB, NXCD = 8, WGM = 8;

__host__ __device__ __forceinline__ int lds_byte(int r, int c) { const int st = (r >> 4) * 2 + (c >> 5), rr = r & 15, cc = c & 31, ob = rr * 64 + cc * 2; return st * 1024 + (ob ^ (((ob >> 9) & 1) << 5)); }
__host__ __device__ __forceinline__ void stage_rc(int b, int& R, int& C) { const int st = b / 1024, sb = b % 1024, swz = sb ^ (((sb >> 9) & 1) << 5); R = (st >> 1) * 16 + swz / 64; C = (st & 1) * 32 + (swz % 64) / 2; }
__host__ __device__ __forceinline__ int perm32(int rho) { const int n = rho >> 4, i = rho & 15; return 8 * (i >> 2) + 4 * n + (i & 3); }

struct Unit { int pm, pn, k0, nt, seg; };
struct Gemm { const bf16_t* A; const bf16_t* Bt; int M, N, K; };

struct StaticOrder {
    int nM, nN, nwg, G, c, ntk;
    __host__ __device__ void init(int M, int N, int K, int G_, int c_) { nM = M / BM; nN = N / BM; nwg = nM * nN; G = G_; c = c_; ntk = K / BK; }
    __host__ __device__ bool next(int i, Unit& u) const {
        const long L = (long)i * G + c; if (L >= nwg) return false;
        int wgid = (int)L; { const int q = nwg / NXCD, r = nwg % NXCD, xcd = wgid % NXCD, off = wgid / NXCD; wgid = (xcd < r ? xcd * (q + 1) : r * (q + 1) + (xcd - r) * q) + off; }
        const int nig = WGM * nN, gid = wgid / nig, fm = gid * WGM, gsz = (nM - fm) < WGM ? (nM - fm) : WGM;
        u.pm = fm + ((wgid % nig) % gsz); u.pn = (wgid % nig) / gsz; u.k0 = 0; u.nt = ntk; u.seg = 0; return true;
    }
    __device__ __forceinline__ void a_ready(const Unit&) const {}
    __device__ __forceinline__ void done(const Unit&) const {}
};
__device__ __forceinline__ unsigned cvt_pk_bf16(float lo, float hi) { unsigned r; asm volatile("s_nop 1\n\tv_cvt_pk_bf16_f32 %0, %1, %2" : "=v"(r) : "v"(lo), "v"(hi)); return r; }
template <class Epi, class Sched, bool ALIGN_EPI = false, bool SP2 = false>
__device__ __forceinline__ void gemm_phase(PG8_LAS unsigned char* lds, const Gemm g, const Sched& S, const Epi& E) {
    const int tid = threadIdx.x, wid = __builtin_amdgcn_readfirstlane(tid >> 6), lane = tid & 63, wr = wid >> 2, wc = wid & 3, fr = lane & 15, fq = lane >> 4;
    const int K = g.K;
    unsigned voffA[2], voffB[2];
#pragma unroll
    for (int i = 0; i < 2; ++i) { int R, C; stage_rc(tid * 16 + i * 8192, R, C); const int Rb = Epi::PERM ? ((R & ~31) + perm32(R & 31)) : R;
        voffA[i] = (unsigned)(R * K + C) * 2u; voffB[i] = (unsigned)(Rb * K + C) * 2u; }
    const size_t kstep = (size_t)(BK * 2);
    const size_t hstep = (size_t)HALF * K * 2;
    const size_t tstep = 2 * hstep;
    const unsigned ldsw = (unsigned)wid * 1024u;
    const int aoff = lds_byte(wr * 64 + fr, fq * 8), boff = lds_byte(wc * 32 + fr, fq * 8);
#define PG8_SA(b, h) (((b) * 2 + (h)) * HTB)
#define PG8_SB(b, h) ((4 + (b) * 2 + (h)) * HTB)
#define PG8_STAGE(bufoff, gbase, voff) do { _Pragma("unroll") for (int _i = 0; _i < 2; ++_i) \
        __builtin_amdgcn_global_load_lds((const unsigned*)((const char*)(gbase) + (voff)[_i]), (PG8_LAS unsigned*)(lds + (bufoff) + ldsw + _i * 8192), 16, 0, 0); } while (0)
#define PG8_LDA(dst, b, h) do { _Pragma("unroll") for (int m = 0; m < 4; ++m) _Pragma("unroll") for (int k = 0; k < 2; ++k) dst[m][k] = *(const PG8_LAS bf16x8*)(lds + PG8_SA(b, h) + aoff + m * 2048 + k * 1024); } while (0)
#define PG8_LDB(dst, b, h) do { _Pragma("unroll") for (int n = 0; n < 2; ++n) _Pragma("unroll") for (int k = 0; k < 2; ++k) dst[n][k] = *(const PG8_LAS bf16x8*)(lds + PG8_SB(b, h) + boff + n * 2048 + k * 1024); } while (0)
#define PG8_MMA(ai, bj, At, Bt) do { __builtin_amdgcn_s_setprio(1); _Pragma("unroll") for (int m = 0; m < 4; ++m) _Pragma("unroll") for (int n = 0; n < 2; ++n) _Pragma("unroll") for (int k = 0; k < 2; ++k) \
        acc[ai][bj][m][n] = __builtin_amdgcn_mfma_f32_16x16x32_bf16(Bt[n][k], At[m][k], acc[ai][bj][m][n], 0, 0, 0); __builtin_amdgcn_s_setprio(0); } while (0)
#define PG8_WAIT_V(n) asm volatile("s_waitcnt vmcnt(" #n ")" ::: "memory")
#define PG8_WAIT_L(n) asm volatile("s_waitcnt lgkmcnt(" #n ")" ::: "memory")
#define PG8_BAR __builtin_amdgcn_s_barrier()
#define PG8_SCHED __builtin_amdgcn_sched_barrier(0)
    Unit cur, nxt; int ui = 0;
    if (!S.next(0, cur)) return;
    f32x4 acc[2][2][4][2];
#pragma unroll
    for (int a = 0; a < 2; ++a)
#pragma unroll
        for (int b = 0; b < 2; ++b)
#pragma unroll
            for (int m = 0; m < 4; ++m)
#pragma unroll
                for (int n = 0; n < 2; ++n) acc[a][b][m][n] = (f32x4){0.f, 0.f, 0.f, 0.f};
    bf16x8 At[4][2], B0[2][2], B1[2][2];
    const char* cA = (const char*)g.A + (size_t)cur.pm * tstep + (size_t)cur.k0 * kstep; const char* cB = (const char*)g.Bt + (size_t)cur.pn * tstep + (size_t)cur.k0 * kstep;
    S.a_ready(cur);
    if constexpr (SP2) {
        PG8_STAGE(PG8_SB(0, 0), cB, voffB); PG8_STAGE(PG8_SB(0, 1), cB + hstep, voffB); PG8_STAGE(PG8_SA(0, 0), cA, voffA); PG8_STAGE(PG8_SA(0, 1), cA + hstep, voffA);
        if (wr == 1) PG8_BAR;
        PG8_WAIT_V(2); PG8_BAR;
        PG8_STAGE(PG8_SB(1, 0), cB + kstep, voffB); PG8_STAGE(PG8_SA(1, 0), cA + kstep, voffA); PG8_STAGE(PG8_SB(1, 1), cB + hstep + kstep, voffB);
        PG8_WAIT_V(6); PG8_BAR;
    } else {
        PG8_STAGE(PG8_SB(0, 0), cB, voffB); PG8_STAGE(PG8_SA(0, 0), cA, voffA); PG8_STAGE(PG8_SB(0, 1), cB + hstep, voffB); PG8_STAGE(PG8_SA(0, 1), cA + hstep, voffA);
        if (wr == 1) PG8_BAR;
        PG8_WAIT_V(4); PG8_BAR;
        PG8_STAGE(PG8_SB(1, 0), cB + kstep, voffB); PG8_STAGE(PG8_SA(1, 0), cA + kstep, voffA); PG8_STAGE(PG8_SB(1, 1), cB + hstep + kstep, voffB);
        PG8_WAIT_V(6); PG8_BAR;
    }
    for (;;) {
        const bool has_next = S.next(ui + 1, nxt);
        const char* nA = has_next ? (const char*)g.A + (size_t)nxt.pm * tstep + (size_t)nxt.k0 * kstep : cA; const char* nB = has_next ? (const char*)g.Bt + (size_t)nxt.pn * tstep + (size_t)nxt.k0 * kstep : cB;
        const int nt = cur.nt;
        for (int t = 0; t < nt; t += 2) {
            const bool last = (t == nt - 2);
            const char* a1 = cA + (size_t)(t + 1) * kstep;
            const char* a2 = last ? nA : cA + (size_t)(t + 2) * kstep; const char* b2 = last ? nB : cB + (size_t)(t + 2) * kstep;
            const char* a3 = a2 + kstep; const char* b3 = b2 + kstep;
            if (last && has_next) S.a_ready(nxt);
            if constexpr (SP2) {
            PG8_LDB(B0, 0, 0); PG8_LDB(B1, 0, 1); PG8_SCHED; PG8_LDA(At, 0, 0); PG8_STAGE(PG8_SA(1, 1), a1 + hstep, voffA);
            PG8_WAIT_V(8); PG8_WAIT_L(0); PG8_BAR; PG8_MMA(0, 0, At, B0); PG8_MMA(0, 1, At, B1); PG8_BAR; PG8_SCHED;
            PG8_LDA(At, 0, 1); PG8_STAGE(PG8_SB(0, 0), b2, voffB); PG8_STAGE(PG8_SB(0, 1), b2 + hstep, voffB); PG8_STAGE(PG8_SA(0, 0), a2, voffA);
            PG8_WAIT_V(8); PG8_WAIT_L(0); PG8_BAR; PG8_MMA(1, 0, At, B0); PG8_MMA(1, 1, At, B1); PG8_BAR; PG8_SCHED;
            PG8_LDB(B0, 1, 0); PG8_LDB(B1, 1, 1); PG8_SCHED; PG8_LDA(At, 1, 0); PG8_STAGE(PG8_SA(0, 1), a2 + hstep, voffA);
            PG8_WAIT_V(8); PG8_WAIT_L(0); PG8_BAR; PG8_MMA(0, 0, At, B0); PG8_MMA(0, 1, At, B1); PG8_BAR; PG8_SCHED;
            PG8_LDA(At, 1, 1); PG8_STAGE(PG8_SB(1, 0), b3, voffB); PG8_STAGE(PG8_SB(1, 1), b3 + hstep, voffB); PG8_STAGE(PG8_SA(1, 0), a3, voffA);
            PG8_WAIT_V(8); PG8_WAIT_L(0); PG8_BAR; PG8_MMA(1, 0, At, B0); PG8_MMA(1, 1, At, B1); PG8_BAR; PG8_SCHED;
            } else {
            PG8_LDB(B0, 0, 0); PG8_SCHED; PG8_LDA(At, 0, 0); PG8_STAGE(PG8_SA(1, 1), a1 + hstep, voffA);
            PG8_WAIT_L(8); PG8_BAR; PG8_WAIT_L(0); PG8_MMA(0, 0, At, B0); PG8_BAR; PG8_SCHED;
            PG8_LDB(B1, 0, 1); PG8_STAGE(PG8_SB(0, 0), b2, voffB);
            PG8_BAR; PG8_WAIT_L(0); PG8_MMA(0, 1, At, B1); PG8_BAR;
            PG8_LDA(At, 0, 1); PG8_STAGE(PG8_SA(0, 0), a2, voffA);
            PG8_BAR; PG8_WAIT_L(0); PG8_MMA(1, 0, At, B0); PG8_BAR; PG8_SCHED;
            PG8_STAGE(PG8_SB(0, 1), b2 + hstep, voffB);
            PG8_WAIT_V(6); PG8_BAR; PG8_MMA(1, 1, At, B1); PG8_BAR;
            PG8_LDB(B0, 1, 0); PG8_SCHED; PG8_LDA(At, 1, 0); PG8_STAGE(PG8_SA(0, 1), a2 + hstep, voffA);
            PG8_WAIT_L(8); PG8_BAR; PG8_WAIT_L(0); PG8_MMA(0, 0, At, B0); PG8_BAR; PG8_SCHED;
            PG8_LDB(B1, 1, 1); PG8_STAGE(PG8_SB(1, 0), b3, voffB);
            PG8_BAR; PG8_WAIT_L(0); PG8_MMA(0, 1, At, B1); PG8_BAR;
            PG8_LDA(At, 1, 1); PG8_STAGE(PG8_SA(1, 0), a3, voffA);
            PG8_BAR; PG8_WAIT_L(0); PG8_MMA(1, 0, At, B0); PG8_BAR; PG8_SCHED;
            PG8_STAGE(PG8_SB(1, 1), b3 + hstep, voffB);
            PG8_WAIT_V(6); PG8_BAR; PG8_MMA(1, 1, At, B1); PG8_BAR;
            }
        }
        if constexpr (ALIGN_EPI) { if (wr == 0) PG8_BAR; }
        if constexpr (!Epi::AFTER_DRAIN) { E(acc, cur, wr, wc, fr, fq); S.done(cur); }
        if (!has_next) break;
#pragma unroll
        for (int a = 0; a < 2; ++a)
#pragma unroll
            for (int b = 0; b < 2; ++b)
#pragma unroll
                for (int m = 0; m < 4; ++m)
#pragma unroll
                    for (int n = 0; n < 2; ++n) acc[a][b][m][n] = (f32x4){0.f, 0.f, 0.f, 0.f};
        cur = nxt; cA = nA; cB = nB; ++ui;
        if constexpr (ALIGN_EPI) { if (wr == 1) PG8_BAR; }
    }
    PG8_WAIT_V(0);
    if constexpr (!ALIGN_EPI) { if (wr == 0) PG8_BAR; }
    PG8_BAR;
    if constexpr (Epi::AFTER_DRAIN) { E.fused(acc, cur, wr, wc, fr, fq, lds, wid, lane); S.done(cur); }
#undef PG8_SA
#undef PG8_SB
#undef PG8_STAGE
#undef PG8_LDA
#undef PG8_LDB
#undef PG8_MMA
#undef PG8_WAIT_V
#undef PG8_WAIT_L
#undef PG8_BAR
#undef PG8_SCHED
}
}

namespace pg8 {
struct EpiBf16P {
    static constexpr bool PERM = true, AFTER_DRAIN = false;
    bf16_t* O; int ldc;
    __device__ __forceinline__ void operator()(const f32x4 (&acc)[2][2][4][2], const Unit& u, int wr, int wc, int fr, int fq) const {
        const int row0 = u.pm * BM + wr * 64 + fr, col0 = u.pn * BM + wc * 32 + 8 * fq;
#pragma unroll
        for (int ai = 0; ai < 2; ++ai)
#pragma unroll
            for (int m = 0; m < 4; ++m) { bf16_t* rowp = O + (size_t)(row0 + ai * HALF + m * 16) * ldc + col0;
#pragma unroll
                for (int bj = 0; bj < 2; ++bj) { const f32x4 v0 = acc[ai][bj][m][0], v1 = acc[ai][bj][m][1];
                    u32x4 w; w.x = cvt_pk_bf16(v0[0], v0[1]); w.y = cvt_pk_bf16(v0[2], v0[3]); w.z = cvt_pk_bf16(v1[0], v1[1]); w.w = cvt_pk_bf16(v1[2], v1[3]);
                    *(u32x4*)(rowp + bj * HALF) = w; } }
    }
};
struct EpiH {
    static constexpr bool PERM = true, AFTER_DRAIN = false;
    bf16_t* O; float* ffn_p; float* ffn_s;
    __device__ __forceinline__ void operator()(const f32x4 (&acc)[2][2][4][2], const Unit& u, int wr, int wc, int fr, int fq) const {
        const int row0 = u.pm * BM + wr * 64 + fr, col0 = u.pn * BM + wc * 32 + 8 * fq;
#pragma unroll
        for (int ai = 0; ai < 2; ++ai)
#pragma unroll
            for (int m = 0; m < 4; ++m) { const int row = row0 + ai * HALF + m * 16; bf16_t* rowp = O + (size_t)row * 11264 + col0;
                float* tail = nullptr;
                if (row < 8192) { const int t = row & 2047; if (t >= 2046) tail = ffn_p + (size_t)((row >> 11) * 2 + (t - 2046)) * 11264 + col0; }
                else { const int r = row - 8192, t = r & 7; if (t >= 6) tail = ffn_s + (size_t)((r >> 3) * 2 + (t - 6)) * 11264 + col0; }
#pragma unroll
                for (int bj = 0; bj < 2; ++bj) { const f32x4 v0 = acc[ai][bj][m][0], v1 = acc[ai][bj][m][1];
                    u32x4 w; w.x = cvt_pk_bf16(v0[0], v0[1]); w.y = cvt_pk_bf16(v0[2], v0[3]); w.z = cvt_pk_bf16(v1[0], v1[1]); w.w = cvt_pk_bf16(v1[2], v1[3]);
                    *(u32x4*)(rowp + bj * HALF) = w;
                    if (tail) { *(f32x4*)(tail + bj * HALF) = v0; *(f32x4*)(tail + bj * HALF + 4) = v1; } } }
    }
};
struct EpiRes {
    static constexpr bool PERM = false, AFTER_DRAIN = false;
    const float* base_p; const float* base_s; float* out;
    __device__ __forceinline__ void operator()(const f32x4 (&acc)[2][2][4][2], const Unit& u, int wr, int wc, int fr, int fq) const {
        const int row0 = u.pm * BM + wr * 64 + fr, col0 = u.pn * BM + wc * 32 + 4 * fq;
        const float* base = (u.pm < 32) ? base_p : (base_s - (size_t)8192 * 2048);
#pragma unroll
        for (int ai = 0; ai < 2; ++ai)
#pragma unroll
            for (int m = 0; m < 4; ++m) { const size_t off = (size_t)(row0 + ai * HALF + m * 16) * 2048 + col0;
#pragma unroll
                for (int bj = 0; bj < 2; ++bj)
#pragma unroll
                    for (int n = 0; n < 2; ++n) { const f32x4 bs = *(const f32x4*)(base + off + bj * HALF + n * 16); *(f32x4*)(out + off + bj * HALF + n * 16) = bs + acc[ai][bj][m][n]; }
                asm volatile("" ::: "memory"); }
    }
};
struct SplitOrder {
    int c, ntk;
    __device__ void init(int K, int c_) { c = c_; ntk = K / BK; }
    __device__ bool next(int i, Unit& u) const {
        if (i == 0) { const int xcd = c & 7, j = c >> 3; u.pm = xcd * 4 + (j >> 3); u.pn = j & 7; u.k0 = 0; u.nt = ntk; u.seg = 0; return true; }
        if (i == 1) { const int uu = c >> 3, seg = c & 7, P = ntk >> 1, p0 = (seg * P) >> 3, p1 = ((seg + 1) * P) >> 3; u.pm = 32 + (uu >> 3); u.pn = uu & 7; u.k0 = 2 * p0; u.nt = 2 * (p1 - p0); u.seg = seg; return true; }
        return false;
    }
    __device__ __forceinline__ void a_ready(const Unit&) const {}
    __device__ __forceinline__ void done(const Unit&) const {}
};
struct EpiResSplit {
    static constexpr bool PERM = false, AFTER_DRAIN = false;
    const float* base_p; float* out_p; float* acc_s;
    __device__ __forceinline__ void operator()(const f32x4 (&acc)[2][2][4][2], const Unit& u, int wr, int wc, int fr, int fq) const {
        const int row0 = u.pm * BM + wr * 64 + fr, col0 = u.pn * BM + wc * 32 + 4 * fq;
        if (u.pm < 32) {
#pragma unroll
            for (int ai = 0; ai < 2; ++ai)
#pragma unroll
                for (int m = 0; m < 4; ++m) { const size_t off = (size_t)(row0 + ai * HALF + m * 16) * 2048 + col0;
#pragma unroll
                    for (int bj = 0; bj < 2; ++bj)
#pragma unroll
                        for (int n = 0; n < 2; ++n) { const f32x4 bs = *(const f32x4*)(base_p + off + bj * HALF + n * 16); *(f32x4*)(out_p + off + bj * HALF + n * 16) = bs + acc[ai][bj][m][n]; }
                    asm volatile("" ::: "memory"); }
        } else {
#pragma unroll
            for (int ai = 0; ai < 2; ++ai)
#pragma unroll
                for (int m = 0; m < 4; ++m) { float* p = acc_s + ((size_t)u.seg * 1024 + (size_t)(row0 - 8192 + ai * HALF + m * 16)) * 2048 + col0;
#pragma unroll
                    for (int bj = 0; bj < 2; ++bj)
#pragma unroll
                        for (int n = 0; n < 2; ++n) *(f32x4*)(p + bj * HALF + n * 16) = acc[ai][bj][m][n]; }
        }
    }
};
}

#define LAS __attribute__((address_space(3)))
typedef unsigned short bf16_t;
typedef float f32x4v __attribute__((ext_vector_type(4)));
typedef float f32x2v __attribute__((ext_vector_type(2)));
constexpr int MTOK = 9216, MPR = 8192, DM = 2048, NIN = 7440, NINP = 7680, DFF = 5632, DFF2 = 11264, RPROJ = 3328, OFFR = 4112;
constexpr int TT = 12, NTILES = MTOK / TT;
constexpr int LDS_BYTES = 131072;
constexpr size_t O_Y = 0, O_GDN_P = 18874368, O_GCONV_P = 19398656, O_RWKV_P = 19435520, O_SHIFT_P = 19697664, O_FFN_P = 19710976,
                 O_GDN_S = 19801088, O_GCONV_S = 36578304, O_RWKV_S = 37757952, O_SHIFT_S = 46146560, O_FFN_S = 46572544, O_END = 49456128;
constexpr size_t W_WTUP = 0, W_WTO = 46137344, W_PROJ = 54525952, W_GQKV = 196083712, W_GAB = 252706816, W_RS = 253296640, W_RV = 328794112, W_RW = 347668480, W_END1 = 385417216;
constexpr size_t W_PART = W_PROJ;
constexpr size_t W_MIXED = W_GQKV, W_H = W_WTO, W_WTDN = W_END1, W_ACT = W_H + (size_t)MTOK * DFF2 * 2 + (size_t)DM * DFF * 2, W_XN2 = W_ACT, W_END2 = W_ACT + (size_t)MTOK * DFF * 2, W_END3 = W_WTDN + (size_t)DM * DFF * 2;
static_assert(W_END2 <= W_END1 + 0, "late-phase overlay must fit");
static_assert(W_END3 == 408485888 && W_END2 == 380633088, "layout");
constexpr size_t W_BAR = W_END3, W_END4 = W_BAR + 8192;
constexpr size_t OB_WBT = O_FFN_S * 4, OB_ABT = OB_WBT + 1024 * 64 * 2, OB_GBT = OB_ABT + 1024 * 64 * 2;

struct Args { const float* in[30]; float* out; unsigned char* ws; int ph_lo, ph_hi; };

__device__ __forceinline__ float bf_lo(unsigned w) { return __uint_as_float(w << 16); }
__device__ __forceinline__ float bf_hi(unsigned w) { return __uint_as_float(w & 0xffff0000u); }
__device__ __forceinline__ unsigned pk2(float lo, float hi) { return pg8::cvt_pk_bf16(lo, hi); }
__device__ __forceinline__ unsigned pk2_safe(float lo, float hi) { unsigned r; asm volatile("s_nop 4\n\tv_cvt_pk_bf16_f32 %0, %1, %2" : "=v"(r) : "v"(lo), "v"(hi)); return r; }
__device__ __forceinline__ void unpack8(const uint4 w, float (&f)[8]) { f[0] = bf_lo(w.x); f[1] = bf_hi(w.x); f[2] = bf_lo(w.y); f[3] = bf_hi(w.y); f[4] = bf_lo(w.z); f[5] = bf_hi(w.z); f[6] = bf_lo(w.w); f[7] = bf_hi(w.w); }
__device__ __forceinline__ float wave_sum(float v) {
#pragma unroll
    for (int o = 1; o < 64; o <<= 1) v += __shfl_xor(v, o);
    return v;
}
__device__ __forceinline__ float half_sum32(float v) {
#pragma unroll
    for (int o = 1; o < 32; o <<= 1) v += __shfl_xor(v, o);
    return v;
}
__device__ __forceinline__ float sum16(float v) {
#pragma unroll
    for (int o = 1; o < 16; o <<= 1) v += __shfl_xor(v, o);
    return v;
}
template <int CTRL> __device__ __forceinline__ float dppf(float v) { return __int_as_float(__builtin_amdgcn_update_dpp(0, __float_as_int(v), CTRL, 0xF, 0xF, true)); }
__device__ __forceinline__ float reduce8(float v) {
    v += dppf<0xB1>(v);
    v += dppf<0x4E>(v);
    v += dppf<0x141>(v);
    return v;
}
__device__ __forceinline__ float sigmoidf_(float x) { return __builtin_amdgcn_rcpf(1.0f + __expf(-x)); }
__device__ __forceinline__ float siluf_(float x) { return x * __builtin_amdgcn_rcpf(1.0f + __expf(-x)); }
__device__ __forceinline__ float softplusf_(float x) { return fmaxf(x, 0.f) + __logf(1.0f + __expf(-fabsf(x))); }
__device__ __forceinline__ float tanhf_(float x) { const float e = __expf(-2.0f * fabsf(x)); const float r = (1.0f - e) * __builtin_amdgcn_rcpf(1.0f + e); return x < 0.f ? -r : r; }
__device__ __forceinline__ void rowinfo(int row, int& grp, int& b, int& t, int& T) {
    if (row < MPR) { grp = 0; b = row >> 11; t = row & 2047; T = 2048; } else { const int r = row - MPR; grp = 1; b = r >> 3; t = r & 7; T = 8; }
}
#define LDS_WAIT() asm volatile("s_waitcnt lgkmcnt(0)" ::: "memory")

__device__ __forceinline__ void transpose_item(const float* __restrict__ W, int K, int N, bf16_t* __restrict__ WT, LAS float* scr, int item, int nblk, int lane) {
    const int kb = item / nblk, nb = item - kb * nblk, k0 = 64 * kb, n0 = 64 * nb;
    const int r4 = lane >> 4, c4 = (lane & 15) * 4, n_in = n0 + c4;
    float4 v[16];
#pragma unroll
    for (int i = 0; i < 16; ++i) { if (n_in < N) { const f32x4v t_ = __builtin_nontemporal_load((const f32x4v*)(W + (size_t)(k0 + 4 * i + r4) * N + n_in)); v[i] = make_float4(t_[0], t_[1], t_[2], t_[3]); } else v[i] = make_float4(0.f, 0.f, 0.f, 0.f); }
#pragma unroll
    for (int i = 0; i < 16; ++i) { const int k = 4 * i + r4; *(LAS f32x4v*)(scr + k * 64 + (c4 ^ (8 * ((k >> 3) & 7)))) = (f32x4v){v[i].x, v[i].y, v[i].z, v[i].w}; }
    LDS_WAIT();
    const int c = lane & 7;
#pragma unroll
    for (int j = 0; j < 8; ++j) { const int n = (lane >> 3) + 8 * j; const LAS float* sp = scr + (8 * c) * 64 + (n ^ (8 * c));
        uint4 o; o.x = pk2(sp[0], sp[64]); o.y = pk2(sp[128], sp[192]); o.z = pk2(sp[256], sp[320]); o.w = pk2(sp[384], sp[448]);
        *(uint4*)(WT + (size_t)(n0 + n) * K + k0 + 8 * c) = o; }
    LDS_WAIT();
}
__device__ __forceinline__ void rms_row_bf16(const float* __restrict__ xrow, const float* __restrict__ g, bf16_t* __restrict__ orow, int lane) {
    float4 v[8]; float ss = 0.f;
#pragma unroll
    for (int j = 0; j < 8; ++j) { v[j] = ((const float4*)xrow)[lane + 64 * j]; ss += (v[j].x * v[j].x + v[j].y * v[j].y) + (v[j].z * v[j].z + v[j].w * v[j].w); }
    const float rs = rsqrtf(wave_sum(ss) * (1.0f / DM) + 1e-6f);
#pragma unroll
    for (int j = 0; j < 8; ++j) { const float4 gg = ((const float4*)g)[lane + 64 * j];
        uint2 o; o.x = pk2(v[j].x * rs * gg.x, v[j].y * rs * gg.y); o.y = pk2(v[j].z * rs * gg.z, v[j].w * rs * gg.w);
        ((uint2*)orow)[lane + 64 * j] = o; }
}
__device__ __forceinline__ void rms_row_f32_inplace(float* xrow, const float* __restrict__ g, int lane) {
    float4 v[8]; float ss = 0.f;
#pragma unroll
    for (int j = 0; j < 8; ++j) { v[j] = ((const float4*)xrow)[lane + 64 * j]; ss += (v[j].x * v[j].x + v[j].y * v[j].y) + (v[j].z * v[j].z + v[j].w * v[j].w); }
    const float rs = rsqrtf(wave_sum(ss) * (1.0f / DM) + 1e-6f);
#pragma unroll
    for (int j = 0; j < 8; ++j) { const float4 gg = ((const float4*)g)[lane + 64 * j];
        float4 o; o.x = v[j].x * rs * gg.x; o.y = v[j].y * rs * gg.y; o.z = v[j].z * rs * gg.z; o.w = v[j].w * rs * gg.w;
        ((float4*)xrow)[lane + 64 * j] = o; }
}

__device__ __forceinline__ void prep_tile(const Args& A, LAS float* lw, int tile, int tid) {
    const bf16_t* PROJ = (const bf16_t*)(A.ws + W_PROJ);
    bf16_t* GQKV = (bf16_t*)(A.ws + W_GQKV); float* GA = (float*)(A.ws + W_GAB); float* GB = GA + MTOK * 8;
    bf16_t* RS = (bf16_t*)(A.ws + W_RS); bf16_t* RV = (bf16_t*)(A.ws + W_RV); float* RW = (float*)(A.ws + W_RW);
    const float* st_gconv = A.in[3]; const float* st_shift = A.in[5];
    const int row_base = tile * TT;
    const int c0 = tid * 2;
    unsigned pw[TT + 1][3];
#pragma unroll
    for (int i = 0; i < TT + 1; ++i) { int r = row_base - 1 + i; r = r < 0 ? 0 : r; const bf16_t* pr = PROJ + (size_t)r * NINP + OFFR + c0;
        pw[i][0] = *(const unsigned*)pr; pw[i][1] = *(const unsigned*)(pr + 1024); pw[i][2] = *(const unsigned*)(pr + 2048); }
    uint4 xr[TT + 3];
    { const int chx = (tid < 384 ? tid : 383) * 8;
#pragma unroll
      for (int i = 0; i < TT + 3; ++i) { int r = row_base - 3 + i; r = r < 0 ? 0 : r; xr[i] = *(const uint4*)(PROJ + (size_t)r * NINP + chx); } }
    {
        if (tid < 4 * 68) ((LAS unsigned*)lw)[TT * 68 + tid] = 0u;
        const float* mu = A.in[13];
#pragma unroll
        for (int i = 0; i < 2; ++i) { const int item = tid + 512 * i; if (item < TT * 64) { const int tk = item >> 6, jp = item & 63, row = row_base + tk; int grp, b, t, T; rowinfo(row, grp, b, t, T);
            const int col = 3072 + 2 * jp; const unsigned pw_ = *(const unsigned*)(PROJ + (size_t)row * NINP + OFFR + col);
            float q0, q1; if (t > 0) { const unsigned qw = *(const unsigned*)(PROJ + (size_t)(row - 1) * NINP + OFFR + col); q0 = bf_lo(qw); q1 = bf_hi(qw); }
            else if (grp) { const float2 sq = *(const float2*)(st_shift + (size_t)b * RPROJ + col); q0 = sq.x; q1 = sq.y; } else { q0 = 0.f; q1 = 0.f; }
            const float2 m2 = *(const float2*)(mu + col); const float p0 = bf_lo(pw_), p1 = bf_hi(pw_);
            float x0 = p0 + (q0 - p0) * m2.x, x1 = p1 + (q1 - p1) * m2.y;
            if (jp < 32) { x0 = tanhf_(x0); x1 = tanhf_(x1); }
            ((LAS unsigned*)lw)[tk * 68 + jp] = pk2_safe(x0, x1); } }
    }
    if (tid < 384) {
        const int ch = tid * 8, stream = tid >> 7;
        const float* cwp = A.in[9];
        float cw[4][8];
#pragma unroll
        for (int i = 0; i < 4; ++i) { const float4 a0 = *(const float4*)(cwp + i * 3072 + ch), a1 = *(const float4*)(cwp + i * 3072 + ch + 4);
            cw[i][0] = a0.x; cw[i][1] = a0.y; cw[i][2] = a0.z; cw[i][3] = a0.w; cw[i][4] = a1.x; cw[i][5] = a1.y; cw[i][6] = a1.z; cw[i][7] = a1.w; }
#pragma unroll
        for (int tk = 0; tk < TT; ++tk) {
            const int row = row_base + tk; int grp, b, t, T; rowinfo(row, grp, b, t, T);
            float y[8], xl[8];
#pragma unroll
            for (int e = 0; e < 8; ++e) y[e] = 0.f;
#pragma unroll
            for (int i = 0; i < 4; ++i) { const int tt = t - 3 + i; float x[8];
                if (tt >= 0) { unpack8(xr[tk + i], x); }
                else if (grp) { const float* sp = st_gconv + ((size_t)b * 3 + (t + i)) * 3072 + ch; const float4 a0 = *(const float4*)sp, a1 = *(const float4*)(sp + 4);
                    x[0] = a0.x; x[1] = a0.y; x[2] = a0.z; x[3] = a0.w; x[4] = a1.x; x[5] = a1.y; x[6] = a1.z; x[7] = a1.w; }
                else {
#pragma unroll
                    for (int e = 0; e < 8; ++e) x[e] = 0.f; }
#pragma unroll
                for (int e = 0; e < 8; ++e) { y[e] += cw[i][e] * x[e]; if (i == 3) xl[e] = x[e]; } }
            float ss = 0.f;
#pragma unroll
            for (int e = 0; e < 8; ++e) { y[e] = siluf_(y[e]); ss += y[e] * y[e]; }
            if (stream < 2) { ss = sum16(ss); const float sc = rsqrtf(ss + 1e-12f) * (stream == 0 ? 0.08838834764831845f : 1.0f);
#pragma unroll
                for (int e = 0; e < 8; ++e) y[e] *= sc; }
            uint4 o; o.x = pk2(y[0], y[1]); o.y = pk2(y[2], y[3]); o.z = pk2(y[4], y[5]); o.w = pk2(y[6], y[7]);
            *(uint4*)(GQKV + (size_t)row * 3072 + ch) = o;
            if (t >= T - 3) { float* gp = A.out + (grp ? O_GCONV_S : O_GCONV_P) + ((size_t)b * 3 + (t - (T - 3))) * 3072 + ch;
                *(float4*)gp = make_float4(xl[0], xl[1], xl[2], xl[3]); *(float4*)(gp + 4) = make_float4(xl[4], xl[5], xl[6], xl[7]); }
        }
    } else if (tid < 384 + TT * 8) {
        const int idx = tid - 384, tk = idx >> 3, h = idx & 7, row = row_base + tk;
        const float pb = bf_lo((unsigned)PROJ[(size_t)row * NINP + 4096 + h]), pa = bf_lo((unsigned)PROJ[(size_t)row * NINP + 4104 + h]);
        const float g = -__expf(A.in[10][h]) * softplusf_(pa + A.in[11][h]);
        GA[(size_t)row * 8 + h] = __expf(g); GB[(size_t)row * 8 + h] = sigmoidf_(pb);
    }
    __syncthreads();
    {
        const int wv_ = __builtin_amdgcn_readfirstlane(tid >> 6), ti = tid & 15, quad = (tid & 63) >> 4;
        LAS float* AWL = lw + 2048; LAS float* AAL = lw + 2048 + 13364;
        const LAS unsigned char* lb = (const LAS unsigned char*)lw + ti * 272 + quad * 16;
        pg8::bf16x8 bop[4];
#pragma unroll
        for (int ks = 0; ks < 4; ++ks) bop[ks] = *(const LAS pg8::bf16x8*)(lb + ks * 64);
#pragma unroll
        for (int which = 0; which < 2; ++which) {
            const bf16_t* WT = (const bf16_t*)((const unsigned char*)A.out + (which == 0 ? OB_WBT : OB_ABT)) + (size_t)(wv_ * 128 + ti) * 64 + quad * 8;
            const float* bias = A.in[which == 0 ? 14 : 16] + wv_ * 128 + quad * 4;
            LAS float* dst = (which == 0 ? AWL : AAL) + (ti < TT ? ti : TT) * 1028 + wv_ * 128 + quad * 4;
            pg8::bf16x8 aop[8][2];
#pragma unroll
            for (int t = 0; t < 8; ++t) { aop[t][0] = *(const pg8::bf16x8*)(WT + (size_t)t * 16 * 64); aop[t][1] = *(const pg8::bf16x8*)(WT + (size_t)t * 16 * 64 + 32); }
#pragma unroll
            for (int t = 0; t < 8; ++t) {
                pg8::f32x4 c = *(const pg8::f32x4*)(bias + t * 16);
                c = __builtin_amdgcn_mfma_f32_16x16x32_bf16(aop[t][0], bop[which * 2], c, 0, 0, 0);
                c = __builtin_amdgcn_mfma_f32_16x16x32_bf16(aop[t][1], bop[which * 2 + 1], c, 0, 0, 0);
                *(LAS f32x4v*)(dst + t * 16) = (f32x4v){c[0], c[1], c[2], c[3]};
            }
        }
    }
    __syncthreads();
    f32x2v aw[TT], aa[TT];
#pragma unroll
    for (int tk = 0; tk < TT; ++tk) { aw[tk] = *(const LAS f32x2v*)(lw + 2048 + tk * 1028 + c0); aa[tk] = *(const LAS f32x2v*)(lw + 2048 + 13364 + tk * 1028 + c0); }
    {
        const float* mu = A.in[13];
        const float2 mur = *(const float2*)(mu + c0), muk = *(const float2*)(mu + 1024 + c0), muv = *(const float2*)(mu + 2048 + c0);
        const float2 kkw = *(const float2*)(A.in[19] + c0), kaw = *(const float2*)(A.in[20] + c0);
#pragma unroll
        for (int tk = 0; tk < TT; ++tk) {
            const int row = row_base + tk; int grp, b, t, T; rowinfo(row, grp, b, t, T);
            const unsigned wr_ = pw[tk + 1][0], wk_ = pw[tk + 1][1], wv_ = pw[tk + 1][2];
            float r0 = bf_lo(wr_), r1 = bf_hi(wr_), k0 = bf_lo(wk_), k1 = bf_hi(wk_), v0 = bf_lo(wv_), v1 = bf_hi(wv_);
            float pr0, pr1, pk0, pk1, pv0, pv1;
            if (t > 0) { const unsigned a_ = pw[tk][0], b_ = pw[tk][1], c_ = pw[tk][2];
                pr0 = bf_lo(a_); pr1 = bf_hi(a_); pk0 = bf_lo(b_); pk1 = bf_hi(b_); pv0 = bf_lo(c_); pv1 = bf_hi(c_); }
            else if (grp) { const float* sp = st_shift + (size_t)b * RPROJ + c0; const float2 a_ = *(const float2*)sp, b_ = *(const float2*)(sp + 1024), c_ = *(const float2*)(sp + 2048);
                pr0 = a_.x; pr1 = a_.y; pk0 = b_.x; pk1 = b_.y; pv0 = c_.x; pv1 = c_.y; }
            else { pr0 = pr1 = pk0 = pk1 = pv0 = pv1 = 0.f; }
            r0 += (pr0 - r0) * mur.x; r1 += (pr1 - r1) * mur.y; k0 += (pk0 - k0) * muk.x; k1 += (pk1 - k1) * muk.y; v0 += (pv0 - v0) * muv.x; v1 += (pv1 - v1) * muv.y;
            const float w0_ = -softplusf_(-aw[tk].x) - 0.5f, w1_ = -softplusf_(-aw[tk].y) - 0.5f;
            const float d0 = __expf(-__expf(w0_)), d1 = __expf(-__expf(w1_));
            const float a0_ = sigmoidf_(aa[tk].x), a1_ = sigmoidf_(aa[tk].y);
            float q0 = k0 * kkw.x, q1 = k1 * kkw.y;
            const float inv = rsqrtf(half_sum32(q0 * q0 + q1 * q1) + 1e-12f);
            q0 *= inv; q1 *= inv;
            const float kp0 = k0 * (1.0f + (a0_ - 1.0f) * kaw.x), kp1 = k1 * (1.0f + (a1_ - 1.0f) * kaw.y);
            bf16_t* rs = RS + (size_t)row * 4096 + c0;
            *(unsigned*)rs = pk2(q0, q1); *(unsigned*)(rs + 1024) = pk2(q0 * a0_, q1 * a1_); *(unsigned*)(rs + 2048) = pk2(kp0, kp1); *(unsigned*)(rs + 3072) = pk2(r0, r1);
            *(unsigned*)(RV + (size_t)row * 1024 + c0) = pk2(v0, v1);
            *(float2*)(RW + (size_t)row * 1024 + c0) = make_float2(d0, d1);
        }
    }
    for (int tk = 0; tk < TT; ++tk) { const int row = row_base + tk; int grp, b, t, T; rowinfo(row, grp, b, t, T);
        if (t == T - 1) { float* sp = A.out + (grp ? O_SHIFT_S : O_SHIFT_P) + (size_t)b * RPROJ;
            for (int j = tid; j < RPROJ; j += 512) sp[j] = bf_lo((unsigned)PROJ[(size_t)row * NINP + OFFR + j]); } }
    __syncthreads();
}

constexpr int SCAN_LDS_PER_WAVE = 10752;
__device__ __forceinline__ void rwkv_sample_loop(LAS float* sl, const bf16_t* __restrict__ RS, const bf16_t* __restrict__ RV, const float* __restrict__ RW, float* __restrict__ yraw,
                                                 const float* __restrict__ st_in, float* __restrict__ st_out, int task0, int stride, int lane) {
    if (task0 >= 16384) return;
    const int part = lane & 7, rr = lane >> 3;
    LAS float* SB = sl; LAS float* WB = sl + 2048; LAS float* VB = sl + 2560;
    float4 nS0, nS1; uint4 nst[4]; float4 nsw[2]; uint4 nsv = make_uint4(0, 0, 0, 0);
#define RWS_LOAD(task_) do { const int bh_ = (task_) >> 3, v0_ = ((task_) & 7) * 8, h_ = bh_ & 15, row0_ = MPR + (bh_ >> 4) * 8; \
        const float* sp_ = st_in + (size_t)bh_ * 4096 + (size_t)(v0_ + rr) * 64 + part * 8; { const f32x4v a_ = __builtin_nontemporal_load((const f32x4v*)sp_), b_ = __builtin_nontemporal_load((const f32x4v*)(sp_ + 4)); nS0 = make_float4(a_[0], a_[1], a_[2], a_[3]); nS1 = make_float4(b_[0], b_[1], b_[2], b_[3]); } \
        _Pragma("unroll") for (int i = 0; i < 4; ++i) { const int id = i * 64 + lane, step = id >> 5, s = (id >> 3) & 3, pc = id & 7; \
            nst[i] = *(const uint4*)(RS + (size_t)(row0_ + step) * 4096 + s * 1024 + h_ * 64 + pc * 8); } \
        _Pragma("unroll") for (int i = 0; i < 2; ++i) { const int id = i * 64 + lane, step = id >> 4, pc = id & 15; \
            nsw[i] = *(const float4*)(RW + (size_t)(row0_ + step) * 1024 + h_ * 64 + pc * 4); } \
        if (lane < 8) nsv = *(const uint4*)(RV + (size_t)(row0_ + lane) * 1024 + h_ * 64 + v0_); } while (0)
    RWS_LOAD(task0);
    for (int task = task0; task < 16384; task += stride) {
        const int bh = task >> 3, v0 = (task & 7) * 8, h = bh & 15, row0 = MPR + (bh >> 4) * 8;
        f32x2v S[4] = {(f32x2v){nS0.x, nS0.y}, (f32x2v){nS0.z, nS0.w}, (f32x2v){nS1.x, nS1.y}, (f32x2v){nS1.z, nS1.w}};
#pragma unroll
        for (int i = 0; i < 4; ++i) { const int id = i * 64 + lane, step = id >> 5, s = (id >> 3) & 3, pc = id & 7; float f[8]; unpack8(nst[i], f);
            LAS float* d = SB + (step * 4 + s) * 64 + pc * 8; *(LAS f32x4v*)d = (f32x4v){f[0], f[1], f[2], f[3]}; *(LAS f32x4v*)(d + 4) = (f32x4v){f[4], f[5], f[6], f[7]}; }
#pragma unroll
        for (int i = 0; i < 2; ++i) { const int id = i * 64 + lane, step = id >> 4, pc = id & 15; *(LAS f32x4v*)(WB + step * 64 + pc * 4) = (f32x4v){nsw[i].x, nsw[i].y, nsw[i].z, nsw[i].w}; }
        if (lane < 8) { float f[8]; unpack8(nsv, f); LAS float* d = VB + lane * 8; *(LAS f32x4v*)d = (f32x4v){f[0], f[1], f[2], f[3]}; *(LAS f32x4v*)(d + 4) = (f32x4v){f[4], f[5], f[6], f[7]}; }
        asm volatile("s_waitcnt lgkmcnt(0)" ::: "memory");
        __builtin_amdgcn_sched_barrier(0);
        if (task + stride < 16384) RWS_LOAD(task + stride);
        __builtin_amdgcn_sched_barrier(0);
        float ys[8];
        f32x4v kk0, kk1, ka0, ka1, kp0, kp1, r0, r1, w0, w1; float vv;
        f32x4v nkk0, nkk1, nka0, nka1, nkp0, nkp1, nr0, nr1, nw0, nw1; float nvv;
#define RW_OPS(s_) do { const LAS float* sb = SB + (s_) * 256 + part * 8; \
            nkk0 = *(const LAS f32x4v*)(sb); nkk1 = *(const LAS f32x4v*)(sb + 4); nka0 = *(const LAS f32x4v*)(sb + 64); nka1 = *(const LAS f32x4v*)(sb + 68); \
            nkp0 = *(const LAS f32x4v*)(sb + 128); nkp1 = *(const LAS f32x4v*)(sb + 132); nr0 = *(const LAS f32x4v*)(sb + 192); nr1 = *(const LAS f32x4v*)(sb + 196); \
            nw0 = *(const LAS f32x4v*)(WB + (s_) * 64 + part * 8); nw1 = *(const LAS f32x4v*)(WB + (s_) * 64 + part * 8 + 4); nvv = VB[(s_) * 8 + rr]; } while (0)
        RW_OPS(0);
#pragma unroll
        for (int s = 0; s < 8; ++s) {
            kk0 = nkk0; kk1 = nkk1; ka0 = nka0; ka1 = nka1; kp0 = nkp0; kp1 = nkp1; r0 = nr0; r1 = nr1; w0 = nw0; w1 = nw1; vv = nvv;
            if (s < 7) RW_OPS(s + 1);
            __builtin_amdgcn_sched_barrier(0);
            f32x2v acc = S[0] * kk0.lo, acc1 = S[1] * kk0.hi; acc = S[2] * kk1.lo + acc; acc1 = S[3] * kk1.hi + acc1; acc += acc1;
            const float sk = reduce8(acc.x + acc.y);
            const f32x2v nsk = (f32x2v){-sk, -sk}, vv2 = (f32x2v){vv, vv};
            S[0] = S[0] * w0.lo + (ka0.lo * nsk + kp0.lo * vv2);
            S[1] = S[1] * w0.hi + (ka0.hi * nsk + kp0.hi * vv2);
            S[2] = S[2] * w1.lo + (ka1.lo * nsk + kp1.lo * vv2);
            S[3] = S[3] * w1.hi + (ka1.hi * nsk + kp1.hi * vv2);
            f32x2v ya = S[0] * r0.lo, ya1 = S[1] * r0.hi; ya = S[2] * r1.lo + ya; ya1 = S[3] * r1.hi + ya1; ya += ya1;
            ys[s] = reduce8(ya.x + ya.y);
            __builtin_amdgcn_sched_barrier(0);
        }
#undef RW_OPS
        { float ysel = ys[0];
#pragma unroll
          for (int i = 1; i < 8; ++i) ysel = (part == i) ? ys[i] : ysel;
          yraw[(size_t)(row0 + part) * 2048 + 1024 + h * 64 + v0 + rr] = ysel; }
        { float* d = st_out + (size_t)bh * 4096 + (size_t)(v0 + rr) * 64 + part * 8; __builtin_nontemporal_store((f32x4v){S[0].x, S[0].y, S[1].x, S[1].y}, (f32x4v*)d); __builtin_nontemporal_store((f32x4v){S[2].x, S[2].y, S[3].x, S[3].y}, (f32x4v*)(d + 4)); }
        asm volatile("" ::: "memory");
    }
#undef RWS_LOAD
}
__device__ __forceinline__ void gdn_sample_loop(LAS float* sl, const bf16_t* __restrict__ GQKV, const float* __restrict__ GA, const float* __restrict__ GB, float* __restrict__ yraw,
                                                const float* __restrict__ st_in, float* __restrict__ st_out, int task0, int stride, int lane) {
    if (task0 >= 16384) return;
    const int part = lane & 7, cc = lane >> 3;
    LAS float* KB = sl; LAS float* QB = sl + 1056; LAS float* VB = sl + 2112; LAS float* AB = sl + 2176;
    const int rdoff = part * 16 + (part >> 2) * 4;
    float nS[16]; uint4 nst[4]; uint4 nsv = make_uint4(0, 0, 0, 0); float nsa = 0.f, nsb = 0.f;
#define GDS_LOAD(task_) do { const int bh_ = (task_) >> 4, j0_ = ((task_) & 15) * 8, h_ = bh_ & 7, row0_ = MPR + (bh_ >> 3) * 8; \
        const float* sp_ = st_in + (size_t)bh_ * 16384 + (size_t)(part * 16) * 128 + j0_ + cc; \
        _Pragma("unroll") for (int e = 0; e < 16; ++e) nS[e] = sp_[(size_t)e * 128]; \
        _Pragma("unroll") for (int i = 0; i < 4; ++i) { const int id = i * 64 + lane, s = id >> 7, step = (id >> 4) & 7, pc = id & 15; \
            nst[i] = *(const uint4*)(GQKV + (size_t)(row0_ + step) * 3072 + (s == 0 ? 1024 : 0) + h_ * 128 + pc * 8); } \
        if (lane < 8) { nsv = *(const uint4*)(GQKV + (size_t)(row0_ + lane) * 3072 + 2048 + h_ * 128 + j0_); \
            nsa = GA[(size_t)(row0_ + lane) * 8 + h_]; nsb = GB[(size_t)(row0_ + lane) * 8 + h_]; } } while (0)
    GDS_LOAD(task0);
    for (int task = task0; task < 16384; task += stride) {
        const int bh = task >> 4, j0 = (task & 15) * 8, h = bh & 7, row0 = MPR + (bh >> 3) * 8;
        f32x2v S[8];
#pragma unroll
        for (int e = 0; e < 8; ++e) S[e] = (f32x2v){nS[2 * e], nS[2 * e + 1]};
#pragma unroll
        for (int i = 0; i < 4; ++i) { const int id = i * 64 + lane, s = id >> 7, step = (id >> 4) & 7, pc = id & 15, pp = pc >> 1; float f[8]; unpack8(nst[i], f);
            LAS float* d = (s == 0 ? KB : QB) + step * 132 + pp * 16 + (pp >> 2) * 4 + (pc & 1) * 8; *(LAS f32x4v*)d = (f32x4v){f[0], f[1], f[2], f[3]}; *(LAS f32x4v*)(d + 4) = (f32x4v){f[4], f[5], f[6], f[7]}; }
        if (lane < 8) { float f[8]; unpack8(nsv, f); LAS float* d = VB + lane * 8; *(LAS f32x4v*)d = (f32x4v){f[0], f[1], f[2], f[3]}; *(LAS f32x4v*)(d + 4) = (f32x4v){f[4], f[5], f[6], f[7]};
            AB[lane * 2] = nsa; AB[lane * 2 + 1] = nsb; }
        asm volatile("s_waitcnt lgkmcnt(0)" ::: "memory");
        __builtin_amdgcn_sched_barrier(0);
        if (task + stride < 16384) GDS_LOAD(task + stride);
        __builtin_amdgcn_sched_barrier(0);
        float os[8];
        f32x4v k[4], q[4], nk[4], nq[4]; float v, a, beta, nv, na, nbeta;
#define GD_OPS(s_) do { const LAS float* kb = KB + (s_) * 132 + rdoff; const LAS float* qb = QB + (s_) * 132 + rdoff; \
            _Pragma("unroll") for (int i = 0; i < 4; ++i) { nk[i] = *(const LAS f32x4v*)(kb + 4 * i); nq[i] = *(const LAS f32x4v*)(qb + 4 * i); } \
            nv = VB[(s_) * 8 + cc]; na = AB[(s_) * 2]; nbeta = AB[(s_) * 2 + 1]; } while (0)
        GD_OPS(0);
#pragma unroll
        for (int s = 0; s < 8; ++s) {
#pragma unroll
            for (int i = 0; i < 4; ++i) { k[i] = nk[i]; q[i] = nq[i]; }
            v = nv; a = na; beta = nbeta;
            if (s < 7) GD_OPS(s + 1);
            __builtin_amdgcn_sched_barrier(0);
            f32x2v acc = S[0] * k[0].lo, acc1 = S[1] * k[0].hi;
#pragma unroll
            for (int i = 1; i < 4; ++i) { acc = S[2 * i] * k[i].lo + acc; acc1 = S[2 * i + 1] * k[i].hi + acc1; }
            acc += acc1;
            const float kS = reduce8(acc.x + acc.y);
            const float cf = beta * (v - a * kS);
            const f32x2v cf2 = (f32x2v){cf, cf}, a2 = (f32x2v){a, a};
#pragma unroll
            for (int i = 0; i < 4; ++i) { S[2 * i] = S[2 * i] * a2 + k[i].lo * cf2; S[2 * i + 1] = S[2 * i + 1] * a2 + k[i].hi * cf2; }
            f32x2v oa = S[0] * q[0].lo, oa1 = S[1] * q[0].hi;
#pragma unroll
            for (int i = 1; i < 4; ++i) { oa = S[2 * i] * q[i].lo + oa; oa1 = S[2 * i + 1] * q[i].hi + oa1; }
            oa += oa1;
            os[s] = reduce8(oa.x + oa.y);
            __builtin_amdgcn_sched_barrier(0);
        }
#undef GD_OPS
        { float osel = os[0];
#pragma unroll
          for (int i = 1; i < 8; ++i) osel = (part == i) ? os[i] : osel;
          yraw[(size_t)(row0 + part) * 2048 + h * 128 + j0 + cc] = osel; }
        { float* d = st_out + (size_t)bh * 16384 + (size_t)(part * 16) * 128 + j0 + cc;
#pragma unroll
          for (int e = 0; e < 8; ++e) { d[(size_t)(2 * e) * 128] = S[e].x; d[(size_t)(2 * e + 1) * 128] = S[e].y; } }
        asm volatile("" ::: "memory");
    }
#undef GDS_LOAD
}

__device__ __forceinline__ void gdn_sample_cols(LAS float* sl, const bf16_t* __restrict__ GQKV, const float* __restrict__ GA, const float* __restrict__ GB, float* __restrict__ yraw,
                                                const float* __restrict__ st_in, float* __restrict__ st_out, int task, int lane) {
    const int bh = task >> 1, j = (task & 1) * 64 + lane, h = bh & 7, row0 = MPR + (bh >> 3) * 8;
    LAS float* KB = sl; LAS float* QB = sl + 1024; LAS float* VB = sl + 2048; LAS float* AB = sl + 2560;
    f32x2v S[64];
    { const float* sp = st_in + (size_t)bh * 16384 + j;
#pragma unroll
      for (int i = 0; i < 64; ++i) { S[i] = (f32x2v){__builtin_nontemporal_load(sp), __builtin_nontemporal_load(sp + 128)}; sp += 256; asm volatile("" : "+v"(sp)); } }
    {
        uint4 st[4];
#pragma unroll
        for (int i = 0; i < 4; ++i) { const int id = i * 64 + lane, s = id >> 7, step = (id >> 4) & 7, pc = id & 15;
            st[i] = *(const uint4*)(GQKV + (size_t)(row0 + step) * 3072 + (s == 0 ? 1024 : 0) + h * 128 + pc * 8); }
        unsigned short vv[8];
#pragma unroll
        for (int s = 0; s < 8; ++s) vv[s] = GQKV[(size_t)(row0 + s) * 3072 + 2048 + h * 128 + j];
        float sa = 0.f, sbt = 0.f;
        if (lane < 8) { sa = GA[(size_t)(row0 + lane) * 8 + h]; sbt = GB[(size_t)(row0 + lane) * 8 + h]; }
#pragma unroll
        for (int i = 0; i < 4; ++i) { const int id = i * 64 + lane, s = id >> 7, step = (id >> 4) & 7, pc = id & 15; float f[8]; unpack8(st[i], f);
            LAS float* d = (s == 0 ? KB : QB) + step * 128 + pc * 8; *(LAS f32x4v*)d = (f32x4v){f[0], f[1], f[2], f[3]}; *(LAS f32x4v*)(d + 4) = (f32x4v){f[4], f[5], f[6], f[7]}; }
#pragma unroll
        for (int s = 0; s < 8; ++s) VB[s * 64 + lane] = bf_lo((unsigned)vv[s]);
        if (lane < 8) { AB[lane * 2] = sa; AB[lane * 2 + 1] = sbt; }
        asm volatile("s_waitcnt lgkmcnt(0)" ::: "memory");
    }
#pragma unroll 1
    for (int s = 0; s < 8; ++s) {
        const LAS float* kb = KB + s * 128; const LAS float* qb = QB + s * 128;
        const float v = VB[s * 64 + lane], a = AB[s * 2], beta = AB[s * 2 + 1];
        f32x2v acc0 = (f32x2v){0.f, 0.f}, acc1 = (f32x2v){0.f, 0.f};
#pragma unroll
        for (int i = 0; i < 32; ++i) { const f32x4v kq = *(const LAS f32x4v*)(kb + 4 * i); acc0 = S[2 * i] * kq.lo + acc0; acc1 = S[2 * i + 1] * kq.hi + acc1; if ((i & 7) == 7) __builtin_amdgcn_sched_barrier(0); }
        acc0 += acc1;
        const float kS = acc0.x + acc0.y;
        const float cf = beta * (v - a * kS);
        const f32x2v cf2 = (f32x2v){cf, cf}, a2 = (f32x2v){a, a};
        f32x2v o0 = (f32x2v){0.f, 0.f}, o1 = (f32x2v){0.f, 0.f};
#pragma unroll
        for (int i = 0; i < 32; ++i) { const f32x4v kq = *(const LAS f32x4v*)(kb + 4 * i), qq = *(const LAS f32x4v*)(qb + 4 * i);
            S[2 * i] = S[2 * i] * a2 + kq.lo * cf2; S[2 * i + 1] = S[2 * i + 1] * a2 + kq.hi * cf2;
            o0 = S[2 * i] * qq.lo + o0; o1 = S[2 * i + 1] * qq.hi + o1; if ((i & 3) == 3) __builtin_amdgcn_sched_barrier(0); }
        o0 += o1;
        yraw[(size_t)(row0 + s) * 2048 + h * 128 + j] = o0.x + o0.y;
    }
    { float* dp = st_out + (size_t)bh * 16384 + j;
#pragma unroll
      for (int i = 0; i < 64; ++i) { __builtin_nontemporal_store(S[i].x, dp); __builtin_nontemporal_store(S[i].y, dp + 128); dp += 256; asm volatile("" : "+v"(dp)); } }
    asm volatile("s_waitcnt lgkmcnt(0)" ::: "memory");
}

__device__ __forceinline__ float reduce16(float v) { v = reduce8(v); v += dppf<0x140>(v); return v; }
__device__ __forceinline__ void gdn_prompt_block(LAS float* L, const bf16_t* __restrict__ GQKV, const float* __restrict__ GA, const float* __restrict__ GB, float* __restrict__ yraw,
                                                 int row0, int T, int h, int jblk, float* __restrict__ s_out, int tid, int wave, int lane) {
    constexpr int BUF = 4768;
    const int part = lane & 15, cc = lane >> 4, j0 = jblk + wave * 4, rdoff = part * 8 + (part >> 3) * 4;
    f32x2v S[4];
#pragma unroll
    for (int e = 0; e < 4; ++e) S[e] = (f32x2v){0.f, 0.f};
    const int ss = tid >> 8, sstep = (tid >> 4) & 15, spc = tid & 15, vstep = (tid >> 2) & 15, vp = tid & 3, astep = tid & 15;
    uint4 st, sv = make_uint4(0, 0, 0, 0); float sa = 0.f, sbt = 0.f;
    const int nch = T >> 4;
#define GB_LOAD(c) do { const int t0_ = (c) * 16; st = *(const uint4*)(GQKV + (size_t)(row0 + t0_ + sstep) * 3072 + (ss == 0 ? 1024 : 0) + h * 128 + spc * 8); \
        if (tid < 64) sv = *(const uint4*)(GQKV + (size_t)(row0 + t0_ + vstep) * 3072 + 2048 + h * 128 + jblk + vp * 8); \
        else if (tid < 80) { sa = GA[(size_t)(row0 + t0_ + astep) * 8 + h]; sbt = GB[(size_t)(row0 + t0_ + astep) * 8 + h]; } } while (0)
#define GB_WRITE(b) do { LAS float* base = L + (b) * BUF; { float f[8]; unpack8(st, f); LAS float* d = base + ss * 2112 + sstep * 132 + spc * 8 + (spc >> 3) * 4; \
            *(LAS f32x4v*)d = (f32x4v){f[0], f[1], f[2], f[3]}; *(LAS f32x4v*)(d + 4) = (f32x4v){f[4], f[5], f[6], f[7]}; } \
        if (tid < 64) { float f[8]; unpack8(sv, f); LAS float* d = base + 4224 + vstep * 32 + vp * 8; *(LAS f32x4v*)d = (f32x4v){f[0], f[1], f[2], f[3]}; *(LAS f32x4v*)(d + 4) = (f32x4v){f[4], f[5], f[6], f[7]}; } \
        else if (tid < 80) { base[4736 + astep * 2] = sa; base[4736 + astep * 2 + 1] = sbt; } } while (0)
    GB_LOAD(0); GB_WRITE(0);
    __syncthreads();
    for (int c = 0; c < nch; ++c) {
        if (c + 1 < nch) GB_LOAD(c + 1);
        __builtin_amdgcn_sched_barrier(0);
        const LAS float* base = L + (c & 1) * BUF;
        float os[16];
        f32x2v k[4], q[4], nk[4], nq[4]; float v, a, beta, nv, na, nbeta;
#define GB_OPS(s_) do { const LAS float* kb = base + (s_) * 132 + rdoff; const LAS float* qb = base + 2112 + (s_) * 132 + rdoff; \
            _Pragma("unroll") for (int i = 0; i < 2; ++i) { const f32x4v t0 = *(const LAS f32x4v*)(kb + 4 * i), t1 = *(const LAS f32x4v*)(qb + 4 * i); \
                nk[2 * i] = t0.lo; nk[2 * i + 1] = t0.hi; nq[2 * i] = t1.lo; nq[2 * i + 1] = t1.hi; } \
            nv = base[4224 + (s_) * 32 + wave * 4 + cc]; na = base[4736 + (s_) * 2]; nbeta = base[4736 + (s_) * 2 + 1]; } while (0)
        GB_OPS(0);
#pragma unroll
        for (int s = 0; s < 16; ++s) {
#pragma unroll
            for (int i = 0; i < 4; ++i) { k[i] = nk[i]; q[i] = nq[i]; }
            v = nv; a = na; beta = nbeta;
            if (s < 15) GB_OPS(s + 1);
            __builtin_amdgcn_sched_barrier(0);
            f32x2v acc = S[0] * k[0], acc1 = S[1] * k[1]; acc = S[2] * k[2] + acc; acc1 = S[3] * k[3] + acc1; acc += acc1;
            const float kS = reduce16(acc.x + acc.y);
            const float cf = beta * (v - a * kS);
            const f32x2v cf2 = (f32x2v){cf, cf}, a2 = (f32x2v){a, a};
#pragma unroll
            for (int i = 0; i < 4; ++i) S[i] = S[i] * a2 + k[i] * cf2;
            f32x2v oa = S[0] * q[0], oa1 = S[1] * q[1]; oa = S[2] * q[2] + oa; oa1 = S[3] * q[3] + oa1; oa += oa1;
            os[s] = reduce16(oa.x + oa.y);
            __builtin_amdgcn_sched_barrier(0);
        }
#undef GB_OPS
        { float osel = os[0];
#pragma unroll
          for (int i = 1; i < 16; ++i) osel = (part == i) ? os[i] : osel;
          yraw[(size_t)(row0 + c * 16 + part) * 2048 + h * 128 + j0 + cc] = osel; }
        if (c + 1 < nch) GB_WRITE((c + 1) & 1);
        __syncthreads();
    }
#undef GB_LOAD
#undef GB_WRITE
#pragma unroll
    for (int e = 0; e < 4; ++e) { s_out[(size_t)(part * 8 + 2 * e) * 128 + j0 + cc] = S[e].x; s_out[(size_t)(part * 8 + 2 * e + 1) * 128 + j0 + cc] = S[e].y; }
}
__device__ __forceinline__ void rwkv_prompt_block(LAS float* L, const bf16_t* __restrict__ RS, const bf16_t* __restrict__ RV, const float* __restrict__ RW, float* __restrict__ yraw,
                                                  int row0, int T, int h, int vblk, float* __restrict__ s_out, int tid, int wave, int lane) {
    constexpr int BUF = 5632;
    const int part = lane & 15, rr = lane >> 4, v0 = vblk + wave * 4;
    f32x2v S[2] = {(f32x2v){0.f, 0.f}, (f32x2v){0.f, 0.f}};
    const int sstep = tid >> 5, ss = (tid >> 3) & 3, spc = tid & 7, wstep = (tid >> 4) & 15, wpc = tid & 15, vstep = (tid >> 2) & 15, vp = tid & 3;
    uint4 st, sv = make_uint4(0, 0, 0, 0); float4 sw = make_float4(0.f, 0.f, 0.f, 0.f);
    const int nch = T >> 4;
#define RB_LOAD(c) do { const int t0_ = (c) * 16; st = *(const uint4*)(RS + (size_t)(row0 + t0_ + sstep) * 4096 + ss * 1024 + h * 64 + spc * 8); \
        if (tid < 256) sw = *(const float4*)(RW + (size_t)(row0 + t0_ + wstep) * 1024 + h * 64 + wpc * 4); \
        else if (tid < 320) sv = *(const uint4*)(RV + (size_t)(row0 + t0_ + vstep) * 1024 + h * 64 + vblk + vp * 8); } while (0)
#define RB_WRITE(b) do { LAS float* base = L + (b) * BUF; { float f[8]; unpack8(st, f); LAS float* d = base + (sstep * 4 + ss) * 64 + spc * 8; \
            *(LAS f32x4v*)d = (f32x4v){f[0], f[1], f[2], f[3]}; *(LAS f32x4v*)(d + 4) = (f32x4v){f[4], f[5], f[6], f[7]}; } \
        if (tid < 256) *(LAS f32x4v*)(base + 4096 + wstep * 64 + wpc * 4) = (f32x4v){sw.x, sw.y, sw.z, sw.w}; \
        else if (tid < 320) { float f[8]; unpack8(sv, f); LAS float* d = base + 5120 + vstep * 32 + vp * 8; *(LAS f32x4v*)d = (f32x4v){f[0], f[1], f[2], f[3]}; *(LAS f32x4v*)(d + 4) = (f32x4v){f[4], f[5], f[6], f[7]}; } } while (0)
    RB_LOAD(0); RB_WRITE(0);
    __syncthreads();
    for (int c = 0; c < nch; ++c) {
        if (c + 1 < nch) RB_LOAD(c + 1);
        __builtin_amdgcn_sched_barrier(0);
        const LAS float* base = L + (c & 1) * BUF;
        float ys[16];
        f32x4v kk, ka, kp, r, w, nkk, nka, nkp, nr, nw; float vv, nvv;
#define RB_OPS(s_) do { const LAS float* sb = base + (s_) * 256 + part * 4; nkk = *(const LAS f32x4v*)(sb); nka = *(const LAS f32x4v*)(sb + 64); nkp = *(const LAS f32x4v*)(sb + 128); nr = *(const LAS f32x4v*)(sb + 192); \
            nw = *(const LAS f32x4v*)(base + 4096 + (s_) * 64 + part * 4); nvv = base[5120 + (s_) * 32 + wave * 4 + rr]; } while (0)
        RB_OPS(0);
#pragma unroll
        for (int s = 0; s < 16; ++s) {
            kk = nkk; ka = nka; kp = nkp; r = nr; w = nw; vv = nvv;
            if (s < 15) RB_OPS(s + 1);
            __builtin_amdgcn_sched_barrier(0);
            f32x2v acc = S[0] * kk.lo + S[1] * kk.hi;
            const float sk = reduce16(acc.x + acc.y);
            const f32x2v nsk = (f32x2v){-sk, -sk}, vv2 = (f32x2v){vv, vv};
            S[0] = S[0] * w.lo + (ka.lo * nsk + kp.lo * vv2);
            S[1] = S[1] * w.hi + (ka.hi * nsk + kp.hi * vv2);
            f32x2v ya = S[0] * r.lo + S[1] * r.hi;
            ys[s] = reduce16(ya.x + ya.y);
            __builtin_amdgcn_sched_barrier(0);
        }
#undef RB_OPS
        { float ysel = ys[0];
#pragma unroll
          for (int i = 1; i < 16; ++i) ysel = (part == i) ? ys[i] : ysel;
          yraw[(size_t)(row0 + c * 16 + part) * 2048 + 1024 + h * 64 + v0 + rr] = ysel; }
        if (c + 1 < nch) RB_WRITE((c + 1) & 1);
        __syncthreads();
    }
#undef RB_LOAD
#undef RB_WRITE
    *(float4*)(s_out + (size_t)(v0 + rr) * 64 + part * 4) = make_float4(S[0].x, S[0].y, S[1].x, S[1].y);
}

__device__ __forceinline__ void post_tile(const Args& A, LAS float* lg, int tile, int tid) {
    const bf16_t* PROJ = (const bf16_t*)(A.ws + W_PROJ);
    const bf16_t* RS = (const bf16_t*)(A.ws + W_RS); const bf16_t* RV = (const bf16_t*)(A.ws + W_RV);
    bf16_t* MIXED = (bf16_t*)(A.ws + W_MIXED);
    const float* yraw = A.out + O_Y; const float* st_shift = A.in[5];
    const int row_base = tile * TT;
    const int c0 = tid * 2;
    float2 yv[TT], ov[TT]; unsigned rwv[TT], kwv[TT], vwv[TT], zwv[TT];
#pragma unroll
    for (int tk = 0; tk < TT; ++tk) { const int row = row_base + tk;
        yv[tk] = *(const float2*)(yraw + (size_t)row * 2048 + 1024 + c0); ov[tk] = *(const float2*)(yraw + (size_t)row * 2048 + c0);
        rwv[tk] = *(const unsigned*)(RS + (size_t)row * 4096 + 3072 + c0); kwv[tk] = *(const unsigned*)(RS + (size_t)row * 4096 + 2048 + c0); vwv[tk] = *(const unsigned*)(RV + (size_t)row * 1024 + c0);
        zwv[tk] = *(const unsigned*)(PROJ + (size_t)row * NINP + 3072 + c0); }
    {
        if (tid < 4 * 68) ((LAS unsigned*)lg)[TT * 68 + tid] = 0u;
        const float* mu = A.in[13];
#pragma unroll
        for (int i = 0; i < 2; ++i) { const int item = tid + 512 * i; if (item < TT * 64) { const int tk = item >> 6, jp = item & 63, row = row_base + tk; int grp, b, t, T; rowinfo(row, grp, b, t, T);
            const int col = 3200 + 2 * jp; const unsigned pw_ = *(const unsigned*)(PROJ + (size_t)row * NINP + OFFR + col);
            float q0, q1; if (t > 0) { const unsigned qw = *(const unsigned*)(PROJ + (size_t)(row - 1) * NINP + OFFR + col); q0 = bf_lo(qw); q1 = bf_hi(qw); }
            else if (grp) { const float2 sq = *(const float2*)(st_shift + (size_t)b * RPROJ + col); q0 = sq.x; q1 = sq.y; } else { q0 = 0.f; q1 = 0.f; }
            const float2 m2 = *(const float2*)(mu + col); const float p0 = bf_lo(pw_), p1 = bf_hi(pw_);
            ((LAS unsigned*)lg)[tk * 68 + jp] = pk2_safe(sigmoidf_(p0 + (q0 - p0) * m2.x), sigmoidf_(p1 + (q1 - p1) * m2.y)); } }
    }
    __syncthreads();
    {
        const int wv_ = __builtin_amdgcn_readfirstlane(tid >> 6), ti = tid & 15, quad = (tid & 63) >> 4;
        const LAS unsigned char* lb = (const LAS unsigned char*)lg + ti * 272 + quad * 16;
        pg8::bf16x8 bop[4];
#pragma unroll
        for (int ks = 0; ks < 4; ++ks) bop[ks] = *(const LAS pg8::bf16x8*)(lb + ks * 64);
        const bf16_t* WT = (const bf16_t*)((const unsigned char*)A.out + OB_GBT) + (size_t)(wv_ * 128 + ti) * 128 + quad * 8;
        LAS float* dst = lg + 2048 + (ti < TT ? ti : TT) * 1028 + wv_ * 128 + quad * 4;
#pragma unroll
        for (int hh = 0; hh < 2; ++hh) {
            pg8::bf16x8 aop[4][4];
#pragma unroll
            for (int t = 0; t < 4; ++t)
#pragma unroll
                for (int ks = 0; ks < 4; ++ks) aop[t][ks] = *(const pg8::bf16x8*)(WT + (size_t)(hh * 4 + t) * 16 * 128 + ks * 32);
#pragma unroll
            for (int t = 0; t < 4; ++t) {
                pg8::f32x4 c = (pg8::f32x4){0.f, 0.f, 0.f, 0.f};
#pragma unroll
                for (int ks = 0; ks < 4; ++ks) c = __builtin_amdgcn_mfma_f32_16x16x32_bf16(aop[t][ks], bop[ks], c, 0, 0, 0);
                *(LAS f32x4v*)(dst + (hh * 4 + t) * 16) = (f32x4v){c[0], c[1], c[2], c[3]};
            }
        }
    }
    __syncthreads();
    f32x2v gate[TT];
#pragma unroll
    for (int tk = 0; tk < TT; ++tk) gate[tk] = *(const LAS f32x2v*)(lg + 2048 + tk * 1028 + c0);
    const float2 gnw = *(const float2*)(A.in[22] + c0), gnb = *(const float2*)(A.in[23] + c0), rk = *(const float2*)(A.in[21] + c0);
    const float2 ng = *(const float2*)(A.in[12] + (c0 & 127));
#pragma unroll
    for (int tk = 0; tk < TT; ++tk) {
        const int row = row_base + tk;
        {
            const float2 y = yv[tk];
            const float mean = half_sum32(y.x + y.y) * (1.0f / 64.0f);
            const float d0 = y.x - mean, d1 = y.y - mean;
            const float var = half_sum32(d0 * d0 + d1 * d1) * (1.0f / 64.0f);
            const float rs = rsqrtf(var + 64e-5f);
            const unsigned rw = rwv[tk], kw = kwv[tk], vw = vwv[tk];
            const float bon = half_sum32(bf_lo(rw) * bf_lo(kw) * rk.x + bf_hi(rw) * bf_hi(kw) * rk.y);
            const float o0 = (d0 * rs * gnw.x + gnb.x + bon * bf_lo(vw)) * gate[tk].x, o1 = (d1 * rs * gnw.y + gnb.y + bon * bf_hi(vw)) * gate[tk].y;
            *(unsigned*)(MIXED + (size_t)row * 2048 + 1024 + c0) = pk2(o0, o1);
        }
        {
            const float2 o = ov[tk];
            const float rs = rsqrtf(wave_sum(o.x * o.x + o.y * o.y) * (1.0f / 128.0f) + 1e-6f);
            const unsigned zw = zwv[tk];
            *(unsigned*)(MIXED + (size_t)row * 2048 + c0) = pk2(o.x * rs * ng.x * siluf_(bf_lo(zw)), o.y * rs * ng.y * siluf_(bf_hi(zw)));
        }
    }
    __syncthreads();
}

__device__ __forceinline__ void act_item(const Args& A, int item, int lane) {
    const bf16_t* H = (const bf16_t*)(A.ws + W_H); bf16_t* ACT = (bf16_t*)(A.ws + W_ACT);
    const float* cwp = A.in[27]; const float* st_ffn = A.in[6];
    const int cgp = item % 11, rg = item / 11, ch = (cgp * 64 + lane) * 8;
    float cg_[3][8], cu_[3][8];
#pragma unroll
    for (int i = 0; i < 3; ++i) { const float4 a0 = *(const float4*)(cwp + (size_t)i * DFF2 + ch), a1 = *(const float4*)(cwp + (size_t)i * DFF2 + ch + 4), b0 = *(const float4*)(cwp + (size_t)i * DFF2 + DFF + ch), b1 = *(const float4*)(cwp + (size_t)i * DFF2 + DFF + ch + 4);
        cg_[i][0] = a0.x; cg_[i][1] = a0.y; cg_[i][2] = a0.z; cg_[i][3] = a0.w; cg_[i][4] = a1.x; cg_[i][5] = a1.y; cg_[i][6] = a1.z; cg_[i][7] = a1.w;
        cu_[i][0] = b0.x; cu_[i][1] = b0.y; cu_[i][2] = b0.z; cu_[i][3] = b0.w; cu_[i][4] = b1.x; cu_[i][5] = b1.y; cu_[i][6] = b1.z; cu_[i][7] = b1.w; }
    uint4 hg[11], hu[11];
#pragma unroll
    for (int i = 0; i < 11; ++i) { int r = rg * 9 - 2 + i; r = r < 0 ? 0 : r; hg[i] = *(const uint4*)(H + (size_t)r * DFF2 + ch); hu[i] = *(const uint4*)(H + (size_t)r * DFF2 + DFF + ch); }
#pragma unroll
    for (int rI = 0; rI < 9; ++rI) {
        const int row = rg * 9 + rI; int grp, b, t, T; rowinfo(row, grp, b, t, T);
        float g[8], u[8];
#pragma unroll
        for (int e = 0; e < 8; ++e) { g[e] = 0.f; u[e] = 0.f; }
#pragma unroll
        for (int i = 0; i < 3; ++i) { const int tt = t - 2 + i; float xg[8], xu[8];
            if (tt >= 0) { unpack8(hg[rI + i], xg); unpack8(hu[rI + i], xu); }
            else if (grp) { const float* sp = st_ffn + ((size_t)b * 2 + (t + i)) * DFF2 + ch; const float4 a0 = *(const float4*)sp, a1 = *(const float4*)(sp + 4), b0 = *(const float4*)(sp + DFF), b1 = *(const float4*)(sp + DFF + 4);
                xg[0] = a0.x; xg[1] = a0.y; xg[2] = a0.z; xg[3] = a0.w; xg[4] = a1.x; xg[5] = a1.y; xg[6] = a1.z; xg[7] = a1.w;
                xu[0] = b0.x; xu[1] = b0.y; xu[2] = b0.z; xu[3] = b0.w; xu[4] = b1.x; xu[5] = b1.y; xu[6] = b1.z; xu[7] = b1.w; }
            else {
#pragma unroll
                for (int e = 0; e < 8; ++e) { xg[e] = 0.f; xu[e] = 0.f; } }
#pragma unroll
            for (int e = 0; e < 8; ++e) { g[e] += cg_[i][e] * xg[e]; u[e] += cu_[i][e] * xu[e]; } }
        float o[8];
#pragma unroll
        for (int e = 0; e < 8; ++e) o[e] = siluf_(g[e]) * u[e];
        uint4 w; w.x = pk2(o[0], o[1]); w.y = pk2(o[2], o[3]); w.z = pk2(o[4], o[5]); w.w = pk2(o[6], o[7]);
        *(uint4*)(ACT + (size_t)row * DFF + ch) = w;
    }
}

__device__ __forceinline__ void fast_grid_barrier(unsigned* bar, unsigned round, unsigned G) {
    asm volatile("s_waitcnt vmcnt(0)" ::: "memory");
    __syncthreads();
    if (threadIdx.x == 0) {
        __builtin_amdgcn_fence(__ATOMIC_RELEASE, "agent");
        asm volatile("s_waitcnt vmcnt(0)" ::: "memory");
        const unsigned g = blockIdx.x >> 4, ngroups = (G + 15u) >> 4, gsize = (G - g * 16u) < 16u ? (G - g * 16u) : 16u;
        unsigned* cnt = bar + 32u * (1u + g); unsigned* top = bar + 32u * 20u; unsigned* gen = bar + 32u * (24u + g);
        const unsigned old = __hip_atomic_fetch_add(cnt, 1u, __ATOMIC_RELAXED, __HIP_MEMORY_SCOPE_AGENT);
        if (old + 1u == round * gsize) {
            const unsigned t = __hip_atomic_fetch_add(top, 1u, __ATOMIC_RELAXED, __HIP_MEMORY_SCOPE_AGENT);
            if (t + 1u == round * ngroups) { for (unsigned q = 0; q < ngroups; ++q) __hip_atomic_store(bar + 32u * (24u + q), round, __ATOMIC_RELAXED, __HIP_MEMORY_SCOPE_AGENT); }
        }
        unsigned sp = 0u;
        while (__hip_atomic_load(gen, __ATOMIC_RELAXED, __HIP_MEMORY_SCOPE_AGENT) < round) { __builtin_amdgcn_s_sleep(1); if (++sp > (1u << 22)) break; }
        __builtin_amdgcn_fence(__ATOMIC_ACQUIRE, "agent");
        asm volatile("s_waitcnt vmcnt(0)" ::: "memory");
    }
    __syncthreads();
}

__global__ void __launch_bounds__(512, 2) hymba_fwd(Args A) {
    extern __shared__ __attribute__((aligned(16))) unsigned char lds_raw[];
    LAS unsigned char* lds = (LAS unsigned char*)lds_raw;
    cg::grid_group grid = cg::this_grid();
    const int tid = threadIdx.x, lane = tid & 63, wave = __builtin_amdgcn_readfirstlane(tid >> 6);
    const int G = gridDim.x, bx = blockIdx.x, gw = bx * 8 + wave, NGW = G * 8;
    const int lo = A.ph_lo, hi = A.ph_hi;
#define IN(k) (lo <= (k) && (k) < hi)
    unsigned* barcnt = (unsigned*)(A.ws + W_BAR); unsigned nbar = 0u;
#define SEAM(k) do { if (IN(k) && IN((k) + 1)) { ++nbar; fast_grid_barrier(barcnt, nbar, (unsigned)G); } } while (0)
    if (hi < 0) grid.sync();
    unsigned char* ws = A.ws; float* out = A.out;
    bf16_t* XN = (bf16_t*)(out + O_GDN_S);
    bf16_t* WT_IN = (bf16_t*)(out + O_RWKV_S);
    bf16_t* WT_O = (bf16_t*)(ws + W_WTO); bf16_t* WT_UP = (bf16_t*)(ws + W_WTUP); bf16_t* WT_DN = (bf16_t*)(ws + W_WTDN);
    bf16_t* PROJ = (bf16_t*)(ws + W_PROJ); bf16_t* MIXED = (bf16_t*)(ws + W_MIXED); bf16_t* XN2 = (bf16_t*)(ws + W_XN2);
    bf16_t* HB = (bf16_t*)(ws + W_H); bf16_t* ACT = (bf16_t*)(ws + W_ACT);
    float* X1 = out + O_Y; float* PART = (float*)(ws + W_PART);

    if (IN(0)) {
        LAS float* scr = (LAS float*)(lds + wave * 16384);
        constexpr int I_IN = 32 * (NINP / 64);
        for (int it = gw; it < I_IN; it += NGW) transpose_item(A.in[8], DM, NIN, WT_IN, scr, it, NINP / 64, lane);
        for (int i = bx * 512 + tid; i < 4096 * 8; i += G * 512) {
            int r = (i >> 9) * 64 + (i & 63); const int q = (i >> 6) & 7; const float* W; bf16_t* WT; int K, j0;
            if (r < 1024) { W = A.in[15]; WT = (bf16_t*)((unsigned char*)out + OB_WBT); K = 64; j0 = 0; }
            else if (r < 2048) { r -= 1024; W = A.in[17]; WT = (bf16_t*)((unsigned char*)out + OB_ABT); K = 64; j0 = 0; }
            else { r -= 2048; W = A.in[18]; WT = (bf16_t*)((unsigned char*)out + OB_GBT); K = 128; j0 = (r >> 10) * 64; r &= 1023; }
            const int ch = r;
            float f[8];
#pragma unroll
            for (int e = 0; e < 8; ++e) f[e] = W[(size_t)(j0 + q * 8 + e) * 1024 + ch];
            uint4 o; o.x = pk2(f[0], f[1]); o.y = pk2(f[2], f[3]); o.z = pk2(f[4], f[5]); o.w = pk2(f[6], f[7]);
            *(uint4*)(WT + (size_t)ch * K + j0 + q * 8) = o;
        }
        for (int m = gw; m < MTOK; m += NGW) { const float* xr = (m < MPR) ? A.in[0] + (size_t)m * DM : A.in[1] + (size_t)(m - MPR) * DM; rms_row_bf16(xr, A.in[7], XN + (size_t)m * DM, lane); }
        __syncthreads();
    }
    SEAM(0);
    if (IN(1)) {
        pg8::Gemm g{XN, WT_IN, MTOK, NINP, DM}; pg8::StaticOrder S; S.init(MTOK, NINP, DM, G, bx);
        pg8::EpiBf16P E{PROJ, NINP};
        pg8::gemm_phase<pg8::EpiBf16P, pg8::StaticOrder, true, true>(lds, g, S, E);
    }
    SEAM(1);
    if (IN(2)) { for (int tile = bx; tile < NTILES; tile += G) prep_tile(A, (LAS float*)lds, tile, tid); }
    SEAM(2);
    if (IN(3)) {
        LAS float* sl = (LAS float*)(lds + wave * 16384);
        const bf16_t* GQKV = (const bf16_t*)(ws + W_GQKV); const float* GA = (const float*)(ws + W_GAB); const float* GB = GA + MTOK * 8;
        const bf16_t* RS = (const bf16_t*)(ws + W_RS); const bf16_t* RV = (const bf16_t*)(ws + W_RV); const float* RW = (const float*)(ws + W_RW);
        float* yraw = out + O_Y;
        const bool heavy = (G == 256) && (bx >= 128);
        const int nshare = (G == 256) ? 3072 : NGW, share0 = (G == 256) ? (heavy ? 1024 + ((bx - 128) * 8 + wave) * 2 : gw) : gw, nsh = heavy ? 2 : 1;
        for (int task = gw; task < 2048; task += NGW) gdn_sample_cols(sl, GQKV, GA, GB, yraw, A.in[2], out + O_GDN_S, task, lane);
        for (int sh = 0; sh < nsh; ++sh) {
            rwkv_sample_loop(sl, RS, RV, RW, yraw, A.in[4], out + O_RWKV_S, share0 + sh, nshare, lane);
            constexpr int I_O = 32 * (DM / 64), I_UP = 32 * (DFF2 / 64), I_DN = (DFF / 64) * (DM / 64);
            for (int it = share0 + sh; it < I_O + I_UP + I_DN; it += nshare) {
                int r = it;
                if (r < I_O) { transpose_item(A.in[24], DM, DM, WT_O, sl, r, DM / 64, lane); continue; } r -= I_O;
                if (r < I_UP) { transpose_item(A.in[26], DM, DFF2, WT_UP, sl, r, DFF2 / 64, lane); continue; } r -= I_UP;
                transpose_item(A.in[28], DFF, DM, WT_DN, sl, r, DM / 64, lane);
            }
        }
        __syncthreads();
        for (int u = bx; u < 256; u += G) {
            if (u < 128) { const int bh = u >> 2, cq = u & 3;
                gdn_prompt_block((LAS float*)lds, GQKV, GA, GB, yraw, (bh >> 3) * 2048, 2048, bh & 7, cq * 32, out + O_GDN_P + (size_t)bh * 16384, tid, wave, lane); }
            else { const int uu = u - 128, bh = uu >> 1, hf = uu & 1;
                rwkv_prompt_block((LAS float*)lds, RS, RV, RW, yraw, (bh >> 4) * 2048, 2048, bh & 15, hf * 32, out + O_RWKV_P + (size_t)bh * 4096, tid, wave, lane); }
        }
        __syncthreads();
    }
    SEAM(3);
    if (IN(4)) {
        for (int tile = bx; tile < NTILES; tile += G) post_tile(A, (LAS float*)lds, tile, tid);
    }
    SEAM(4);
    if (IN(5)) {
        pg8::Gemm g{MIXED, WT_O, MTOK, DM, DM}; pg8::SplitOrder S; S.init(DM, bx);
        pg8::EpiResSplit E{A.in[0], X1, PART};
        pg8::gemm_phase<pg8::EpiResSplit, pg8::SplitOrder, true, true>(lds, g, S, E);
    }
    SEAM(5);
    if (IN(6)) {
        LAS float* scr = (LAS float*)(lds + wave * 16384);
        for (int m = gw; m < MTOK; m += NGW) {
            if (m >= MPR) { const float4* xs = (const float4*)(A.in[1] + (size_t)(m - MPR) * DM); float4* xo = (float4*)(X1 + (size_t)m * DM);
#pragma unroll
                for (int j = 0; j < 8; ++j) { float4 a = xs[lane + 64 * j];
#pragma unroll
                    for (int sg = 0; sg < 8; ++sg) { const float4 b = ((const float4*)(PART + ((size_t)sg * 1024 + (m - MPR)) * DM))[lane + 64 * j]; a.x += b.x; a.y += b.y; a.z += b.z; a.w += b.w; }
                    xo[lane + 64 * j] = a; } }
            rms_row_bf16(X1 + (size_t)m * DM, A.in[25], XN2 + (size_t)m * DM, lane);
        }
        __syncthreads();
    }
    SEAM(6);
    if (IN(7)) {
        pg8::Gemm g{XN2, WT_UP, MTOK, DFF2, DM}; pg8::StaticOrder S; S.init(MTOK, DFF2, DM, G, bx);
        pg8::EpiH E{HB, out + O_FFN_P, out + O_FFN_S};
        pg8::gemm_phase<pg8::EpiH, pg8::StaticOrder, true, true>(lds, g, S, E);
    }
    SEAM(7);
    if (IN(8)) { for (int it = gw; it < 11 * (MTOK / 9); it += NGW) act_item(A, it, lane); }
    SEAM(8);
    if (IN(9)) {
        pg8::Gemm g{ACT, WT_DN, MTOK, DM, DFF}; pg8::SplitOrder S; S.init(DFF, bx);
        pg8::EpiResSplit E{X1, X1, PART};
        pg8::gemm_phase<pg8::EpiResSplit, pg8::SplitOrder, true, true>(lds, g, S, E);
    }
    SEAM(9);
    if (IN(10)) { for (int m = gw; m < MTOK; m += NGW) {
            if (m >= MPR) { float4* xo = (float4*)(X1 + (size_t)m * DM);
#pragma unroll
                for (int j = 0; j < 8; ++j) { float4 a = xo[lane + 64 * j];
#pragma unroll
                    for (int sg = 0; sg < 8; ++sg) { const float4 b = ((const float4*)(PART + ((size_t)sg * 1024 + (m - MPR)) * DM))[lane + 64 * j]; a.x += b.x; a.y += b.y; a.z += b.z; a.w += b.w; }
                    xo[lane + 64 * j] = a; } }
            rms_row_f32_inplace(X1 + (size_t)m * DM, A.in[29], lane); } }
#undef IN
#undef SEAM
}

#ifndef N_LAUNCH_SPLIT
#define N_LAUNCH_SPLIT 0
#endif
extern "C" void kernel_launch(void* const* d_in, const int* in_sizes, int n_in, void* d_out, int out_size, void* d_ws, size_t ws_size, hipStream_t stream) {
    static int grid = 0;
    if (grid == 0) {
        int dev = 0, cus = 0, per_cu = 0;
        hipGetDevice(&dev);
        hipDeviceGetAttribute(&cus, hipDeviceAttributeMultiprocessorCount, dev);
        if (hipFuncSetAttribute((const void*)hymba_fwd, hipFuncAttributeMaxDynamicSharedMemorySize, LDS_BYTES) != hipSuccess) fprintf(stderr, "kernel_launch: hipFuncSetAttribute failed\n");
        if (hipOccupancyMaxActiveBlocksPerMultiprocessor(&per_cu, (const void*)hymba_fwd, 512, LDS_BYTES) != hipSuccess || per_cu < 1) { fprintf(stderr, "kernel_launch: occupancy query says %d\n", per_cu); per_cu = 1; }
        (void)hipGetLastError();
        grid = cus * 1;
        if (n_in != 30 || out_size != (int)O_END || ws_size < W_END4) fprintf(stderr, "kernel_launch: unexpected sizes n_in %d out %d ws %zu (need %zu)\n", n_in, out_size, ws_size, (size_t)W_END3);
    }
    if (hipMemsetAsync((char*)d_ws + W_BAR, 0, 8192, stream) != hipSuccess) fprintf(stderr, "kernel_launch: memset of the barrier word failed\n");
    Args a{};
    for (int i = 0; i < 30; ++i) a.in[i] = (const float*)d_in[i];
    a.out = (float*)d_out; a.ws = (unsigned char*)d_ws;
#if N_LAUNCH_SPLIT
    for (int p = 0; p <= 10; ++p) { a.ph_lo = p; a.ph_hi = p + 1; void* args[] = {&a};
        hipError_t e = hipLaunchCooperativeKernel((const void*)hymba_fwd, dim3(grid), dim3(512), args, LDS_BYTES, stream);
        if (e != hipSuccess) { fprintf(stderr, "kernel_launch: launch of phase %d failed: %s\n", p, hipGetErrorString(e)); break; } }
#else
    a.ph_lo = 0; a.ph_hi = 11; void* args[] = {&a};
    hipError_t e = hipLaunchCooperativeKernel((const void*)hymba_fwd, dim3(grid), dim3(512), args, LDS_BYTES, stream);
    if (e != hipSuccess) fprintf(stderr, "kernel_launch: cooperative launch failed: %s (grid %d)\n", hipGetErrorString(e), grid);
#endif
}
```

```cpp
#include <hip/hip_runtime.h>
#include <hip/hip_cooperative_groups.h>
#include <cstdio>
#include <cstdint>
namespace cg = cooperative_groups;
namespace pg8 {
#define PG8_LAS __attribute__((address_space(3)))
typedef unsigned short bf16_t;
typedef short bf16x8 __attribute__((ext_vector_type(8)));
typedef float f32x4 __attribute__((ext_vector_type(4)));
typedef unsigned u32x4 __attribute__((ext_vector_type(4)));
constexpr int BM = 256, BK = 64, HALF = 128, HTB = HALF * BK * 2  , STAGE_BYTES = 8 * HTB, NXCD = 8, WGM = 8;

__host__ __device__ __forceinline__ int lds_byte(int r, int c) { const int st = (r >> 4) * 2 + (c >> 5), rr = r & 15, cc = c & 31, ob = rr * 64 + cc * 2; return st * 1024 + (ob ^ (((ob >> 9) & 1) << 5)); }
__host__ __device__ __forceinline__ void stage_rc(int b, int& R, int& C) { const int st = b / 1024, sb = b % 1024, swz = sb ^ (((sb >> 9) & 1) << 5); R = (st >> 1) * 16 + swz / 64; C = (st & 1) * 32 + (swz % 64) / 2; }
__host__ __device__ __forceinline__ int perm32(int rho) { const int n = rho >> 4, i = rho & 15; return 8 * (i >> 2) + 4 * n + (i & 3); }

struct Unit { int pm, pn, k0, nt, seg; };
struct Gemm { const bf16_t* A; const bf16_t* Bt; int M, N, K; };

struct StaticOrder {
    int nM, nN, nwg, G, c, ntk;
    __host__ __device__ void init(int M, int N, int K, int G_, int c_) { nM = M / BM; nN = N / BM; nwg = nM * nN; G = G_; c = c_; ntk = K / BK; }
    __host__ __device__ bool next(int i, Unit& u) const {
        const long L = (long)i * G + c; if (L >= nwg) return false;
        int wgid = (int)L; { const int q = nwg / NXCD, r = nwg % NXCD, xcd = wgid % NXCD, off = wgid / NXCD; wgid = (xcd < r ? xcd * (q + 1) : r * (q + 1) + (xcd - r) * q) + off; }
        const int nig = WGM * nN, gid = wgid / nig, fm = gid * WGM, gsz = (nM - fm) < WGM ? (nM - fm) : WGM;
        u.pm = fm + ((wgid % nig) % gsz); u.pn = (wgid % nig) / gsz; u.k0 = 0; u.nt = ntk; u.seg = 0; return true;
    }
    __device__ __forceinline__ void a_ready(const Unit&) const {}
    __device__ __forceinline__ void done(const Unit&) const {}
};
__device__ __forceinline__ unsigned cvt_pk_bf16(float lo, float hi) { unsigned r; asm volatile("s_nop 1\n\tv_cvt_pk_bf16_f32 %0, %1, %2" : "=v"(r) : "v"(lo), "v"(hi)); return r; }
template <class Epi, class Sched, bool ALIGN_EPI = false, bool SP2 = false>
__device__ __forceinline__ void gemm_phase(PG8_LAS unsigned char* lds, const Gemm g, const Sched& S, const Epi& E) {
    const int tid = threadIdx.x, wid = __builtin_amdgcn_readfirstlane(tid >> 6), lane = tid & 63, wr = wid >> 2, wc = wid & 3, fr = lane & 15, fq = lane >> 4;
    const int K = g.K;
    unsigned voffA[2], voffB[2];
#pragma unroll
    for (int i = 0; i < 2; ++i) { int R, C; stage_rc(tid * 16 + i * 8192, R, C); const int Rb = Epi::PERM ? ((R & ~31) + perm32(R & 31)) : R;
        voffA[i] = (unsigned)(R * K + C) * 2u; voffB[i] = (unsigned)(Rb * K + C) * 2u; }
    const size_t kstep = (size_t)(BK * 2);
    const size_t hstep = (size_t)HALF * K * 2;
    const size_t tstep = 2 * hstep;
    const unsigned ldsw = (unsigned)wid * 1024u;
    const int aoff = lds_byte(wr * 64 + fr, fq * 8), boff = lds_byte(wc * 32 + fr, fq * 8);
#define PG8_SA(b, h) (((b) * 2 + (h)) * HTB)
#define PG8_SB(b, h) ((4 + (b) * 2 + (h)) * HTB)
#define PG8_STAGE(bufoff, gbase, voff) do { _Pragma("unroll") for (int _i = 0; _i < 2; ++_i) \
        __builtin_amdgcn_global_load_lds((const unsigned*)((const char*)(gbase) + (voff)[_i]), (PG8_LAS unsigned*)(lds + (bufoff) + ldsw + _i * 8192), 16, 0, 0); } while (0)
#define PG8_LDA(dst, b, h) do { _Pragma("unroll") for (int m = 0; m < 4; ++m) _Pragma("unroll") for (int k = 0; k < 2; ++k) dst[m][k] = *(const PG8_LAS bf16x8*)(lds + PG8_SA(b, h) + aoff + m * 2048 + k * 1024); } while (0)
#define PG8_LDB(dst, b, h) do { _Pragma("unroll") for (int n = 0; n < 2; ++n) _Pragma("unroll") for (int k = 0; k < 2; ++k) dst[n][k] = *(const PG8_LAS bf16x8*)(lds + PG8_SB(b, h) + boff + n * 2048 + k * 1024); } while (0)
#define PG8_MMA(ai, bj, At, Bt) do { __builtin_amdgcn_s_setprio(1); _Pragma("unroll") for (int m = 0; m < 4; ++m) _Pragma("unroll") for (int n = 0; n < 2; ++n) _Pragma("unroll") for (int k = 0; k < 2; ++k) \
        acc[ai][bj][m][n] = __builtin_amdgcn_mfma_f32_16x16x32_bf16(Bt[n][k], At[m][k], acc[ai][bj][m][n], 0, 0, 0); __builtin_amdgcn_s_setprio(0); } while (0)
#define PG8_WAIT_V(n) asm volatile("s_waitcnt vmcnt(" #n ")" ::: "memory")
#define PG8_WAIT_L(n) asm volatile("s_waitcnt lgkmcnt(" #n ")" ::: "memory")
#define PG8_BAR __builtin_amdgcn_s_barrier()
#define PG8_SCHED __builtin_amdgcn_sched_barrier(0)
    Unit cur, nxt; int ui = 0;
    if (!S.next(0, cur)) return;
    f32x4 acc[2][2][4][2];
#pragma unroll
    for (int a = 0; a < 2; ++a)
#pragma unroll
        for (int b = 0; b < 2; ++b)
#pragma unroll
            for (int m = 0; m < 4; ++m)
#pragma unroll
                for (int n = 0; n < 2; ++n) acc[a][b][m][n] = (f32x4){0.f, 0.f, 0.f, 0.f};
    bf16x8 At[4][2], B0[2][2], B1[2][2];
    const char* cA = (const char*)g.A + (size_t)cur.pm * tstep + (size_t)cur.k0 * kstep; const char* cB = (const char*)g.Bt + (size_t)cur.pn * tstep + (size_t)cur.k0 * kstep;
    S.a_ready(cur);
    if constexpr (SP2) {
        PG8_STAGE(PG8_SB(0, 0), cB, voffB); PG8_STAGE(PG8_SB(0, 1), cB + hstep, voffB); PG8_STAGE(PG8_SA(0, 0), cA, voffA); PG8_STAGE(PG8_SA(0, 1), cA + hstep, voffA);
        if (wr == 1) PG8_BAR;
        PG8_WAIT_V(2); PG8_BAR;
        PG8_STAGE(PG8_SB(1, 0), cB + kstep, voffB); PG8_STAGE(PG8_SA(1, 0), cA + kstep, voffA); PG8_STAGE(PG8_SB(1, 1), cB + hstep + kstep, voffB);
        PG8_WAIT_V(6); PG8_BAR;
    } else {
        PG8_STAGE(PG8_SB(0, 0), cB, voffB); PG8_STAGE(PG8_SA(0, 0), cA, voffA); PG8_STAGE(PG8_SB(0, 1), cB + hstep, voffB); PG8_STAGE(PG8_SA(0, 1), cA + hstep, voffA);
        if (wr == 1) PG8_BAR;
        PG8_WAIT_V(4); PG8_BAR;
        PG8_STAGE(PG8_SB(1, 0), cB + kstep, voffB); PG8_STAGE(PG8_SA(1, 0), cA + kstep, voffA); PG8_STAGE(PG8_SB(1, 1), cB + hstep + kstep, voffB);
        PG8_WAIT_V(6); PG8_BAR;
    }
    for (;;) {
        const bool has_next = S.next(ui + 1, nxt);
        const char* nA = has_next ? (const char*)g.A + (size_t)nxt.pm * tstep + (size_t)nxt.k0 * kstep : cA; const char* nB = has_next ? (const char*)g.Bt + (size_t)nxt.pn * tstep + (size_t)nxt.k0 * kstep : cB;
        const int nt = cur.nt;
        for (int t = 0; t < nt; t += 2) {
            const bool last = (t == nt - 2);
            const char* a1 = cA + (size_t)(t + 1) * kstep;
            const char* a2 = last ? nA : cA + (size_t)(t + 2) * kstep; const char* b2 = last ? nB : cB + (size_t)(t + 2) * kstep;
            const char* a3 = a2 + kstep; const char* b3 = b2 + kstep;
            if (last && has_next) S.a_ready(nxt);
            if constexpr (SP2) {
            PG8_LDB(B0, 0, 0); PG8_LDB(B1, 0, 1); PG8_SCHED; PG8_LDA(At, 0, 0); PG8_STAGE(PG8_SA(1, 1), a1 + hstep, voffA);
            PG8_WAIT_V(8); PG8_WAIT_L(0); PG8_BAR; PG8_MMA(0, 0, At, B0); PG8_MMA(0, 1, At, B1); PG8_BAR; PG8_SCHED;
            PG8_LDA(At, 0, 1); PG8_STAGE(PG8_SB(0, 0), b2, voffB); PG8_STAGE(PG8_SB(0, 1), b2 + hstep, voffB); PG8_STAGE(PG8_SA(0, 0), a2, voffA);
            PG8_WAIT_V(8); PG8_WAIT_L(0); PG8_BAR; PG8_MMA(1, 0, At, B0); PG8_MMA(1, 1, At, B1); PG8_BAR; PG8_SCHED;
            PG8_LDB(B0, 1, 0); PG8_LDB(B1, 1, 1); PG8_SCHED; PG8_LDA(At, 1, 0); PG8_STAGE(PG8_SA(0, 1), a2 + hstep, voffA);
            PG8_WAIT_V(8); PG8_WAIT_L(0); PG8_BAR; PG8_MMA(0, 0, At, B0); PG8_MMA(0, 1, At, B1); PG8_BAR; PG8_SCHED;
            PG8_LDA(At, 1, 1); PG8_STAGE(PG8_SB(1, 0), b3, voffB); PG8_STAGE(PG8_SB(1, 1), b3 + hstep, voffB); PG8_STAGE(PG8_SA(1, 0), a3, voffA);
            PG8_WAIT_V(8); PG8_WAIT_L(0); PG8_BAR; PG8_MMA(1, 0, At, B0); PG8_MMA(1, 1, At, B1); PG8_BAR; PG8_SCHED;
            } else {
            PG8_LDB(B0, 0, 0); PG8_SCHED; PG8_LDA(At, 0, 0); PG8_STAGE(PG8_SA(1, 1), a1 + hstep, voffA);
            PG8_WAIT_L(8); PG8_BAR; PG8_WAIT_L(0); PG8_MMA(0, 0, At, B0); PG8_BAR; PG8_SCHED;
            PG8_LDB(B1, 0, 1); PG8_STAGE(PG8_SB(0, 0), b2, voffB);
            PG8_BAR; PG8_WAIT_L(0); PG8_MMA(0, 1, At, B1); PG8_BAR;
            PG8_LDA(At, 0, 1); PG8_STAGE(PG8_SA(0, 0), a2, voffA);
            PG8_BAR; PG8_WAIT_L(0); PG8_MMA(1, 0, At, B0); PG8_BAR; PG8_SCHED;
            PG8_STAGE(PG8_SB(0, 1), b2 + hstep, voffB);
            PG8_WAIT_V(6); PG8_BAR; PG8_MMA(1, 1, At, B1); PG8_BAR;
            PG8_LDB(B0, 1, 0); PG8_SCHED; PG8_LDA(At, 1, 0); PG8_STAGE(PG8_SA(0, 1), a2 + hstep, voffA);
            PG8_WAIT_L(8); PG8_BAR; PG8_WAIT_L(0); PG8_MMA(0, 0, At, B0); PG8_BAR; PG8_SCHED;
            PG8_LDB(B1, 1, 1); PG8_STAGE(PG8_SB(1, 0), b3, voffB);
            PG8_BAR; PG8_WAIT_L(0); PG8_MMA(0, 1, At, B1); PG8_BAR;
            PG8_LDA(At, 1, 1); PG8_STAGE(PG8_SA(1, 0), a3, voffA);
            PG8_BAR; PG8_WAIT_L(0); PG8_MMA(1, 0, At, B0); PG8_BAR; PG8_SCHED;
            PG8_STAGE(PG8_SB(1, 1), b3 + hstep, voffB);
            PG8_WAIT_V(6); PG8_BAR; PG8_MMA(1, 1, At, B1); PG8_BAR;
            }
        }
        if constexpr (ALIGN_EPI) { if (wr == 0) PG8_BAR; }
        if constexpr (!Epi::AFTER_DRAIN) { E(acc, cur, wr, wc, fr, fq); S.done(cur); }
        if (!has_next) break;
#pragma unroll
        for (int a = 0; a < 2; ++a)
#pragma unroll
            for (int b = 0; b < 2; ++b)
#pragma unroll
                for (int m = 0; m < 4; ++m)
#pragma unroll
                    for (int n = 0; n < 2; ++n) acc[a][b][m][n] = (f32x4){0.f, 0.f, 0.f, 0.f};
        cur = nxt; cA = nA; cB = nB; ++ui;
        if constexpr (ALIGN_EPI) { if (wr == 1) PG8_BAR; }
    }
    PG8_WAIT_V(0);
    if constexpr (!ALIGN_EPI) { if (wr == 0) PG8_BAR; }
    PG8_BAR;
    if constexpr (Epi::AFTER_DRAIN) { E.fused(acc, cur, wr, wc, fr, fq, lds, wid, lane); S.done(cur); }
#undef PG8_SA
#undef PG8_SB
#undef PG8_STAGE
#undef PG8_LDA
#undef PG8_LDB
#undef PG8_MMA
#undef PG8_WAIT_V
#undef PG8_WAIT_L
#undef PG8_BAR
#undef PG8_SCHED
}
}

namespace pg8 {
struct EpiBf16P {
    static constexpr bool PERM = true, AFTER_DRAIN = false;
    bf16_t* O; int ldc;
    __device__ __forceinline__ void operator()(const f32x4 (&acc)[2][2][4][2], const Unit& u, int wr, int wc, int fr, int fq) const {
        const int row0 = u.pm * BM + wr * 64 + fr, col0 = u.pn * BM + wc * 32 + 8 * fq;
#pragma unroll
        for (int ai = 0; ai < 2; ++ai)
#pragma unroll
            for (int m = 0; m < 4; ++m) { bf16_t* rowp = O + (size_t)(row0 + ai * HALF + m * 16) * ldc + col0;
#pragma unroll
                for (int bj = 0; bj < 2; ++bj) { const f32x4 v0 = acc[ai][bj][m][0], v1 = acc[ai][bj][m][1];
                    u32x4 w; w.x = cvt_pk_bf16(v0[0], v0[1]); w.y = cvt_pk_bf16(v0[2], v0[3]); w.z = cvt_pk_bf16(v1[0], v1[1]); w.w = cvt_pk_bf16(v1[2], v1[3]);
                    *(u32x4*)(rowp + bj * HALF) = w; } }
    }
};
struct EpiH {
    static constexpr bool PERM = true, AFTER_DRAIN = false;
    bf16_t* O; float* ffn_p; float* ffn_s;
    __device__ __forceinline__ void operator()(const f32x4 (&acc)[2][2][4][2], const Unit& u, int wr, int wc, int fr, int fq) const {
        const int row0 = u.pm * BM + wr * 64 + fr, col0 = u.pn * BM + wc * 32 + 8 * fq;
#pragma unroll
        for (int ai = 0; ai < 2; ++ai)
#pragma unroll
            for (int m = 0; m < 4; ++m) { const int row = row0 + ai * HALF + m * 16; bf16_t* rowp = O + (size_t)row * 11264 + col0;
                float* tail = nullptr;
                if (row < 8192) { const int t = row & 2047; if (t >= 2046) tail = ffn_p + (size_t)((row >> 11) * 2 + (t - 2046)) * 11264 + col0; }
                else { const int r = row - 8192, t = r & 7; if (t >= 6) tail = ffn_s + (size_t)((r >> 3) * 2 + (t - 6)) * 11264 + col0; }
#pragma unroll
                for (int bj = 0; bj < 2; ++bj) { const f32x4 v0 = acc[ai][bj][m][0], v1 = acc[ai][bj][m][1];
                    u32x4 w; w.x = cvt_pk_bf16(v0[0], v0[1]); w.y = cvt_pk_bf16(v0[2], v0[3]); w.z = cvt_pk_bf16(v1[0], v1[1]); w.w = cvt_pk_bf16(v1[2], v1[3]);
                    *(u32x4*)(rowp + bj * HALF) = w;
                    if (tail) { *(f32x4*)(tail + bj * HALF) = v0; *(f32x4*)(tail + bj * HALF + 4) = v1; } } }
    }
};
struct EpiRes {
    static constexpr bool PERM = false, AFTER_DRAIN = false;
    const float* base_p; const float* base_s; float* out;
    __device__ __forceinline__ void operator()(const f32x4 (&acc)[2][2][4][2], const Unit& u, int wr, int wc, int fr, int fq) const {
        const int row0 = u.pm * BM + wr * 64 + fr, col0 = u.pn * BM + wc * 32 + 4 * fq;
        const float* base = (u.pm < 32) ? base_p : (base_s - (size_t)8192 * 2048);
#pragma unroll
        for (int ai = 0; ai < 2; ++ai)
#pragma unroll
            for (int m = 0; m < 4; ++m) { const size_t off = (size_t)(row0 + ai * HALF + m * 16) * 2048 + col0;
#pragma unroll
                for (int bj = 0; bj < 2; ++bj)
#pragma unroll
                    for (int n = 0; n < 2; ++n) { const f32x4 bs = *(const f32x4*)(base + off + bj * HALF + n * 16); *(f32x4*)(out + off + bj * HALF + n * 16) = bs + acc[ai][bj][m][n]; }
                asm volatile("" ::: "memory"); }
    }
};
struct SplitOrder {
    int c, ntk;
    __device__ void init(int K, int c_) { c = c_; ntk = K / BK; }
    __device__ bool next(int i, Unit& u) const {
        if (i == 0) { const int xcd = c & 7, j = c >> 3; u.pm = xcd * 4 + (j >> 3); u.pn = j & 7; u.k0 = 0; u.nt = ntk; u.seg = 0; return true; }
        if (i == 1) { const int uu = c >> 3, seg = c & 7, P = ntk >> 1, p0 = (seg * P) >> 3, p1 = ((seg + 1) * P) >> 3; u.pm = 32 + (uu >> 3); u.pn = uu & 7; u.k0 = 2 * p0; u.nt = 2 * (p1 - p0); u.seg = seg; return true; }
        return false;
    }
    __device__ __forceinline__ void a_ready(const Unit&) const {}
    __device__ __forceinline__ void done(const Unit&) const {}
};
struct EpiResSplit {
    static constexpr bool PERM = false, AFTER_DRAIN = false;
    const float* base_p; float* out_p; float* acc_s;
    __device__ __forceinline__ void operator()(const f32x4 (&acc)[2][2][4][2], const Unit& u, int wr, int wc, int fr, int fq) const {
        const int row0 = u.pm * BM + wr * 64 + fr, col0 = u.pn * BM + wc * 32 + 4 * fq;
        if (u.pm < 32) {
#pragma unroll
            for (int ai = 0; ai < 2; ++ai)
#pragma unroll
                for (int m = 0; m < 4; ++m) { const size_t off = (size_t)(row0 + ai * HALF + m * 16) * 2048 + col0;
#pragma unroll
                    for (int bj = 0; bj < 2; ++bj)
#pragma unroll
                        for (int n = 0; n < 2; ++n) { const f32x4 bs = *(const f32x4*)(base_p + off + bj * HALF + n * 16); *(f32x4*)(out_p + off + bj * HALF + n * 16) = bs + acc[ai][bj][m][n]; }
                    asm volatile("" ::: "memory"); }
        } else {
#pragma unroll
            for (int ai = 0; ai < 2; ++ai)
#pragma unroll
                for (int m = 0; m < 4; ++m) { float* p = acc_s + ((size_t)u.seg * 1024 + (size_t)(row0 - 8192 + ai * HALF + m * 16)) * 2048 + col0;
#pragma unroll
                    for (int bj = 0; bj < 2; ++bj)
#pragma unroll
                        for (int n = 0; n < 2; ++n) *(f32x4*)(p + bj * HALF + n * 16) = acc[ai][bj][m][n]; }
        }
    }
};
}

#define LAS __attribute__((address_space(3)))
typedef unsigned short bf16_t;
typedef float f32x4v __attribute__((ext_vector_type(4)));
typedef float f32x2v __attribute__((ext_vector_type(2)));
constexpr int MTOK = 9216, MPR = 8192, DM = 2048, NIN = 7440, NINP = 7680, DFF = 5632, DFF2 = 11264, RPROJ = 3328, OFFR = 4112;
constexpr int TT = 12, NTILES = MTOK / TT;
constexpr int LDS_BYTES = 131072;
constexpr size_t O_Y = 0, O_GDN_P = 18874368, O_GCONV_P = 19398656, O_RWKV_P = 19435520, O_SHIFT_P = 19697664, O_FFN_P = 19710976,
                 O_GDN_S = 19801088, O_GCONV_S = 36578304, O_RWKV_S = 37757952, O_SHIFT_S = 46146560, O_FFN_S = 46572544, O_END = 49456128;
constexpr size_t W_WTUP = 0, W_WTO = 46137344, W_PROJ = 54525952, W_GQKV = 196083712, W_GAB = 252706816, W_RS = 253296640, W_RV = 328794112, W_RW = 347668480, W_END1 = 385417216;
constexpr size_t W_PART = W_PROJ;
constexpr size_t W_MIXED = W_GQKV, W_H = W_WTO, W_WTDN = W_END1, W_ACT = W_H + (size_t)MTOK * DFF2 * 2 + (size_t)DM * DFF * 2, W_XN2 = W_ACT, W_END2 = W_ACT + (size_t)MTOK * DFF * 2, W_END3 = W_WTDN + (size_t)DM * DFF * 2;
static_assert(W_END2 <= W_END1 + 0, "late-phase overlay must fit");
static_assert(W_END3 == 408485888 && W_END2 == 380633088, "layout");
constexpr size_t W_BAR = W_END3, W_END4 = W_BAR + 8192;
constexpr size_t OB_WBT = O_FFN_S * 4, OB_ABT = OB_WBT + 1024 * 64 * 2, OB_GBT = OB_ABT + 1024 * 64 * 2;

struct Args { const float* in[30]; float* out; unsigned char* ws; int ph_lo, ph_hi; };

__device__ __forceinline__ float bf_lo(unsigned w) { return __uint_as_float(w << 16); }
__device__ __forceinline__ float bf_hi(unsigned w) { return __uint_as_float(w & 0xffff0000u); }
__device__ __forceinline__ unsigned pk2(float lo, float hi) { return pg8::cvt_pk_bf16(lo, hi); }
__device__ __forceinline__ unsigned pk2_safe(float lo, float hi) { unsigned r; asm volatile("s_nop 4\n\tv_cvt_pk_bf16_f32 %0, %1, %2" : "=v"(r) : "v"(lo), "v"(hi)); return r; }
__device__ __forceinline__ void unpack8(const uint4 w, float (&f)[8]) { f[0] = bf_lo(w.x); f[1] = bf_hi(w.x); f[2] = bf_lo(w.y); f[3] = bf_hi(w.y); f[4] = bf_lo(w.z); f[5] = bf_hi(w.z); f[6] = bf_lo(w.w); f[7] = bf_hi(w.w); }
__device__ __forceinline__ float wave_sum(float v) {
#pragma unroll
    for (int o = 1; o < 64; o <<= 1) v += __shfl_xor(v, o);
    return v;
}
__device__ __forceinline__ float half_sum32(float v) {
#pragma unroll
    for (int o = 1; o < 32; o <<= 1) v += __shfl_xor(v, o);
    return v;
}
__device__ __forceinline__ float sum16(float v) {
#pragma unroll
    for (int o = 1; o < 16; o <<= 1) v += __shfl_xor(v, o);
    return v;
}
template <int CTRL> __device__ __forceinline__ float dppf(float v) { return __int_as_float(__builtin_amdgcn_update_dpp(0, __float_as_int(v), CTRL, 0xF, 0xF, true)); }
__device__ __forceinline__ float reduce8(float v) {
    v += dppf<0xB1>(v);
    v += dppf<0x4E>(v);
    v += dppf<0x141>(v);
    return v;
}
__device__ __forceinline__ float sigmoidf_(float x) { return __builtin_amdgcn_rcpf(1.0f + __expf(-x)); }
__device__ __forceinline__ float siluf_(float x) { return x * __builtin_amdgcn_rcpf(1.0f + __expf(-x)); }
__device__ __forceinline__ float softplusf_(float x) { return fmaxf(x, 0.f) + __logf(1.0f + __expf(-fabsf(x))); }
__device__ __forceinline__ float tanhf_(float x) { const float e = __expf(-2.0f * fabsf(x)); const float r = (1.0f - e) * __builtin_amdgcn_rcpf(1.0f + e); return x < 0.f ? -r : r; }
__device__ __forceinline__ void rowinfo(int row, int& grp, int& b, int& t, int& T) {
    if (row < MPR) { grp = 0; b = row >> 11; t = row & 2047; T = 2048; } else { const int r = row - MPR; grp = 1; b = r >> 3; t = r & 7; T = 8; }
}
#define LDS_WAIT() asm volatile("s_waitcnt lgkmcnt(0)" ::: "memory")

__device__ __forceinline__ void transpose_item(const float* __restrict__ W, int K, int N, bf16_t* __restrict__ WT, LAS float* scr, int item, int nblk, int lane) {
    const int kb = item / nblk, nb = item - kb * nblk, k0 = 64 * kb, n0 = 64 * nb;
    const int r4 = lane >> 4, c4 = (lane & 15) * 4, n_in = n0 + c4;
    float4 v[16];
#pragma unroll
    for (int i = 0; i < 16; ++i) { if (n_in < N) { const f32x4v t_ = __builtin_nontemporal_load((const f32x4v*)(W + (size_t)(k0 + 4 * i + r4) * N + n_in)); v[i] = make_float4(t_[0], t_[1], t_[2], t_[3]); } else v[i] = make_float4(0.f, 0.f, 0.f, 0.f); }
#pragma unroll
    for (int i = 0; i < 16; ++i) { const int k = 4 * i + r4; *(LAS f32x4v*)(scr + k * 64 + (c4 ^ (8 * ((k >> 3) & 7)))) = (f32x4v){v[i].x, v[i].y, v[i].z, v[i].w}; }
    LDS_WAIT();
    const int c = lane & 7;
#pragma unroll
    for (int j = 0; j < 8; ++j) { const int n = (lane >> 3) + 8 * j; const LAS float* sp = scr + (8 * c) * 64 + (n ^ (8 * c));
        uint4 o; o.x = pk2(sp[0], sp[64]); o.y = pk2(sp[128], sp[192]); o.z = pk2(sp[256], sp[320]); o.w = pk2(sp[384], sp[448]);
        *(uint4*)(WT + (size_t)(n0 + n) * K + k0 + 8 * c) = o; }
    LDS_WAIT();
}
template <bool NT = false>
__device__ __forceinline__ void rms_row_bf16(const float* __restrict__ xrow, const float* __restrict__ g, bf16_t* __restrict__ orow, int lane) {
    float4 v[8]; float ss = 0.f;
#pragma unroll
    for (int j = 0; j < 8; ++j) { if (NT) { const f32x4v t_ = __builtin_nontemporal_load((const f32x4v*)xrow + lane + 64 * j); v[j] = make_float4(t_[0], t_[1], t_[2], t_[3]); } else v[j] = ((const float4*)xrow)[lane + 64 * j]; ss += (v[j].x * v[j].x + v[j].y * v[j].y) + (v[j].z * v[j].z + v[j].w * v[j].w); }
    const float rs = rsqrtf(wave_sum(ss) * (1.0f / DM) + 1e-6f);
#pragma unroll
    for (int j = 0; j < 8; ++j) { const float4 gg = ((const float4*)g)[lane + 64 * j];
        uint2 o; o.x = pk2(v[j].x * rs * gg.x, v[j].y * rs * gg.y); o.y = pk2(v[j].z * rs * gg.z, v[j].w * rs * gg.w);
        ((uint2*)orow)[lane + 64 * j] = o; }
}
template <bool NT = false>
__device__ __forceinline__ void rms_row_f32_inplace(float* xrow, const float* __restrict__ g, int lane) {
    float4 v[8]; float ss = 0.f;
#pragma unroll
    for (int j = 0; j < 8; ++j) { if (NT) { const f32x4v t_ = __builtin_nontemporal_load((const f32x4v*)xrow + lane + 64 * j); v[j] = make_float4(t_[0], t_[1], t_[2], t_[3]); } else v[j] = ((const float4*)xrow)[lane + 64 * j]; ss += (v[j].x * v[j].x + v[j].y * v[j].y) + (v[j].z * v[j].z + v[j].w * v[j].w); }
    const float rs = rsqrtf(wave_sum(ss) * (1.0f / DM) + 1e-6f);
#pragma unroll
    for (int j = 0; j < 8; ++j) { const float4 gg = ((const float4*)g)[lane + 64 * j];
        float4 o; o.x = v[j].x * rs * gg.x; o.y = v[j].y * rs * gg.y; o.z = v[j].z * rs * gg.z; o.w = v[j].w * rs * gg.w;
        if (NT) __builtin_nontemporal_store((f32x4v){o.x, o.y, o.z, o.w}, (f32x4v*)xrow + lane + 64 * j); else ((float4*)xrow)[lane + 64 * j] = o; }
}

__device__ __forceinline__ void prep_tile(const Args& A, LAS float* lw, int tile, int tid) {
    const bf16_t* PROJ = (const bf16_t*)(A.ws + W_PROJ);
    bf16_t* GQKV = (bf16_t*)(A.ws + W_GQKV); float* GA = (float*)(A.ws + W_GAB); float* GB = GA + MTOK * 8;
    bf16_t* RS = (bf16_t*)(A.ws + W_RS); bf16_t* RV = (bf16_t*)(A.ws + W_RV); float* RW = (float*)(A.ws + W_RW);
    const float* st_gconv = A.in[3]; const float* st_shift = A.in[5];
    const int row_base = tile * TT;
    const int c0 = tid * 2;
    unsigned pw[TT + 1][3];
#pragma unroll
    for (int i = 0; i < TT + 1; ++i) { int r = row_base - 1 + i; r = r < 0 ? 0 : r; const bf16_t* pr = PROJ + (size_t)r * NINP + OFFR + c0;
        pw[i][0] = *(const unsigned*)pr; pw[i][1] = *(const unsigned*)(pr + 1024); pw[i][2] = *(const unsigned*)(pr + 2048); }
    uint4 xr[TT + 3];
    { const int chx = (tid < 384 ? tid : 383) * 8;
#pragma unroll
      for (int i = 0; i < TT + 3; ++i) { int r = row_base - 3 + i; r = r < 0 ? 0 : r; xr[i] = *(const uint4*)(PROJ + (size_t)r * NINP + chx); } }
    {
        if (tid < 4 * 68) ((LAS unsigned*)lw)[TT * 68 + tid] = 0u;
        const float* mu = A.in[13];
#pragma unroll
        for (int i = 0; i < 2; ++i) { const int item = tid + 512 * i; if (item < TT * 64) { const int tk = item >> 6, jp = item & 63, row = row_base + tk; int grp, b, t, T; rowinfo(row, grp, b, t, T);
            const int col = 3072 + 2 * jp; const unsigned pw_ = *(const unsigned*)(PROJ + (size_t)row * NINP + OFFR + col);
            float q0, q1; if (t > 0) { const unsigned qw = *(const unsigned*)(PROJ + (size_t)(row - 1) * NINP + OFFR + col); q0 = bf_lo(qw); q1 = bf_hi(qw); }
            else if (grp) { const float2 sq = *(const float2*)(st_shift + (size_t)b * RPROJ + col); q0 = sq.x; q1 = sq.y; } else { q0 = 0.f; q1 = 0.f; }
            const float2 m2 = *(const float2*)(mu + col); const float p0 = bf_lo(pw_), p1 = bf_hi(pw_);
            float x0 = p0 + (q0 - p0) * m2.x, x1 = p1 + (q1 - p1) * m2.y;
            if (jp < 32) { x0 = tanhf_(x0); x1 = tanhf_(x1); }
            ((LAS unsigned*)lw)[tk * 68 + jp] = pk2_safe(x0, x1); } }
    }
    if (tid < 384) {
        const int ch = tid * 8, stream = tid >> 7;
        const float* cwp = A.in[9];
        float cw[4][8];
#pragma unroll
        for (int i = 0; i < 4; ++i) { const float4 a0 = *(const float4*)(cwp + i * 3072 + ch), a1 = *(const float4*)(cwp + i * 3072 + ch + 4);
            cw[i][0] = a0.x; cw[i][1] = a0.y; cw[i][2] = a0.z; cw[i][3] = a0.w; cw[i][4] = a1.x; cw[i][5] = a1.y; cw[i][6] = a1.z; cw[i][7] = a1.w; }
#pragma unroll
        for (int tk = 0; tk < TT; ++tk) {
            const int row = row_base + tk; int grp, b, t, T; rowinfo(row, grp, b, t, T);
            float y[8], xl[8];
#pragma unroll
            for (int e = 0; e < 8; ++e) y[e] = 0.f;
#pragma unroll
            for (int i = 0; i < 4; ++i) { const int tt = t - 3 + i; float x[8];
                if (tt >= 0) { unpack8(xr[tk + i], x); }
                else if (grp) { const float* sp = st_gconv + ((size_t)b * 3 + (t + i)) * 3072 + ch; const float4 a0 = *(const float4*)sp, a1 = *(const float4*)(sp + 4);
                    x[0] = a0.x; x[1] = a0.y; x[2] = a0.z; x[3] = a0.w; x[4] = a1.x; x[5] = a1.y; x[6] = a1.z; x[7] = a1.w; }
                else {
#pragma unroll
                    for (int e = 0; e < 8; ++e) x[e] = 0.f; }
#pragma unroll
                for (int e = 0; e < 8; ++e) { y[e] += cw[i][e] * x[e]; if (i == 3) xl[e] = x[e]; } }
            float ss = 0.f;
#pragma unroll
            for (int e = 0; e < 8; ++e) { y[e] = siluf_(y[e]); ss += y[e] * y[e]; }
            if (stream < 2) { ss = sum16(ss); const float sc = rsqrtf(ss + 1e-12f) * (stream == 0 ? 0.08838834764831845f : 1.0f);
#pragma unroll
                for (int e = 0; e < 8; ++e) y[e] *= sc; }
            uint4 o; o.x = pk2(y[0], y[1]); o.y = pk2(y[2], y[3]); o.z = pk2(y[4], y[5]); o.w = pk2(y[6], y[7]);
            *(uint4*)(GQKV + (size_t)row * 3072 + ch) = o;
            if (t >= T - 3) { float* gp = A.out + (grp ? O_GCONV_S : O_GCONV_P) + ((size_t)b * 3 + (t - (T - 3))) * 3072 + ch;
                *(float4*)gp = make_float4(xl[0], xl[1], xl[2], xl[3]); *(float4*)(gp + 4) = make_float4(xl[4], xl[5], xl[6], xl[7]); }
        }
    } else if (tid < 384 + TT * 8) {
        const int idx = tid - 384, tk = idx >> 3, h = idx & 7, row = row_base + tk;
        const float pb = bf_lo((unsigned)PROJ[(size_t)row * NINP + 4096 + h]), pa = bf_lo((unsigned)PROJ[(size_t)row * NINP + 4104 + h]);
        const float g = -__expf(A.in[10][h]) * softplusf_(pa + A.in[11][h]);
        GA[(size_t)row * 8 + h] = __expf(g); GB[(size_t)row * 8 + h] = sigmoidf_(pb);
    }
    __syncthreads();
    {
        const int wv_ = __builtin_amdgcn_readfirstlane(tid >> 6), ti = tid & 15, quad = (tid & 63) >> 4;
        LAS float* AWL = lw + 2048; LAS float* AAL = lw + 2048 + 13364;
        const LAS unsigned char* lb = (const LAS unsigned char*)lw + ti * 272 + quad * 16;
        pg8::bf16x8 bop[4];
#pragma unroll
        for (int ks = 0; ks < 4; ++ks) bop[ks] = *(const LAS pg8::bf16x8*)(lb + ks * 64);
#pragma unroll
        for (int which = 0; which < 2; ++which) {
            const bf16_t* WT = (const bf16_t*)((const unsigned char*)A.out + (which == 0 ? OB_WBT : OB_ABT)) + (size_t)(wv_ * 128 + ti) * 64 + quad * 8;
            const float* bias = A.in[which == 0 ? 14 : 16] + wv_ * 128 + quad * 4;
            LAS float* dst = (which == 0 ? AWL : AAL) + (ti < TT ? ti : TT) * 1028 + wv_ * 128 + quad * 4;
            pg8::bf16x8 aop[8][2];
#pragma unroll
            for (int t = 0; t < 8; ++t) { aop[t][0] = *(const pg8::bf16x8*)(WT + (size_t)t * 16 * 64); aop[t][1] = *(const pg8::bf16x8*)(WT + (size_t)t * 16 * 64 + 32); }
#pragma unroll
            for (int t = 0; t < 8; ++t) {
                pg8::f32x4 c = *(const pg8::f32x4*)(bias + t * 16);
                c = __builtin_amdgcn_mfma_f32_16x16x32_bf16(aop[t][0], bop[which * 2], c, 0, 0, 0);
                c = __builtin_amdgcn_mfma_f32_16x16x32_bf16(aop[t][1], bop[which * 2 + 1], c, 0, 0, 0);
                *(LAS f32x4v*)(dst + t * 16) = (f32x4v){c[0], c[1], c[2], c[3]};
            }
        }
    }
    __syncthreads();
    f32x2v aw[TT], aa[TT];
#pragma unroll
    for (int tk = 0; tk < TT; ++tk) { aw[tk] = *(const LAS f32x2v*)(lw + 2048 + tk * 1028 + c0); aa[tk] = *(const LAS f32x2v*)(lw + 2048 + 13364 + tk * 1028 + c0); }
    {
        const float* mu = A.in[13];
        const float2 mur = *(const float2*)(mu + c0), muk = *(const float2*)(mu + 1024 + c0), muv = *(const float2*)(mu + 2048 + c0);
        const float2 kkw = *(const float2*)(A.in[19] + c0), kaw = *(const float2*)(A.in[20] + c0);
#pragma unroll
        for (int tk = 0; tk < TT; ++tk) {
            const int row = row_base + tk; int grp, b, t, T; rowinfo(row, grp, b, t, T);
            const unsigned wr_ = pw[tk + 1][0], wk_ = pw[tk + 1][1], wv_ = pw[tk + 1][2];
            float r0 = bf_lo(wr_), r1 = bf_hi(wr_), k0 = bf_lo(wk_), k1 = bf_hi(wk_), v0 = bf_lo(wv_), v1 = bf_hi(wv_);
            float pr0, pr1, pk0, pk1, pv0, pv1;
            if (t > 0) { const unsigned a_ = pw[tk][0], b_ = pw[tk][1], c_ = pw[tk][2];
                pr0 = bf_lo(a_); pr1 = bf_hi(a_); pk0 = bf_lo(b_); pk1 = bf_hi(b_); pv0 = bf_lo(c_); pv1 = bf_hi(c_); }
            else if (grp) { const float* sp = st_shift + (size_t)b * RPROJ + c0; const float2 a_ = *(const float2*)sp, b_ = *(const float2*)(sp + 1024), c_ = *(const float2*)(sp + 2048);
                pr0 = a_.x; pr1 = a_.y; pk0 = b_.x; pk1 = b_.y; pv0 = c_.x; pv1 = c_.y; }
            else { pr0 = pr1 = pk0 = pk1 = pv0 = pv1 = 0.f; }
            r0 += (pr0 - r0) * mur.x; r1 += (pr1 - r1) * mur.y; k0 += (pk0 - k0) * muk.x; k1 += (pk1 - k1) * muk.y; v0 += (pv0 - v0) * muv.x; v1 += (pv1 - v1) * muv.y;
            const float w0_ = -softplusf_(-aw[tk].x) - 0.5f, w1_ = -softplusf_(-aw[tk].y) - 0.5f;
            const float d0 = __expf(-__expf(w0_)), d1 = __expf(-__expf(w1_));
            const float a0_ = sigmoidf_(aa[tk].x), a1_ = sigmoidf_(aa[tk].y);
            float q0 = k0 * kkw.x, q1 = k1 * kkw.y;
            const float inv = rsqrtf(half_sum32(q0 * q0 + q1 * q1) + 1e-12f);
            q0 *= inv; q1 *= inv;
            const float kp0 = k0 * (1.0f + (a0_ - 1.0f) * kaw.x), kp1 = k1 * (1.0f + (a1_ - 1.0f) * kaw.y);
            bf16_t* rs = RS + (size_t)row * 4096 + c0;
            *(unsigned*)rs = pk2(q0, q1); *(unsigned*)(rs + 1024) = pk2(q0 * a0_, q1 * a1_); *(unsigned*)(rs + 2048) = pk2(kp0, kp1); *(unsigned*)(rs + 3072) = pk2(r0, r1);
            *(unsigned*)(RV + (size_t)row * 1024 + c0) = pk2(v0, v1);
            *(float2*)(RW + (size_t)row * 1024 + c0) = make_float2(d0, d1);
        }
    }
    for (int tk = 0; tk < TT; ++tk) { const int row = row_base + tk; int grp, b, t, T; rowinfo(row, grp, b, t, T);
        if (t == T - 1) { float* sp = A.out + (grp ? O_SHIFT_S : O_SHIFT_P) + (size_t)b * RPROJ;
            for (int j = tid; j < RPROJ; j += 512) sp[j] = bf_lo((unsigned)PROJ[(size_t)row * NINP + OFFR + j]); } }
    __syncthreads();
}

constexpr int SCAN_LDS_PER_WAVE = 10752;
__device__ __forceinline__ void rwkv_sample_loop(LAS float* sl, const bf16_t* __restrict__ RS, const bf16_t* __restrict__ RV, const float* __restrict__ RW, float* __restrict__ yraw,
                                                 const float* __restrict__ st_in, float* __restrict__ st_out, int task0, int stride, int lane) {
    if (task0 >= 16384) return;
    const int part = lane & 7, rr = lane >> 3;
    LAS float* SB = sl; LAS float* WB = sl + 2048; LAS float* VB = sl + 2560;
    float4 nS0, nS1; uint4 nst[4]; float4 nsw[2]; uint4 nsv = make_uint4(0, 0, 0, 0);
#define RWS_LOAD(task_) do { const int bh_ = (task_) >> 3, v0_ = ((task_) & 7) * 8, h_ = bh_ & 15, row0_ = MPR + (bh_ >> 4) * 8; \
        const float* sp_ = st_in + (size_t)bh_ * 4096 + (size_t)(v0_ + rr) * 64 + part * 8; { const f32x4v a_ = __builtin_nontemporal_load((const f32x4v*)sp_), b_ = __builtin_nontemporal_load((const f32x4v*)(sp_ + 4)); nS0 = make_float4(a_[0], a_[1], a_[2], a_[3]); nS1 = make_float4(b_[0], b_[1], b_[2], b_[3]); } \
        _Pragma("unroll") for (int i = 0; i < 4; ++i) { const int id = i * 64 + lane, step = id >> 5, s = (id >> 3) & 3, pc = id & 7; \
            nst[i] = *(const uint4*)(RS + (size_t)(row0_ + step) * 4096 + s * 1024 + h_ * 64 + pc * 8); } \
        _Pragma("unroll") for (int i = 0; i < 2; ++i) { const int id = i * 64 + lane, step = id >> 4, pc = id & 15; \
            nsw[i] = *(const float4*)(RW + (size_t)(row0_ + step) * 1024 + h_ * 64 + pc * 4); } \
        if (lane < 8) nsv = *(const uint4*)(RV + (size_t)(row0_ + lane) * 1024 + h_ * 64 + v0_); } while (0)
    RWS_LOAD(task0);
    for (int task = task0; task < 16384; task += stride) {
        const int bh = task >> 3, v0 = (task & 7) * 8, h = bh & 15, row0 = MPR + (bh >> 4) * 8;
        f32x2v S[4] = {(f32x2v){nS0.x, nS0.y}, (f32x2v){nS0.z, nS0.w}, (f32x2v){nS1.x, nS1.y}, (f32x2v){nS1.z, nS1.w}};
#pragma unroll
        for (int i = 0; i < 4; ++i) { const int id = i * 64 + lane, step = id >> 5, s = (id >> 3) & 3, pc = id & 7; float f[8]; unpack8(nst[i], f);
            LAS float* d = SB + (step * 4 + s) * 64 + pc * 8; *(LAS f32x4v*)d = (f32x4v){f[0], f[1], f[2], f[3]}; *(LAS f32x4v*)(d + 4) = (f32x4v){f[4], f[5], f[6], f[7]}; }
#pragma unroll
        for (int i = 0; i < 2; ++i) { const int id = i * 64 + lane, step = id >> 4, pc = id & 15; *(LAS f32x4v*)(WB + step * 64 + pc * 4) = (f32x4v){nsw[i].x, nsw[i].y, nsw[i].z, nsw[i].w}; }
        if (lane < 8) { float f[8]; unpack8(nsv, f); LAS float* d = VB + lane * 8; *(LAS f32x4v*)d = (f32x4v){f[0], f[1], f[2], f[3]}; *(LAS f32x4v*)(d + 4) = (f32x4v){f[4], f[5], f[6], f[7]}; }
        asm volatile("s_waitcnt lgkmcnt(0)" ::: "memory");
        __builtin_amdgcn_sched_barrier(0);
        if (task + stride < 16384) RWS_LOAD(task + stride);
        __builtin_amdgcn_sched_barrier(0);
        float ys[8];
        f32x4v kk0, kk1, ka0, ka1, kp0, kp1, r0, r1, w0, w1; float vv;
        f32x4v nkk0, nkk1, nka0, nka1, nkp0, nkp1, nr0, nr1, nw0, nw1; float nvv;
#define RW_OPS(s_) do { const LAS float* sb = SB + (s_) * 256 + part * 8; \
            nkk0 = *(const LAS f32x4v*)(sb); nkk1 = *(const LAS f32x4v*)(sb + 4); nka0 = *(const LAS f32x4v*)(sb + 64); nka1 = *(const LAS f32x4v*)(sb + 68); \
            nkp0 = *(const LAS f32x4v*)(sb + 128); nkp1 = *(const LAS f32x4v*)(sb + 132); nr0 = *(const LAS f32x4v*)(sb + 192); nr1 = *(const LAS f32x4v*)(sb + 196); \
            nw0 = *(const LAS f32x4v*)(WB + (s_) * 64 + part * 8); nw1 = *(const LAS f32x4v*)(WB + (s_) * 64 + part * 8 + 4); nvv = VB[(s_) * 8 + rr]; } while (0)
        RW_OPS(0);
#pragma unroll
        for (int s = 0; s < 8; ++s) {
            kk0 = nkk0; kk1 = nkk1; ka0 = nka0; ka1 = nka1; kp0 = nkp0; kp1 = nkp1; r0 = nr0; r1 = nr1; w0 = nw0; w1 = nw1; vv = nvv;
            if (s < 7) RW_OPS(s + 1);
            __builtin_amdgcn_sched_barrier(0);
            f32x2v acc = S[0] * kk0.lo, acc1 = S[1] * kk0.hi; acc = S[2] * kk1.lo + acc; acc1 = S[3] * kk1.hi + acc1; acc += acc1;
            const float sk = reduce8(acc.x + acc.y);
            const f32x2v nsk = (f32x2v){-sk, -sk}, vv2 = (f32x2v){vv, vv};
            S[0] = S[0] * w0.lo + (ka0.lo * nsk + kp0.lo * vv2);
            S[1] = S[1] * w0.hi + (ka0.hi * nsk + kp0.hi * vv2);
            S[2] = S[2] * w1.lo + (ka1.lo * nsk + kp1.lo * vv2);
            S[3] = S[3] * w1.hi + (ka1.hi * nsk + kp1.hi * vv2);
            f32x2v ya = S[0] * r0.lo, ya1 = S[1] * r0.hi; ya = S[2] * r1.lo + ya; ya1 = S[3] * r1.hi + ya1; ya += ya1;
            ys[s] = reduce8(ya.x + ya.y);
            __builtin_amdgcn_sched_barrier(0);
        }
#undef RW_OPS
        { float ysel = ys[0];
#pragma unroll
          for (int i = 1; i < 8; ++i) ysel = (part == i) ? ys[i] : ysel;
          yraw[(size_t)(row0 + part) * 2048 + 1024 + h * 64 + v0 + rr] = ysel; }
        { float* d = st_out + (size_t)bh * 4096 + (size_t)(v0 + rr) * 64 + part * 8; __builtin_nontemporal_store((f32x4v){S[0].x, S[0].y, S[1].x, S[1].y}, (f32x4v*)d); __builtin_nontemporal_store((f32x4v){S[2].x, S[2].y, S[3].x, S[3].y}, (f32x4v*)(d + 4)); }
        asm volatile("" ::: "memory");
    }
#undef RWS_LOAD
}
__device__ __forceinline__ void gdn_sample_loop(LAS float* sl, const bf16_t* __restrict__ GQKV, const float* __restrict__ GA, const float* __restrict__ GB, float* __restrict__ yraw,
                                                const float* __restrict__ st_in, float* __restrict__ st_out, int task0, int stride, int lane) {
    if (task0 >= 16384) return;
    const int part = lane & 7, cc = lane >> 3;
    LAS float* KB = sl; LAS float* QB = sl + 1056; LAS float* VB = sl + 2112; LAS float* AB = sl + 2176;
    const int rdoff = part * 16 + (part >> 2) * 4;
    float nS[16]; uint4 nst[4]; uint4 nsv = make_uint4(0, 0, 0, 0); float nsa = 0.f, nsb = 0.f;
#define GDS_LOAD(task_) do { const int bh_ = (task_) >> 4, j0_ = ((task_) & 15) * 8, h_ = bh_ & 7, row0_ = MPR + (bh_ >> 3) * 8; \
        const float* sp_ = st_in + (size_t)bh_ * 16384 + (size_t)(part * 16) * 128 + j0_ + cc; \
        _Pragma("unroll") for (int e = 0; e < 16; ++e) nS[e] = sp_[(size_t)e * 128]; \
        _Pragma("unroll") for (int i = 0; i < 4; ++i) { const int id = i * 64 + lane, s = id >> 7, step = (id >> 4) & 7, pc = id & 15; \
            nst[i] = *(const uint4*)(GQKV + (size_t)(row0_ + step) * 3072 + (s == 0 ? 1024 : 0) + h_ * 128 + pc * 8); } \
        if (lane < 8) { nsv = *(const uint4*)(GQKV + (size_t)(row0_ + lane) * 3072 + 2048 + h_ * 128 + j0_); \
            nsa = GA[(size_t)(row0_ + lane) * 8 + h_]; nsb = GB[(size_t)(row0_ + lane) * 8 + h_]; } } while (0)
    GDS_LOAD(task0);
    for (int task = task0; task < 16384; task += stride) {
        const int bh = task >> 4, j0 = (task & 15) * 8, h = bh & 7, row0 = MPR + (bh >> 3) * 8;
        f32x2v S[8];
#pragma unroll
        for (int e = 0; e < 8; ++e) S[e] = (f32x2v){nS[2 * e], nS[2 * e + 1]};
#pragma unroll
        for (int i = 0; i < 4; ++i) { const int id = i * 64 + lane, s = id >> 7, step = (id >> 4) & 7, pc = id & 15, pp = pc >> 1; float f[8]; unpack8(nst[i], f);
            LAS float* d = (s == 0 ? KB : QB) + step * 132 + pp * 16 + (pp >> 2) * 4 + (pc & 1) * 8; *(LAS f32x4v*)d = (f32x4v){f[0], f[1], f[2], f[3]}; *(LAS f32x4v*)(d + 4) = (f32x4v){f[4], f[5], f[6], f[7]}; }
        if (lane < 8) { float f[8]; unpack8(nsv, f); LAS float* d = VB + lane * 8; *(LAS f32x4v*)d = (f32x4v){f[0], f[1], f[2], f[3]}; *(LAS f32x4v*)(d + 4) = (f32x4v){f[4], f[5], f[6], f[7]};
            AB[lane * 2] = nsa; AB[lane * 2 + 1] = nsb; }
        asm volatile("s_waitcnt lgkmcnt(0)" ::: "memory");
        __builtin_amdgcn_sched_barrier(0);
        if (task + stride < 16384) GDS_LOAD(task + stride);
        __builtin_amdgcn_sched_barrier(0);
        float os[8];
        f32x4v k[4], q[4], nk[4], nq[4]; float v, a, beta, nv, na, nbeta;
#define GD_OPS(s_) do { const LAS float* kb = KB + (s_) * 132 + rdoff; const LAS float* qb = QB + (s_) * 132 + rdoff; \
            _Pragma("unroll") for (int i = 0; i < 4; ++i) { nk[i] = *(const LAS f32x4v*)(kb + 4 * i); nq[i] = *(const LAS f32x4v*)(qb + 4 * i); } \
            nv = VB[(s_) * 8 + cc]; na = AB[(s_) * 2]; nbeta = AB[(s_) * 2 + 1]; } while (0)
        GD_OPS(0);
#pragma unroll
        for (int s = 0; s < 8; ++s) {
#pragma unroll
            for (int i = 0; i < 4; ++i) { k[i] = nk[i]; q[i] = nq[i]; }
            v = nv; a = na; beta = nbeta;
            if (s < 7) GD_OPS(s + 1);
            __builtin_amdgcn_sched_barrier(0);
            f32x2v acc = S[0] * k[0].lo, acc1 = S[1] * k[0].hi;
#pragma unroll
            for (int i = 1; i < 4; ++i) { acc = S[2 * i] * k[i].lo + acc; acc1 = S[2 * i + 1] * k[i].hi + acc1; }
            acc += acc1;
            const float kS = reduce8(acc.x + acc.y);
            const float cf = beta * (v - a * kS);
            const f32x2v cf2 = (f32x2v){cf, cf}, a2 = (f32x2v){a, a};
#pragma unroll
            for (int i = 0; i < 4; ++i) { S[2 * i] = S[2 * i] * a2 + k[i].lo * cf2; S[2 * i + 1] = S[2 * i + 1] * a2 + k[i].hi * cf2; }
            f32x2v oa = S[0] * q[0].lo, oa1 = S[1] * q[0].hi;
#pragma unroll
            for (int i = 1; i < 4; ++i) { oa = S[2 * i] * q[i].lo + oa; oa1 = S[2 * i + 1] * q[i].hi + oa1; }
            oa += oa1;
            os[s] = reduce8(oa.x + oa.y);
            __builtin_amdgcn_sched_barrier(0);
        }
#undef GD_OPS
        { float osel = os[0];
#pragma unroll
          for (int i = 1; i < 8; ++i) osel = (part == i) ? os[i] : osel;
          yraw[(size_t)(row0 + part) * 2048 + h * 128 + j0 + cc] = osel; }
        { float* d = st_out + (size_t)bh * 16384 + (size_t)(part * 16) * 128 + j0 + cc;
#pragma unroll
          for (int e = 0; e < 8; ++e) { d[(size_t)(2 * e) * 128] = S[e].x; d[(size_t)(2 * e + 1) * 128] = S[e].y; } }
        asm volatile("" ::: "memory");
    }
#undef GDS_LOAD
}

__device__ __forceinline__ void gdn_sample_cols(LAS float* sl, const bf16_t* __restrict__ GQKV, const float* __restrict__ GA, const float* __restrict__ GB, float* __restrict__ yraw,
                                                const float* __restrict__ st_in, float* __restrict__ st_out, int task, int lane) {
    const int bh = task >> 1, j = (task & 1) * 64 + lane, h = bh & 7, row0 = MPR + (bh >> 3) * 8;
    LAS float* KB = sl; LAS float* QB = sl + 1024; LAS float* VB = sl + 2048; LAS float* AB = sl + 2560;
    f32x2v S[64];
    { const float* sp = st_in + (size_t)bh * 16384 + j;
#pragma unroll
      for (int i = 0; i < 64; ++i) { S[i] = (f32x2v){__builtin_nontemporal_load(sp), __builtin_nontemporal_load(sp + 128)}; sp += 256; asm volatile("" : "+v"(sp)); } }
    {
        uint4 st[4];
#pragma unroll
        for (int i = 0; i < 4; ++i) { const int id = i * 64 + lane, s = id >> 7, step = (id >> 4) & 7, pc = id & 15;
            st[i] = *(const uint4*)(GQKV + (size_t)(row0 + step) * 3072 + (s == 0 ? 1024 : 0) + h * 128 + pc * 8); }
        unsigned short vv[8];
#pragma unroll
        for (int s = 0; s < 8; ++s) vv[s] = GQKV[(size_t)(row0 + s) * 3072 + 2048 + h * 128 + j];
        float sa = 0.f, sbt = 0.f;
        if (lane < 8) { sa = GA[(size_t)(row0 + lane) * 8 + h]; sbt = GB[(size_t)(row0 + lane) * 8 + h]; }
#pragma unroll
        for (int i = 0; i < 4; ++i) { const int id = i * 64 + lane, s = id >> 7, step = (id >> 4) & 7, pc = id & 15; float f[8]; unpack8(st[i], f);
            LAS float* d = (s == 0 ? KB : QB) + step * 128 + pc * 8; *(LAS f32x4v*)d = (f32x4v){f[0], f[1], f[2], f[3]}; *(LAS f32x4v*)(d + 4) = (f32x4v){f[4], f[5], f[6], f[7]}; }
#pragma unroll
        for (int s = 0; s < 8; ++s) VB[s * 64 + lane] = bf_lo((unsigned)vv[s]);
        if (lane < 8) { AB[lane * 2] = sa; AB[lane * 2 + 1] = sbt; }
        asm volatile("s_waitcnt lgkmcnt(0)" ::: "memory");
    }
#pragma unroll 1
    for (int s = 0; s < 8; ++s) {
        const LAS float* kb = KB + s * 128; const LAS float* qb = QB + s * 128;
        const float v = VB[s * 64 + lane], a = AB[s * 2], beta = AB[s * 2 + 1];
        f32x2v acc0 = (f32x2v){0.f, 0.f}, acc1 = (f32x2v){0.f, 0.f};
#pragma unroll
        for (int i = 0; i < 32; ++i) { const f32x4v kq = *(const LAS f32x4v*)(kb + 4 * i); acc0 = S[2 * i] * kq.lo + acc0; acc1 = S[2 * i + 1] * kq.hi + acc1; if ((i & 7) == 7) __builtin_amdgcn_sched_barrier(0); }
        acc0 += acc1;
        const float kS = acc0.x + acc0.y;
        const float cf = beta * (v - a * kS);
        const f32x2v cf2 = (f32x2v){cf, cf}, a2 = (f32x2v){a, a};
        f32x2v o0 = (f32x2v){0.f, 0.f}, o1 = (f32x2v){0.f, 0.f};
#pragma unroll
        for (int i = 0; i < 32; ++i) { const f32x4v kq = *(const LAS f32x4v*)(kb + 4 * i), qq = *(const LAS f32x4v*)(qb + 4 * i);
            S[2 * i] = S[2 * i] * a2 + kq.lo * cf2; S[2 * i + 1] = S[2 * i + 1] * a2 + kq.hi * cf2;
            o0 = S[2 * i] * qq.lo + o0; o1 = S[2 * i + 1] * qq.hi + o1; if ((i & 3) == 3) __builtin_amdgcn_sched_barrier(0); }
        o0 += o1;
        yraw[(size_t)(row0 + s) * 2048 + h * 128 + j] = o0.x + o0.y;
    }
    { float* dp = st_out + (size_t)bh * 16384 + j;
#pragma unroll
      for (int i = 0; i < 64; ++i) { __builtin_nontemporal_store(S[i].x, dp); __builtin_nontemporal_store(S[i].y, dp + 128); dp += 256; asm volatile("" : "+v"(dp)); } }
    asm volatile("s_waitcnt lgkmcnt(0)" ::: "memory");
}

__device__ __forceinline__ float reduce16(float v) { v = reduce8(v); v += dppf<0x140>(v); return v; }
__device__ __forceinline__ void gdn_prompt_block(LAS float* L, const bf16_t* __restrict__ GQKV, const float* __restrict__ GA, const float* __restrict__ GB, float* __restrict__ yraw,
                                                 int row0, int T, int h, int jblk, float* __restrict__ s_out, int tid, int wave, int lane) {
    constexpr int BUF = 4768;
    const int part = lane & 15, cc = lane >> 4, j0 = jblk + wave * 4, rdoff = part * 8 + (part >> 3) * 4;
    f32x2v S[4];
#pragma unroll
    for (int e = 0; e < 4; ++e) S[e] = (f32x2v){0.f, 0.f};
    const int ss = tid >> 8, sstep = (tid >> 4) & 15, spc = tid & 15, vstep = (tid >> 2) & 15, vp = tid & 3, astep = tid & 15;
    uint4 st, sv = make_uint4(0, 0, 0, 0); float sa = 0.f, sbt = 0.f;
    const int nch = T >> 4;
#define GB_LOAD(c) do { const int t0_ = (c) * 16; st = *(const uint4*)(GQKV + (size_t)(row0 + t0_ + sstep) * 3072 + (ss == 0 ? 1024 : 0) + h * 128 + spc * 8); \
        if (tid < 64) sv = *(const uint4*)(GQKV + (size_t)(row0 + t0_ + vstep) * 3072 + 2048 + h * 128 + jblk + vp * 8); \
        else if (tid < 80) { sa = GA[(size_t)(row0 + t0_ + astep) * 8 + h]; sbt = GB[(size_t)(row0 + t0_ + astep) * 8 + h]; } } while (0)
#define GB_WRITE(b) do { LAS float* base = L + (b) * BUF; { float f[8]; unpack8(st, f); LAS float* d = base + ss * 2112 + sstep * 132 + spc * 8 + (spc >> 3) * 4; \
            *(LAS f32x4v*)d = (f32x4v){f[0], f[1], f[2], f[3]}; *(LAS f32x4v*)(d + 4) = (f32x4v){f[4], f[5], f[6], f[7]}; } \
        if (tid < 64) { float f[8]; unpack8(sv, f); LAS float* d = base + 4224 + vstep * 32 + vp * 8; *(LAS f32x4v*)d = (f32x4v){f[0], f[1], f[2], f[3]}; *(LAS f32x4v*)(d + 4) = (f32x4v){f[4], f[5], f[6], f[7]}; } \
        else if (tid < 80) { base[4736 + astep * 2] = sa; base[4736 + astep * 2 + 1] = sbt; } } while (0)
    GB_LOAD(0); GB_WRITE(0);
    __syncthreads();
    for (int c = 0; c < nch; ++c) {
        if (c + 1 < nch) GB_LOAD(c + 1);
        __builtin_amdgcn_sched_barrier(0);
        const LAS float* base = L + (c & 1) * BUF;
        float os[16];
        f32x2v k[4], q[4], nk[4], nq[4]; float v, a, beta, nv, na, nbeta;
#define GB_OPS(s_) do { const LAS float* kb = base + (s_) * 132 + rdoff; const LAS float* qb = base + 2112 + (s_) * 132 + rdoff; \
            _Pragma("unroll") for (int i = 0; i < 2; ++i) { const f32x4v t0 = *(const LAS f32x4v*)(kb + 4 * i), t1 = *(const LAS f32x4v*)(qb + 4 * i); \
                nk[2 * i] = t0.lo; nk[2 * i + 1] = t0.hi; nq[2 * i] = t1.lo; nq[2 * i + 1] = t1.hi; } \
            nv = base[4224 + (s_) * 32 + wave * 4 + cc]; na = base[4736 + (s_) * 2]; nbeta = base[4736 + (s_) * 2 + 1]; } while (0)
        GB_OPS(0);
#pragma unroll
        for (int s = 0; s < 16; ++s) {
#pragma unroll
            for (int i = 0; i < 4; ++i) { k[i] = nk[i]; q[i] = nq[i]; }
            v = nv; a = na; beta = nbeta;
            if (s < 15) GB_OPS(s + 1);
            __builtin_amdgcn_sched_barrier(0);
            f32x2v acc = S[0] * k[0], acc1 = S[1] * k[1]; acc = S[2] * k[2] + acc; acc1 = S[3] * k[3] + acc1; acc += acc1;
            const float kS = reduce16(acc.x + acc.y);
            const float cf = beta * (v - a * kS);
            const f32x2v cf2 = (f32x2v){cf, cf}, a2 = (f32x2v){a, a};
#pragma unroll
            for (int i = 0; i < 4; ++i) S[i] = S[i] * a2 + k[i] * cf2;
            f32x2v oa = S[0] * q[0], oa1 = S[1] * q[1]; oa = S[2] * q[2] + oa; oa1 = S[3] * q[3] + oa1; oa += oa1;
            os[s] = reduce16(oa.x + oa.y);
            __builtin_amdgcn_sched_barrier(0);
        }
#undef GB_OPS
        { float osel = os[0];
#pragma unroll
          for (int i = 1; i < 16; ++i) osel = (part == i) ? os[i] : osel;
          yraw[(size_t)(row0 + c * 16 + part) * 2048 + h * 128 + j0 + cc] = osel; }
        if (c + 1 < nch) GB_WRITE((c + 1) & 1);
        __syncthreads();
    }
#undef GB_LOAD
#undef GB_WRITE
#pragma unroll
    for (int e = 0; e < 4; ++e) { s_out[(size_t)(part * 8 + 2 * e) * 128 + j0 + cc] = S[e].x; s_out[(size_t)(part * 8 + 2 * e + 1) * 128 + j0 + cc] = S[e].y; }
}
__device__ __forceinline__ void rwkv_prompt_block(LAS float* L, const bf16_t* __restrict__ RS, const bf16_t* __restrict__ RV, const float* __restrict__ RW, float* __restrict__ yraw,
                                                  int row0, int T, int h, int vblk, float* __restrict__ s_out, int tid, int wave, int lane) {
    constexpr int BUF = 5632;
    const int part = lane & 15, rr = lane >> 4, v0 = vblk + wave * 4;
    f32x2v S[2] = {(f32x2v){0.f, 0.f}, (f32x2v){0.f, 0.f}};
    const int sstep = tid >> 5, ss = (tid >> 3) & 3, spc = tid & 7, wstep = (tid >> 4) & 15, wpc = tid & 15, vstep = (tid >> 2) & 15, vp = tid & 3;
    uint4 st, sv = make_uint4(0, 0, 0, 0); float4 sw = make_float4(0.f, 0.f, 0.f, 0.f);
    const int nch = T >> 4;
#define RB_LOAD(c) do { const int t0_ = (c) * 16; st = *(const uint4*)(RS + (size_t)(row0 + t0_ + sstep) * 4096 + ss * 1024 + h * 64 + spc * 8); \
        if (tid < 256) sw = *(const float4*)(RW + (size_t)(row0 + t0_ + wstep) * 1024 + h * 64 + wpc * 4); \
        else if (tid < 320) sv = *(const uint4*)(RV + (size_t)(row0 + t0_ + vstep) * 1024 + h * 64 + vblk + vp * 8); } while (0)
#define RB_WRITE(b) do { LAS float* base = L + (b) * BUF; { float f[8]; unpack8(st, f); LAS float* d = base + (sstep * 4 + ss) * 64 + spc * 8; \
            *(LAS f32x4v*)d = (f32x4v){f[0], f[1], f[2], f[3]}; *(LAS f32x4v*)(d + 4) = (f32x4v){f[4], f[5], f[6], f[7]}; } \
        if (tid < 256) *(LAS f32x4v*)(base + 4096 + wstep * 64 + wpc * 4) = (f32x4v){sw.x, sw.y, sw.z, sw.w}; \
        else if (tid < 320) { float f[8]; unpack8(sv, f); LAS float* d = base + 5120 + vstep * 32 + vp * 8; *(LAS f32x4v*)d = (f32x4v){f[0], f[1], f[2], f[3]}; *(LAS f32x4v*)(d + 4) = (f32x4v){f[4], f[5], f[6], f[7]}; } } while (0)
    RB_LOAD(0); RB_WRITE(0);
    __syncthreads();
    for (int c = 0; c < nch; ++c) {
        if (c + 1 < nch) RB_LOAD(c + 1);
        __builtin_amdgcn_sched_barrier(0);
        const LAS float* base = L + (c & 1) * BUF;
        float ys[16];
        f32x4v kk, ka, kp, r, w, nkk, nka, nkp, nr, nw; float vv, nvv;
#define RB_OPS(s_) do { const LAS float* sb = base + (s_) * 256 + part * 4; nkk = *(const LAS f32x4v*)(sb); nka = *(const LAS f32x4v*)(sb + 64); nkp = *(const LAS f32x4v*)(sb + 128); nr = *(const LAS f32x4v*)(sb + 192); \
            nw = *(const LAS f32x4v*)(base + 4096 + (s_) * 64 + part * 4); nvv = base[5120 + (s_) * 32 + wave * 4 + rr]; } while (0)
        RB_OPS(0);
#pragma unroll
        for (int s = 0; s < 16; ++s) {
            kk = nkk; ka = nka; kp = nkp; r = nr; w = nw; vv = nvv;
            if (s < 15) RB_OPS(s + 1);
            __builtin_amdgcn_sched_barrier(0);
            f32x2v acc = S[0] * kk.lo + S[1] * kk.hi;
            const float sk = reduce16(acc.x + acc.y);
            const f32x2v nsk = (f32x2v){-sk, -sk}, vv2 = (f32x2v){vv, vv};
            S[0] = S[0] * w.lo + (ka.lo * nsk + kp.lo * vv2);
            S[1] = S[1] * w.hi + (ka.hi * nsk + kp.hi * vv2);
            f32x2v ya = S[0] * r.lo + S[1] * r.hi;
            ys[s] = reduce16(ya.x + ya.y);
            __builtin_amdgcn_sched_barrier(0);
        }
#undef RB_OPS
        { float ysel = ys[0];
#pragma unroll
          for (int i = 1; i < 16; ++i) ysel = (part == i) ? ys[i] : ysel;
          yraw[(size_t)(row0 + c * 16 + part) * 2048 + 1024 + h * 64 + v0 + rr] = ysel; }
        if (c + 1 < nch) RB_WRITE((c + 1) & 1);
        __syncthreads();
    }
#undef RB_LOAD
#undef RB_WRITE
    *(float4*)(s_out + (size_t)(v0 + rr) * 64 + part * 4) = make_float4(S[0].x, S[0].y, S[1].x, S[1].y);
}

__device__ __forceinline__ void post_tile(const Args& A, LAS float* lg, int tile, int tid) {
    const bf16_t* PROJ = (const bf16_t*)(A.ws + W_PROJ);
    const bf16_t* RS = (const bf16_t*)(A.ws + W_RS); const bf16_t* RV = (const bf16_t*)(A.ws + W_RV);
    bf16_t* MIXED = (bf16_t*)(A.ws + W_MIXED);
    const float* yraw = A.out + O_Y; const float* st_shift = A.in[5];
    const int row_base = tile * TT;
    const int c0 = tid * 2;
    float2 yv[TT], ov[TT]; unsigned rwv[TT], kwv[TT], vwv[TT], zwv[TT];
#pragma unroll
    for (int tk = 0; tk < TT; ++tk) { const int row = row_base + tk;
        { const f32x2v y_ = __builtin_nontemporal_load((const f32x2v*)(yraw + (size_t)row * 2048 + 1024 + c0)), o_ = __builtin_nontemporal_load((const f32x2v*)(yraw + (size_t)row * 2048 + c0)); yv[tk] = make_float2(y_.x, y_.y); ov[tk] = make_float2(o_.x, o_.y); }
        rwv[tk] = __builtin_nontemporal_load((const unsigned*)(RS + (size_t)row * 4096 + 3072 + c0)); kwv[tk] = __builtin_nontemporal_load((const unsigned*)(RS + (size_t)row * 4096 + 2048 + c0)); vwv[tk] = __builtin_nontemporal_load((const unsigned*)(RV + (size_t)row * 1024 + c0));
        zwv[tk] = *(const unsigned*)(PROJ + (size_t)row * NINP + 3072 + c0); }
    {
        if (tid < 4 * 68) ((LAS unsigned*)lg)[TT * 68 + tid] = 0u;
        const float* mu = A.in[13];
#pragma unroll
        for (int i = 0; i < 2; ++i) { const int item = tid + 512 * i; if (item < TT * 64) { const int tk = item >> 6, jp = item & 63, row = row_base + tk; int grp, b, t, T; rowinfo(row, grp, b, t, T);
            const int col = 3200 + 2 * jp; const unsigned pw_ = *(const unsigned*)(PROJ + (size_t)row * NINP + OFFR + col);
            float q0, q1; if (t > 0) { const unsigned qw = *(const unsigned*)(PROJ + (size_t)(row - 1) * NINP + OFFR + col); q0 = bf_lo(qw); q1 = bf_hi(qw); }
            else if (grp) { const float2 sq = *(const float2*)(st_shift + (size_t)b * RPROJ + col); q0 = sq.x; q1 = sq.y; } else { q0 = 0.f; q1 = 0.f; }
            const float2 m2 = *(const float2*)(mu + col); const float p0 = bf_lo(pw_), p1 = bf_hi(pw_);
            ((LAS unsigned*)lg)[tk * 68 + jp] = pk2_safe(sigmoidf_(p0 + (q0 - p0) * m2.x), sigmoidf_(p1 + (q1 - p1) * m2.y)); } }
    }
    __syncthreads();
    {
        const int wv_ = __builtin_amdgcn_readfirstlane(tid >> 6), ti = tid & 15, quad = (tid & 63) >> 4;
        const LAS unsigned char* lb = (const LAS unsigned char*)lg + ti * 272 + quad * 16;
        pg8::bf16x8 bop[4];
#pragma unroll
        for (int ks = 0; ks < 4; ++ks) bop[ks] = *(const LAS pg8::bf16x8*)(lb + ks * 64);
        const bf16_t* WT = (const bf16_t*)((const unsigned char*)A.out + OB_GBT) + (size_t)(wv_ * 128 + ti) * 128 + quad * 8;
        LAS float* dst = lg + 2048 + (ti < TT ? ti : TT) * 1028 + wv_ * 128 + quad * 4;
#pragma unroll
        for (int hh = 0; hh < 2; ++hh) {
            pg8::bf16x8 aop[4][4];
#pragma unroll
            for (int t = 0; t < 4; ++t)
#pragma unroll
                for (int ks = 0; ks < 4; ++ks) aop[t][ks] = *(const pg8::bf16x8*)(WT + (size_t)(hh * 4 + t) * 16 * 128 + ks * 32);
#pragma unroll
            for (int t = 0; t < 4; ++t) {
                pg8::f32x4 c = (pg8::f32x4){0.f, 0.f, 0.f, 0.f};
#pragma unroll
                for (int ks = 0; ks < 4; ++ks) c = __builtin_amdgcn_mfma_f32_16x16x32_bf16(aop[t][ks], bop[ks], c, 0, 0, 0);
                *(LAS f32x4v*)(dst + (hh * 4 + t) * 16) = (f32x4v){c[0], c[1], c[2], c[3]};
            }
        }
    }
    __syncthreads();
    f32x2v gate[TT];
#pragma unroll
    for (int tk = 0; tk < TT; ++tk) gate[tk] = *(const LAS f32x2v*)(lg + 2048 + tk * 1028 + c0);
    const float2 gnw = *(const float2*)(A.in[22] + c0), gnb = *(const float2*)(A.in[23] + c0), rk = *(const float2*)(A.in[21] + c0);
    const float2 ng = *(const float2*)(A.in[12] + (c0 & 127));
#pragma unroll
    for (int tk = 0; tk < TT; ++tk) {
        const int row = row_base + tk;
        {
            const float2 y = yv[tk];
            const float mean = half_sum32(y.x + y.y) * (1.0f / 64.0f);
            const float d0 = y.x - mean, d1 = y.y - mean;
            const float var = half_sum32(d0 * d0 + d1 * d1) * (1.0f / 64.0f);
            const float rs = rsqrtf(var + 64e-5f);
            const unsigned rw = rwv[tk], kw = kwv[tk], vw = vwv[tk];
            const float bon = half_sum32(bf_lo(rw) * bf_lo(kw) * rk.x + bf_hi(rw) * bf_hi(kw) * rk.y);
            const float o0 = (d0 * rs * gnw.x + gnb.x + bon * bf_lo(vw)) * gate[tk].x, o1 = (d1 * rs * gnw.y + gnb.y + bon * bf_hi(vw)) * gate[tk].y;
            *(unsigned*)(MIXED + (size_t)row * 2048 + 1024 + c0) = pk2(o0, o1);
        }
        {
            const float2 o = ov[tk];
            const float rs = rsqrtf(wave_sum(o.x * o.x + o.y * o.y) * (1.0f / 128.0f) + 1e-6f);
            const unsigned zw = zwv[tk];
            *(unsigned*)(MIXED + (size_t)row * 2048 + c0) = pk2(o.x * rs * ng.x * siluf_(bf_lo(zw)), o.y * rs * ng.y * siluf_(bf_hi(zw)));
        }
    }
    __syncthreads();
}

__device__ __forceinline__ void act_item(const Args& A, int item, int lane) {
    const bf16_t* H = (const bf16_t*)(A.ws + W_H); bf16_t* ACT = (bf16_t*)(A.ws + W_ACT);
    const float* cwp = A.in[27]; const float* st_ffn = A.in[6];
    const int cgp = item % 11, rg = item / 11, ch = (cgp * 64 + lane) * 8;
    float cg_[3][8], cu_[3][8];
#pragma unroll
    for (int i = 0; i < 3; ++i) { const float4 a0 = *(const float4*)(cwp + (size_t)i * DFF2 + ch), a1 = *(const float4*)(cwp + (size_t)i * DFF2 + ch + 4), b0 = *(const float4*)(cwp + (size_t)i * DFF2 + DFF + ch), b1 = *(const float4*)(cwp + (size_t)i * DFF2 + DFF + ch + 4);
        cg_[i][0] = a0.x; cg_[i][1] = a0.y; cg_[i][2] = a0.z; cg_[i][3] = a0.w; cg_[i][4] = a1.x; cg_[i][5] = a1.y; cg_[i][6] = a1.z; cg_[i][7] = a1.w;
        cu_[i][0] = b0.x; cu_[i][1] = b0.y; cu_[i][2] = b0.z; cu_[i][3] = b0.w; cu_[i][4] = b1.x; cu_[i][5] = b1.y; cu_[i][6] = b1.z; cu_[i][7] = b1.w; }
    uint4 hg[11], hu[11];
#pragma unroll
    for (int i = 0; i < 11; ++i) { int r = rg * 9 - 2 + i; r = r < 0 ? 0 : r; hg[i] = *(const uint4*)(H + (size_t)r * DFF2 + ch); hu[i] = *(const uint4*)(H + (size_t)r * DFF2 + DFF + ch); }
#pragma unroll
    for (int rI = 0; rI < 9; ++rI) {
        const int row = rg * 9 + rI; int grp, b, t, T; rowinfo(row, grp, b, t, T);
        float g[8], u[8];
#pragma unroll
        for (int e = 0; e < 8; ++e) { g[e] = 0.f; u[e] = 0.f; }
#pragma unroll
        for (int i = 0; i < 3; ++i) { const int tt = t - 2 + i; float xg[8], xu[8];
            if (tt >= 0) { unpack8(hg[rI + i], xg); unpack8(hu[rI + i], xu); }
            else if (grp) { const float* sp = st_ffn + ((size_t)b * 2 + (t + i)) * DFF2 + ch; const float4 a0 = *(const float4*)sp, a1 = *(const float4*)(sp + 4), b0 = *(const float4*)(sp + DFF), b1 = *(const float4*)(sp + DFF + 4);
                xg[0] = a0.x; xg[1] = a0.y; xg[2] = a0.z; xg[3] = a0.w; xg[4] = a1.x; xg[5] = a1.y; xg[6] = a1.z; xg[7] = a1.w;
                xu[0] = b0.x; xu[1] = b0.y; xu[2] = b0.z; xu[3] = b0.w; xu[4] = b1.x; xu[5] = b1.y; xu[6] = b1.z; xu[7] = b1.w; }
            else {
#pragma unroll
                for (int e = 0; e < 8; ++e) { xg[e] = 0.f; xu[e] = 0.f; } }
#pragma unroll
            for (int e = 0; e < 8; ++e) { g[e] += cg_[i][e] * xg[e]; u[e] += cu_[i][e] * xu[e]; } }
        float o[8];
#pragma unroll
        for (int e = 0; e < 8; ++e) o[e] = siluf_(g[e]) * u[e];
        uint4 w; w.x = pk2(o[0], o[1]); w.y = pk2(o[2], o[3]); w.z = pk2(o[4], o[5]); w.w = pk2(o[6], o[7]);
        *(uint4*)(ACT + (size_t)row * DFF + ch) = w;
    }
}

__device__ __forceinline__ void fast_grid_barrier(unsigned* bar, unsigned round, unsigned G) {
    asm volatile("s_waitcnt vmcnt(0)" ::: "memory");
    __syncthreads();
    if (threadIdx.x == 0) {
        __builtin_amdgcn_fence(__ATOMIC_RELEASE, "agent");
        asm volatile("s_waitcnt vmcnt(0)" ::: "memory");
        const unsigned g = blockIdx.x >> 4, ngroups = (G + 15u) >> 4, gsize = (G - g * 16u) < 16u ? (G - g * 16u) : 16u;
        unsigned* cnt = bar + 32u * (1u + g); unsigned* top = bar + 32u * 20u; unsigned* gen = bar + 32u * (24u + g);
        const unsigned old = __hip_atomic_fetch_add(cnt, 1u, __ATOMIC_RELAXED, __HIP_MEMORY_SCOPE_AGENT);
        if (old + 1u == round * gsize) {
            const unsigned t = __hip_atomic_fetch_add(top, 1u, __ATOMIC_RELAXED, __HIP_MEMORY_SCOPE_AGENT);
            if (t + 1u == round * ngroups) { for (unsigned q = 0; q < ngroups; ++q) __hip_atomic_store(bar + 32u * (24u + q), round, __ATOMIC_RELAXED, __HIP_MEMORY_SCOPE_AGENT); }
        }
        unsigned sp = 0u;
        while (__hip_atomic_load(gen, __ATOMIC_RELAXED, __HIP_MEMORY_SCOPE_AGENT) < round) { __builtin_amdgcn_s_sleep(1); if (++sp > (1u << 22)) break; }
        __builtin_amdgcn_fence(__ATOMIC_ACQUIRE, "agent");
        asm volatile("s_waitcnt vmcnt(0)" ::: "memory");
    }
    __syncthreads();
}

__global__ void __launch_bounds__(512, 2) hymba_fwd(Args A) {
    extern __shared__ __attribute__((aligned(16))) unsigned char lds_raw[];
    LAS unsigned char* lds = (LAS unsigned char*)lds_raw;
    cg::grid_group grid = cg::this_grid();
    const int tid = threadIdx.x, lane = tid & 63, wave = __builtin_amdgcn_readfirstlane(tid >> 6);
    const int G = gridDim.x, bx = blockIdx.x, gw = bx * 8 + wave, NGW = G * 8;
    const int lo = A.ph_lo, hi = A.ph_hi;
#define IN(k) (lo <= (k) && (k) < hi)
    unsigned* barcnt = (unsigned*)(A.ws + W_BAR); unsigned nbar = 0u;
#define SEAM(k) do { if (IN(k) && IN((k) + 1)) { ++nbar; fast_grid_barrier(barcnt, nbar, (unsigned)G); } } while (0)
    if (hi < 0) grid.sync();
    unsigned char* ws = A.ws; float* out = A.out;
    bf16_t* XN = (bf16_t*)(out + O_GDN_S);
    bf16_t* WT_IN = (bf16_t*)(out + O_RWKV_S);
    bf16_t* WT_O = (bf16_t*)(ws + W_WTO); bf16_t* WT_UP = (bf16_t*)(ws + W_WTUP); bf16_t* WT_DN = (bf16_t*)(ws + W_WTDN);
    bf16_t* PROJ = (bf16_t*)(ws + W_PROJ); bf16_t* MIXED = (bf16_t*)(ws + W_MIXED); bf16_t* XN2 = (bf16_t*)(ws + W_XN2);
    bf16_t* HB = (bf16_t*)(ws + W_H); bf16_t* ACT = (bf16_t*)(ws + W_ACT);
    float* X1 = out + O_Y; float* PART = (float*)(ws + W_PART);

    if (IN(0)) {
        LAS float* scr = (LAS float*)(lds + wave * 16384);
        constexpr int I_IN = 32 * (NINP / 64);
        for (int it = gw; it < I_IN; it += NGW) transpose_item(A.in[8], DM, NIN, WT_IN, scr, it, NINP / 64, lane);
        for (int i = bx * 512 + tid; i < 4096 * 8; i += G * 512) {
            int r = (i >> 9) * 64 + (i & 63); const int q = (i >> 6) & 7; const float* W; bf16_t* WT; int K, j0;
            if (r < 1024) { W = A.in[15]; WT = (bf16_t*)((unsigned char*)out + OB_WBT); K = 64; j0 = 0; }
            else if (r < 2048) { r -= 1024; W = A.in[17]; WT = (bf16_t*)((unsigned char*)out + OB_ABT); K = 64; j0 = 0; }
            else { r -= 2048; W = A.in[18]; WT = (bf16_t*)((unsigned char*)out + OB_GBT); K = 128; j0 = (r >> 10) * 64; r &= 1023; }
            const int ch = r;
            float f[8];
#pragma unroll
            for (int e = 0; e < 8; ++e) f[e] = W[(size_t)(j0 + q * 8 + e) * 1024 + ch];
            uint4 o; o.x = pk2(f[0], f[1]); o.y = pk2(f[2], f[3]); o.z = pk2(f[4], f[5]); o.w = pk2(f[6], f[7]);
            *(uint4*)(WT + (size_t)ch * K + j0 + q * 8) = o;
        }
        for (int m = gw; m < MTOK; m += NGW) { const float* xr = (m < MPR) ? A.in[0] + (size_t)m * DM : A.in[1] + (size_t)(m - MPR) * DM; rms_row_bf16<true>(xr, A.in[7], XN + (size_t)m * DM, lane); }
        __syncthreads();
    }
    SEAM(0);
    if (IN(1)) {
        pg8::Gemm g{XN, WT_IN, MTOK, NINP, DM}; pg8::StaticOrder S; S.init(MTOK, NINP, DM, G, bx);
        pg8::EpiBf16P E{PROJ, NINP};
        pg8::gemm_phase<pg8::EpiBf16P, pg8::StaticOrder, true, true>(lds, g, S, E);
    }
    SEAM(1);
    if (IN(2)) { for (int tile = bx; tile < NTILES; tile += G) prep_tile(A, (LAS float*)lds, tile, tid); }
    SEAM(2);
    if (IN(3)) {
        LAS float* sl = (LAS float*)(lds + wave * 16384);
        const bf16_t* GQKV = (const bf16_t*)(ws + W_GQKV); const float* GA = (const float*)(ws + W_GAB); const float* GB = GA + MTOK * 8;
        const bf16_t* RS = (const bf16_t*)(ws + W_RS); const bf16_t* RV = (const bf16_t*)(ws + W_RV); const float* RW = (const float*)(ws + W_RW);
        float* yraw = out + O_Y;
        const bool heavy = (G == 256) && (bx >= 128);
        const int nshare = (G == 256) ? 3072 : NGW, share0 = (G == 256) ? (heavy ? 1024 + ((bx - 128) * 8 + wave) * 2 : gw) : gw, nsh = heavy ? 2 : 1;
        for (int task = gw; task < 2048; task += NGW) gdn_sample_cols(sl, GQKV, GA, GB, yraw, A.in[2], out + O_GDN_S, task, lane);
        for (int sh = 0; sh < nsh; ++sh) {
            rwkv_sample_loop(sl, RS, RV, RW, yraw, A.in[4], out + O_RWKV_S, share0 + sh, nshare, lane);
            constexpr int I_O = 32 * (DM / 64), I_UP = 32 * (DFF2 / 64), I_DN = (DFF / 64) * (DM / 64);
            for (int it = share0 + sh; it < I_O + I_UP + I_DN; it += nshare) {
                int r = it;
                if (r < I_O) { transpose_item(A.in[24], DM, DM, WT_O, sl, r, DM / 64, lane); continue; } r -= I_O;
                if (r < I_UP) { transpose_item(A.in[26], DM, DFF2, WT_UP, sl, r, DFF2 / 64, lane); continue; } r -= I_UP;
                transpose_item(A.in[28], DFF, DM, WT_DN, sl, r, DM / 64, lane);
            }
        }
        __syncthreads();
        for (int u = bx; u < 256; u += G) {
            if (u < 128) { const int bh = u >> 2, cq = u & 3;
                gdn_prompt_block((LAS float*)lds, GQKV, GA, GB, yraw, (bh >> 3) * 2048, 2048, bh & 7, cq * 32, out + O_GDN_P + (size_t)bh * 16384, tid, wave, lane); }
            else { const int uu = u - 128, bh = uu >> 1, hf = uu & 1;
                rwkv_prompt_block((LAS float*)lds, RS, RV, RW, yraw, (bh >> 4) * 2048, 2048, bh & 15, hf * 32, out + O_RWKV_P + (size_t)bh * 4096, tid, wave, lane); }
        }
        __syncthreads();
    }
    SEAM(3);
    if (IN(4)) {
        for (int tile = bx; tile < NTILES; tile += G) post_tile(A, (LAS float*)lds, tile, tid);
    }
    SEAM(4);
    if (IN(5)) {
        pg8::Gemm g{MIXED, WT_O, MTOK, DM, DM}; pg8::SplitOrder S; S.init(DM, bx);
        pg8::EpiResSplit E{A.in[0], X1, PART};
        pg8::gemm_phase<pg8::EpiResSplit, pg8::SplitOrder, true, true>(lds, g, S, E);
    }
    SEAM(5);
    if (IN(6)) {
        LAS float* scr = (LAS float*)(lds + wave * 16384);
        for (int m = gw; m < MTOK; m += NGW) {
            if (m >= MPR) { const float4* xs = (const float4*)(A.in[1] + (size_t)(m - MPR) * DM); float4* xo = (float4*)(X1 + (size_t)m * DM);
#pragma unroll
                for (int j = 0; j < 8; ++j) { float4 a = xs[lane + 64 * j];
#pragma unroll
                    for (int sg = 0; sg < 8; ++sg) { const f32x4v b = __builtin_nontemporal_load((const f32x4v*)(PART + ((size_t)sg * 1024 + (m - MPR)) * DM) + lane + 64 * j); a.x += b[0]; a.y += b[1]; a.z += b[2]; a.w += b[3]; }
                    xo[lane + 64 * j] = a; } }
            rms_row_bf16(X1 + (size_t)m * DM, A.in[25], XN2 + (size_t)m * DM, lane);
        }
        __syncthreads();
    }
    SEAM(6);
    if (IN(7)) {
        pg8::Gemm g{XN2, WT_UP, MTOK, DFF2, DM}; pg8::StaticOrder S; S.init(MTOK, DFF2, DM, G, bx);
        pg8::EpiH E{HB, out + O_FFN_P, out + O_FFN_S};
        pg8::gemm_phase<pg8::EpiH, pg8::StaticOrder, true, true>(lds, g, S, E);
    }
    SEAM(7);
    if (IN(8)) { for (int it = gw; it < 11 * (MTOK / 9); it += NGW) act_item(A, it, lane); }
    SEAM(8);
    if (IN(9)) {
        pg8::Gemm g{ACT, WT_DN, MTOK, DM, DFF}; pg8::SplitOrder S; S.init(DFF, bx);
        pg8::EpiResSplit E{X1, X1, PART};
        pg8::gemm_phase<pg8::EpiResSplit, pg8::SplitOrder, true, true>(lds, g, S, E);
    }
    SEAM(9);
    if (IN(10)) { for (int m = gw; m < MTOK; m += NGW) {
            if (m >= MPR) { float4* xo = (float4*)(X1 + (size_t)m * DM);
#pragma unroll
                for (int j = 0; j < 8; ++j) { float4 a = xo[lane + 64 * j];
#pragma unroll
                    for (int sg = 0; sg < 8; ++sg) { const f32x4v b = __builtin_nontemporal_load((const f32x4v*)(PART + ((size_t)sg * 1024 + (m - MPR)) * DM) + lane + 64 * j); a.x += b[0]; a.y += b[1]; a.z += b[2]; a.w += b[3]; }
                    xo[lane + 64 * j] = a; } }
            if (m < MPR) rms_row_f32_inplace<true>(X1 + (size_t)m * DM, A.in[29], lane); else rms_row_f32_inplace<false>(X1 + (size_t)m * DM, A.in[29], lane); } }
#undef IN
#undef SEAM
}

#ifndef N_LAUNCH_SPLIT
#define N_LAUNCH_SPLIT 0
#endif
extern "C" void kernel_launch(void* const* d_in, const int* in_sizes, int n_in, void* d_out, int out_size, void* d_ws, size_t ws_size, hipStream_t stream) {
    static int grid = 0;
    if (grid == 0) {
        int dev = 0, cus = 0, per_cu = 0;
        hipGetDevice(&dev);
        hipDeviceGetAttribute(&cus, hipDeviceAttributeMultiprocessorCount, dev);
        if (hipFuncSetAttribute((const void*)hymba_fwd, hipFuncAttributeMaxDynamicSharedMemorySize, LDS_BYTES) != hipSuccess) fprintf(stderr, "kernel_launch: hipFuncSetAttribute failed\n");
        if (hipOccupancyMaxActiveBlocksPerMultiprocessor(&per_cu, (const void*)hymba_fwd, 512, LDS_BYTES) != hipSuccess || per_cu < 1) { fprintf(stderr, "kernel_launch: occupancy query says %d\n", per_cu); per_cu = 1; }
        (void)hipGetLastError();
        grid = cus * 1;
        if (n_in != 30 || out_size != (int)O_END || ws_size < W_END4) fprintf(stderr, "kernel_launch: unexpected sizes n_in %d out %d ws %zu (need %zu)\n", n_in, out_size, ws_size, (size_t)W_END3);
    }
    if (hipMemsetAsync((char*)d_ws + W_BAR, 0, 8192, stream) != hipSuccess) fprintf(stderr, "kernel_launch: memset of the barrier word failed\n");
    Args a{};
    for (int i = 0; i < 30; ++i) a.in[i] = (const float*)d_in[i];
    a.out = (float*)d_out; a.ws = (unsigned char*)d_ws;
#if N_LAUNCH_SPLIT
    for (int p = 0; p <= 10; ++p) { a.ph_lo = p; a.ph_hi = p + 1; void* args[] = {&a};
        hipError_t e = hipLaunchCooperativeKernel((const void*)hymba_fwd, dim3(grid), dim3(512), args, LDS_BYTES, stream);
        if (e != hipSuccess) { fprintf(stderr, "kernel_launch: launch of phase %d failed: %s\n", p, hipGetErrorString(e)); break; } }
#else
    a.ph_lo = 0; a.ph_hi = 11; void* args[] = {&a};
    hipError_t e = hipLaunchCooperativeKernel((const void*)hymba_fwd, dim3(grid), dim3(512), args, LDS_BYTES, stream);
    if (e != hipSuccess) fprintf(stderr, "kernel_launch: cooperative launch failed: %s (grid %d)\n", hipGetErrorString(e), grid);
#endif
}
```

```cpp
#include <hip/hip_runtime.h>
#include <hip/hip_cooperative_groups.h>
#include <cstdio>
#include <cstdint>
namespace cg = cooperative_groups;
namespace pg8 {
#define PG8_LAS __attribute__((address_space(3)))
typedef unsigned short bf16_t;
typedef short bf16x8 __attribute__((ext_vector_type(8)));
typedef float f32x4 __attribute__((ext_vector_type(4)));
typedef unsigned u32x4 __attribute__((ext_vector_type(4)));
constexpr int BM = 256, BK = 64, HALF = 128, HTB = HALF * BK * 2  , STAGE_BYTES = 8 * HTB, NXCD = 8, WGM = 8;

__host__ __device__ __forceinline__ int lds_byte(int r, int c) { const int st = (r >> 4) * 2 + (c >> 5), rr = r & 15, cc = c & 31, ob = rr * 64 + cc * 2; return st * 1024 + (ob ^ (((ob >> 9) & 1) << 5)); }
__host__ __device__ __forceinline__ void stage_rc(int b, int& R, int& C) { const int st = b / 1024, sb = b % 1024, swz = sb ^ (((sb >> 9) & 1) << 5); R = (st >> 1) * 16 + swz / 64; C = (st & 1) * 32 + (swz % 64) / 2; }
__host__ __device__ __forceinline__ int perm32(int rho) { const int n = rho >> 4, i = rho & 15; return 8 * (i >> 2) + 4 * n + (i & 3); }

struct Unit { int pm, pn, k0, nt, seg; };
struct Gemm { const bf16_t* A; const bf16_t* Bt; int M, N, K; };

struct StaticOrder {
    int nM, nN, nwg, G, c, ntk;
    __host__ __device__ void init(int M, int N, int K, int G_, int c_) { nM = M / BM; nN = N / BM; nwg = nM * nN; G = G_; c = c_; ntk = K / BK; }
    __host__ __device__ bool next(int i, Unit& u) const {
        const long L = (long)i * G + c; if (L >= nwg) return false;
        int wgid = (int)L; { const int q = nwg / NXCD, r = nwg % NXCD, xcd = wgid % NXCD, off = wgid / NXCD; wgid = (xcd < r ? xcd * (q + 1) : r * (q + 1) + (xcd - r) * q) + off; }
        const int nig = WGM * nN, gid = wgid / nig, fm = gid * WGM, gsz = (nM - fm) < WGM ? (nM - fm) : WGM;
        u.pm = fm + ((wgid % nig) % gsz); u.pn = (wgid % nig) / gsz; u.k0 = 0; u.nt = ntk; u.seg = 0; return true;
    }
    __device__ __forceinline__ void a_ready(const Unit&) const {}
    __device__ __forceinline__ void done(const Unit&) const {}
};
__device__ __forceinline__ unsigned cvt_pk_bf16(float lo, float hi) { unsigned r; asm volatile("s_nop 1\n\tv_cvt_pk_bf16_f32 %0, %1, %2" : "=v"(r) : "v"(lo), "v"(hi)); return r; }
template <class Epi, class Sched, bool ALIGN_EPI = false, bool SP2 = false>
__device__ __forceinline__ void gemm_phase(PG8_LAS unsigned char* lds, const Gemm g, const Sched& S, const Epi& E) {
    const int tid = threadIdx.x, wid = __builtin_amdgcn_readfirstlane(tid >> 6), lane = tid & 63, wr = wid >> 2, wc = wid & 3, fr = lane & 15, fq = lane >> 4;
    const int K = g.K;
    unsigned voffA[2], voffB[2];
#pragma unroll
    for (int i = 0; i < 2; ++i) { int R, C; stage_rc(tid * 16 + i * 8192, R, C); const int Rb = Epi::PERM ? ((R & ~31) + perm32(R & 31)) : R;
        voffA[i] = (unsigned)(R * K + C) * 2u; voffB[i] = (unsigned)(Rb * K + C) * 2u; }
    const size_t kstep = (size_t)(BK * 2);
    const size_t hstep = (size_t)HALF * K * 2;
    const size_t tstep = 2 * hstep;
    const unsigned ldsw = (unsigned)wid * 1024u;
    const int aoff = lds_byte(wr * 64 + fr, fq * 8), boff = lds_byte(wc * 32 + fr, fq * 8);
#define PG8_SA(b, h) (((b) * 2 + (h)) * HTB)
#define PG8_SB(b, h) ((4 + (b) * 2 + (h)) * HTB)
#define PG8_STAGE(bufoff, gbase, voff) do { _Pragma("unroll") for (int _i = 0; _i < 2; ++_i) \
        __builtin_amdgcn_global_load_lds((const unsigned*)((const char*)(gbase) + (voff)[_i]), (PG8_LAS unsigned*)(lds + (bufoff) + ldsw + _i * 8192), 16, 0, 0); } while (0)
#define PG8_LDA(dst, b, h) do { _Pragma("unroll") for (int m = 0; m < 4; ++m) _Pragma("unroll") for (int k = 0; k < 2; ++k) dst[m][k] = *(const PG8_LAS bf16x8*)(lds + PG8_SA(b, h) + aoff + m * 2048 + k * 1024); } while (0)
#define PG8_LDB(dst, b, h) do { _Pragma("unroll") for (int n = 0; n < 2; ++n) _Pragma("unroll") for (int k = 0; k < 2; ++k) dst[n][k] = *(const PG8_LAS bf16x8*)(lds + PG8_SB(b, h) + boff + n * 2048 + k * 1024); } while (0)
#define PG8_MMA(ai, bj, At, Bt) do { __builtin_amdgcn_s_setprio(1); _Pragma("unroll") for (int m = 0; m < 4; ++m) _Pragma("unroll") for (int n = 0; n < 2; ++n) _Pragma("unroll") for (int k = 0; k < 2; ++k) \
        acc[ai][bj][m][n] = __builtin_amdgcn_mfma_f32_16x16x32_bf16(Bt[n][k], At[m][k], acc[ai][bj][m][n], 0, 0, 0); __builtin_amdgcn_s_setprio(0); } while (0)
#define PG8_WAIT_V(n) asm volatile("s_waitcnt vmcnt(" #n ")" ::: "memory")
#define PG8_WAIT_L(n) asm volatile("s_waitcnt lgkmcnt(" #n ")" ::: "memory")
#define PG8_BAR __builtin_amdgcn_s_barrier()
#define PG8_SCHED __builtin_amdgcn_sched_barrier(0)
    Unit cur, nxt; int ui = 0;
    if (!S.next(0, cur)) return;
    f32x4 acc[2][2][4][2];
#pragma unroll
    for (int a = 0; a < 2; ++a)
#pragma unroll
        for (int b = 0; b < 2; ++b)
#pragma unroll
            for (int m = 0; m < 4; ++m)
#pragma unroll
                for (int n = 0; n < 2; ++n) acc[a][b][m][n] = (f32x4){0.f, 0.f, 0.f, 0.f};
    bf16x8 At[4][2], B0[2][2], B1[2][2];
    const char* cA = (const char*)g.A + (size_t)cur.pm * tstep + (size_t)cur.k0 * kstep; const char* cB = (const char*)g.Bt + (size_t)cur.pn * tstep + (size_t)cur.k0 * kstep;
    S.a_ready(cur);
    if constexpr (SP2) {
        PG8_STAGE(PG8_SB(0, 0), cB, voffB); PG8_STAGE(PG8_SB(0, 1), cB + hstep, voffB); PG8_STAGE(PG8_SA(0, 0), cA, voffA); PG8_STAGE(PG8_SA(0, 1), cA + hstep, voffA);
        if (wr == 1) PG8_BAR;
        PG8_WAIT_V(2); PG8_BAR;
        PG8_STAGE(PG8_SB(1, 0), cB + kstep, voffB); PG8_STAGE(PG8_SA(1, 0), cA + kstep, voffA); PG8_STAGE(PG8_SB(1, 1), cB + hstep + kstep, voffB);
        PG8_WAIT_V(6); PG8_BAR;
    } else {
        PG8_STAGE(PG8_SB(0, 0), cB, voffB); PG8_STAGE(PG8_SA(0, 0), cA, voffA); PG8_STAGE(PG8_SB(0, 1), cB + hstep, voffB); PG8_STAGE(PG8_SA(0, 1), cA + hstep, voffA);
        if (wr == 1) PG8_BAR;
        PG8_WAIT_V(4); PG8_BAR;
        PG8_STAGE(PG8_SB(1, 0), cB + kstep, voffB); PG8_STAGE(PG8_SA(1, 0), cA + kstep, voffA); PG8_STAGE(PG8_SB(1, 1), cB + hstep + kstep, voffB);
        PG8_WAIT_V(6); PG8_BAR;
    }
    for (;;) {
        const bool has_next = S.next(ui + 1, nxt);
        const char* nA = has_next ? (const char*)g.A + (size_t)nxt.pm * tstep + (size_t)nxt.k0 * kstep : cA; const char* nB = has_next ? (const char*)g.Bt + (size_t)nxt.pn * tstep + (size_t)nxt.k0 * kstep : cB;
        const int nt = cur.nt;
        for (int t = 0; t < nt; t += 2) {
            const bool last = (t == nt - 2);
            const char* a1 = cA + (size_t)(t + 1) * kstep;
            const char* a2 = last ? nA : cA + (size_t)(t + 2) * kstep; const char* b2 = last ? nB : cB + (size_t)(t + 2) * kstep;
            const char* a3 = a2 + kstep; const char* b3 = b2 + kstep;
            if (last && has_next) S.a_ready(nxt);
            if constexpr (SP2) {
            PG8_LDB(B0, 0, 0); PG8_LDB(B1, 0, 1); PG8_SCHED; PG8_LDA(At, 0, 0); PG8_STAGE(PG8_SA(1, 1), a1 + hstep, voffA);
            PG8_WAIT_V(8); PG8_WAIT_L(0); PG8_BAR; PG8_MMA(0, 0, At, B0); PG8_MMA(0, 1, At, B1); PG8_BAR; PG8_SCHED;
            PG8_LDA(At, 0, 1); PG8_STAGE(PG8_SB(0, 0), b2, voffB); PG8_STAGE(PG8_SB(0, 1), b2 + hstep, voffB); PG8_STAGE(PG8_SA(0, 0), a2, voffA);
            PG8_WAIT_V(8); PG8_WAIT_L(0); PG8_BAR; PG8_MMA(1, 0, At, B0); PG8_MMA(1, 1, At, B1); PG8_BAR; PG8_SCHED;
            PG8_LDB(B0, 1, 0); PG8_LDB(B1, 1, 1); PG8_SCHED; PG8_LDA(At, 1, 0); PG8_STAGE(PG8_SA(0, 1), a2 + hstep, voffA);
            PG8_WAIT_V(8); PG8_WAIT_L(0); PG8_BAR; PG8_MMA(0, 0, At, B0); PG8_MMA(0, 1, At, B1); PG8_BAR; PG8_SCHED;
            PG8_LDA(At, 1, 1); PG8_STAGE(PG8_SB(1, 0), b3, voffB); PG8_STAGE(PG8_SB(1, 1), b3 + hstep, voffB); PG8_STAGE(PG8_SA(1, 0), a3, voffA);
            PG8_WAIT_V(8); PG8_WAIT_L(0); PG8_BAR; PG8_MMA(1, 0, At, B0); PG8_MMA(1, 1, At, B1); PG8_BAR; PG8_SCHED;
            } else {
            PG8_LDB(B0, 0, 0); PG8_SCHED; PG8_LDA(At, 0, 0); PG8_STAGE(PG8_SA(1, 1), a1 + hstep, voffA);
            PG8_WAIT_L(8); PG8_BAR; PG8_WAIT_L(0); PG8_MMA(0, 0, At, B0); PG8_BAR; PG8_SCHED;
            PG8_LDB(B1, 0, 1); PG8_STAGE(PG8_SB(0, 0), b2, voffB);
            PG8_BAR; PG8_WAIT_L(0); PG8_MMA(0, 1, At, B1); PG8_BAR;
            PG8_LDA(At, 0, 1); PG8_STAGE(PG8_SA(0, 0), a2, voffA);
            PG8_BAR; PG8_WAIT_L(0); PG8_MMA(1, 0, At, B0); PG8_BAR; PG8_SCHED;
            PG8_STAGE(PG8_SB(0, 1), b2 + hstep, voffB);
            PG8_WAIT_V(6); PG8_BAR; PG8_MMA(1, 1, At, B1); PG8_BAR;
            PG8_LDB(B0, 1, 0); PG8_SCHED; PG8_LDA(At, 1, 0); PG8_STAGE(PG8_SA(0, 1), a2 + hstep, voffA);
            PG8_WAIT_L(8); PG8_BAR; PG8_WAIT_L(0); PG8_MMA(0, 0, At, B0); PG8_BAR; PG8_SCHED;
            PG8_LDB(B1, 1, 1); PG8_STAGE(PG8_SB(1, 0), b3, voffB);
            PG8_BAR; PG8_WAIT_L(0); PG8_MMA(0, 1, At, B1); PG8_BAR;
            PG8_LDA(At, 1, 1); PG8_STAGE(PG8_SA(1, 0), a3, voffA);
            PG8_BAR; PG8_WAIT_L(0); PG8_MMA(1, 0, At, B0); PG8_BAR; PG8_SCHED;
            PG8_STAGE(PG8_SB(1, 1), b3 + hstep, voffB);
            PG8_WAIT_V(6); PG8_BAR; PG8_MMA(1, 1, At, B1); PG8_BAR;
            }
        }
        if constexpr (ALIGN_EPI) { if (wr == 0) PG8_BAR; }
        if constexpr (!Epi::AFTER_DRAIN) { E(acc, cur, wr, wc, fr, fq); S.done(cur); }
        if (!has_next) break;
#pragma unroll
        for (int a = 0; a < 2; ++a)
#pragma unroll
            for (int b = 0; b < 2; ++b)
#pragma unroll
                for (int m = 0; m < 4; ++m)
#pragma unroll
                    for (int n = 0; n < 2; ++n) acc[a][b][m][n] = (f32x4){0.f, 0.f, 0.f, 0.f};
        cur = nxt; cA = nA; cB = nB; ++ui;
        if constexpr (ALIGN_EPI) { if (wr == 1) PG8_BAR; }
    }
    PG8_WAIT_V(0);
    if constexpr (!ALIGN_EPI) { if (wr == 0) PG8_BAR; }
    PG8_BAR;
    if constexpr (Epi::AFTER_DRAIN) { E.fused(acc, cur, wr, wc, fr, fq, lds, wid, lane); S.done(cur); }
#undef PG8_SA
#undef PG8_SB
#undef PG8_STAGE
#undef PG8_LDA
#undef PG8_LDB
#undef PG8_MMA
#undef PG8_WAIT_V
#undef PG8_WAIT_L
#undef PG8_BAR
#undef PG8_SCHED
}
}

namespace pg8 {
struct EpiBf16P {
    static constexpr bool PERM = true, AFTER_DRAIN = false;
    bf16_t* O; int ldc;
    __device__ __forceinline__ void operator()(const f32x4 (&acc)[2][2][4][2], const Unit& u, int wr, int wc, int fr, int fq) const {
        const int row0 = u.pm * BM + wr * 64 + fr, col0 = u.pn * BM + wc * 32 + 8 * fq;
#pragma unroll
        for (int ai = 0; ai < 2; ++ai)
#pragma unroll
            for (int m = 0; m < 4; ++m) { bf16_t* rowp = O + (size_t)(row0 + ai * HALF + m * 16) * ldc + col0;
#pragma unroll
                for (int bj = 0; bj < 2; ++bj) { const f32x4 v0 = acc[ai][bj][m][0], v1 = acc[ai][bj][m][1];
                    u32x4 w; w.x = cvt_pk_bf16(v0[0], v0[1]); w.y = cvt_pk_bf16(v0[2], v0[3]); w.z = cvt_pk_bf16(v1[0], v1[1]); w.w = cvt_pk_bf16(v1[2], v1[3]);
                    *(u32x4*)(rowp + bj * HALF) = w; } }
    }
};
struct EpiH {
    static constexpr bool PERM = true, AFTER_DRAIN = false;
    bf16_t* O; float* ffn_p; float* ffn_s;
    __device__ __forceinline__ void operator()(const f32x4 (&acc)[2][2][4][2], const Unit& u, int wr, int wc, int fr, int fq) const {
        const int row0 = u.pm * BM + wr * 64 + fr, col0 = u.pn * BM + wc * 32 + 8 * fq;
#pragma unroll
        for (int ai = 0; ai < 2; ++ai)
#pragma unroll
            for (int m = 0; m < 4; ++m) { const int row = row0 + ai * HALF + m * 16; bf16_t* rowp = O + (size_t)row * 11264 + col0;
                float* tail = nullptr;
                if (row < 8192) { const int t = row & 2047; if (t >= 2046) tail = ffn_p + (size_t)((row >> 11) * 2 + (t - 2046)) * 11264 + col0; }
                else { const int r = row - 8192, t = r & 7; if (t >= 6) tail = ffn_s + (size_t)((r >> 3) * 2 + (t - 6)) * 11264 + col0; }
#pragma unroll
                for (int bj = 0; bj < 2; ++bj) { const f32x4 v0 = acc[ai][bj][m][0], v1 = acc[ai][bj][m][1];
                    u32x4 w; w.x = cvt_pk_bf16(v0[0], v0[1]); w.y = cvt_pk_bf16(v0[2], v0[3]); w.z = cvt_pk_bf16(v1[0], v1[1]); w.w = cvt_pk_bf16(v1[2], v1[3]);
                    *(u32x4*)(rowp + bj * HALF) = w;
                    if (tail) { *(f32x4*)(tail + bj * HALF) = v0; *(f32x4*)(tail + bj * HALF + 4) = v1; } } }
    }
};
struct EpiRes {
    static constexpr bool PERM = false, AFTER_DRAIN = false;
    const float* base_p; const float* base_s; float* out;
    __device__ __forceinline__ void operator()(const f32x4 (&acc)[2][2][4][2], const Unit& u, int wr, int wc, int fr, int fq) const {
        const int row0 = u.pm * BM + wr * 64 + fr, col0 = u.pn * BM + wc * 32 + 4 * fq;
        const float* base = (u.pm < 32) ? base_p : (base_s - (size_t)8192 * 2048);
#pragma unroll
        for (int ai = 0; ai < 2; ++ai)
#pragma unroll
            for (int m = 0; m < 4; ++m) { const size_t off = (size_t)(row0 + ai * HALF + m * 16) * 2048 + col0;
#pragma unroll
                for (int bj = 0; bj < 2; ++bj)
#pragma unroll
                    for (int n = 0; n < 2; ++n) { const f32x4 bs = *(const f32x4*)(base + off + bj * HALF + n * 16); *(f32x4*)(out + off + bj * HALF + n * 16) = bs + acc[ai][bj][m][n]; }
                asm volatile("" ::: "memory"); }
    }
};
struct SplitOrder {
    int c, ntk;
    __device__ void init(int K, int c_) { c = c_; ntk = K / BK; }
    __device__ bool next(int i, Unit& u) const {
        if (i == 0) { const int xcd = c & 7, j = c >> 3; u.pm = xcd * 4 + (j >> 3); u.pn = j & 7; u.k0 = 0; u.nt = ntk; u.seg = 0; return true; }
        if (i == 1) { const int uu = c >> 3, seg = c & 7, P = ntk >> 1, p0 = (seg * P) >> 3, p1 = ((seg + 1) * P) >> 3; u.pm = 32 + (uu >> 3); u.pn = uu & 7; u.k0 = 2 * p0; u.nt = 2 * (p1 - p0); u.seg = seg; return true; }
        return false;
    }
    __device__ __forceinline__ void a_ready(const Unit&) const {}
    __device__ __forceinline__ void done(const Unit&) const {}
};
struct EpiResSplit {
    static constexpr bool PERM = false, AFTER_DRAIN = false;
    const float* base_p; float* out_p; float* acc_s;
    __device__ __forceinline__ void operator()(const f32x4 (&acc)[2][2][4][2], const Unit& u, int wr, int wc, int fr, int fq) const {
        const int row0 = u.pm * BM + wr * 64 + fr, col0 = u.pn * BM + wc * 32 + 4 * fq;
        if (u.pm < 32) {
#pragma unroll
            for (int ai = 0; ai < 2; ++ai)
#pragma unroll
                for (int m = 0; m < 4; ++m) { const size_t off = (size_t)(row0 + ai * HALF + m * 16) * 2048 + col0;
#pragma unroll
                    for (int bj = 0; bj < 2; ++bj)
#pragma unroll
                        for (int n = 0; n < 2; ++n) { const f32x4 bs = *(const f32x4*)(base_p + off + bj * HALF + n * 16); *(f32x4*)(out_p + off + bj * HALF + n * 16) = bs + acc[ai][bj][m][n]; }
                    asm volatile("" ::: "memory"); }
        } else {
#pragma unroll
            for (int ai = 0; ai < 2; ++ai)
#pragma unroll
                for (int m = 0; m < 4; ++m) { float* p = acc_s + ((size_t)u.seg * 1024 + (size_t)(row0 - 8192 + ai * HALF + m * 16)) * 2048 + col0;
#pragma unroll
                    for (int bj = 0; bj < 2; ++bj)
#pragma unroll
                        for (int n = 0; n < 2; ++n) *(f32x4*)(p + bj * HALF + n * 16) = acc[ai][bj][m][n]; }
        }
    }
};
}

#define LAS __attribute__((address_space(3)))
typedef unsigned short bf16_t;
typedef float f32x4v __attribute__((ext_vector_type(4)));
typedef float f32x2v __attribute__((ext_vector_type(2)));
constexpr int MTOK = 9216, MPR = 8192, DM = 2048, NIN = 7440, NINP = 7680, DFF = 5632, DFF2 = 11264, RPROJ = 3328, OFFR = 4112;
constexpr int TT = 12, NTILES = MTOK / TT;
constexpr int LDS_BYTES = 131072;
constexpr size_t O_Y = 0, O_GDN_P = 18874368, O_GCONV_P = 19398656, O_RWKV_P = 19435520, O_SHIFT_P = 19697664, O_FFN_P = 19710976,
                 O_GDN_S = 19801088, O_GCONV_S = 36578304, O_RWKV_S = 37757952, O_SHIFT_S = 46146560, O_FFN_S = 46572544, O_END = 49456128;
constexpr size_t W_WTUP = 0, W_WTO = 46137344, W_PROJ = 54525952, W_GQKV = 196083712, W_GAB = 252706816, W_RS = 253296640, W_RV = 328794112, W_RW = 347668480, W_END1 = 385417216;
constexpr size_t W_PART = W_PROJ;
constexpr size_t W_MIXED = W_GQKV, W_H = W_WTO, W_WTDN = W_END1, W_ACT = W_H + (size_t)MTOK * DFF2 * 2 + (size_t)DM * DFF * 2, W_XN2 = W_ACT, W_END2 = W_ACT + (size_t)MTOK * DFF * 2, W_END3 = W_WTDN + (size_t)DM * DFF * 2;
static_assert(W_END2 <= W_END1 + 0, "late-phase overlay must fit");
static_assert(W_END3 == 408485888 && W_END2 == 380633088, "layout");
constexpr size_t W_BAR = W_END3, W_END4 = W_BAR + 8192;
constexpr size_t OB_WBT = O_FFN_S * 4, OB_ABT = OB_WBT + 1024 * 64 * 2, OB_GBT = OB_ABT + 1024 * 64 * 2;

struct Args { const float* in[30]; float* out; unsigned char* ws; int ph_lo, ph_hi; };

__device__ __forceinline__ float bf_lo(unsigned w) { return __uint_as_float(w << 16); }
__device__ __forceinline__ float bf_hi(unsigned w) { return __uint_as_float(w & 0xffff0000u); }
__device__ __forceinline__ unsigned pk2(float lo, float hi) { return pg8::cvt_pk_bf16(lo, hi); }
__device__ __forceinline__ unsigned pk2_safe(float lo, float hi) { unsigned r; asm volatile("s_nop 4\n\tv_cvt_pk_bf16_f32 %0, %1, %2" : "=v"(r) : "v"(lo), "v"(hi)); return r; }
__device__ __forceinline__ void unpack8(const uint4 w, float (&f)[8]) { f[0] = bf_lo(w.x); f[1] = bf_hi(w.x); f[2] = bf_lo(w.y); f[3] = bf_hi(w.y); f[4] = bf_lo(w.z); f[5] = bf_hi(w.z); f[6] = bf_lo(w.w); f[7] = bf_hi(w.w); }
__device__ __forceinline__ float wave_sum(float v) {
#pragma unroll
    for (int o = 1; o < 64; o <<= 1) v += __shfl_xor(v, o);
    return v;
}
__device__ __forceinline__ float half_sum32(float v) {
#pragma unroll
    for (int o = 1; o < 32; o <<= 1) v += __shfl_xor(v, o);
    return v;
}
__device__ __forceinline__ float sum16(float v) {
#pragma unroll
    for (int o = 1; o < 16; o <<= 1) v += __shfl_xor(v, o);
    return v;
}
template <int CTRL> __device__ __forceinline__ float dppf(float v) { return __int_as_float(__builtin_amdgcn_update_dpp(0, __float_as_int(v), CTRL, 0xF, 0xF, true)); }
__device__ __forceinline__ float reduce8(float v) {
    v += dppf<0xB1>(v);
    v += dppf<0x4E>(v);
    v += dppf<0x141>(v);
    return v;
}
__device__ __forceinline__ float sigmoidf_(float x) { return __builtin_amdgcn_rcpf(1.0f + __expf(-x)); }
__device__ __forceinline__ float siluf_(float x) { return x * __builtin_amdgcn_rcpf(1.0f + __expf(-x)); }
__device__ __forceinline__ float softplusf_(float x) { return fmaxf(x, 0.f) + __logf(1.0f + __expf(-fabsf(x))); }
__device__ __forceinline__ float tanhf_(float x) { const float e = __expf(-2.0f * fabsf(x)); const float r = (1.0f - e) * __builtin_amdgcn_rcpf(1.0f + e); return x < 0.f ? -r : r; }
__device__ __forceinline__ void rowinfo(int row, int& grp, int& b, int& t, int& T) {
    if (row < MPR) { grp = 0; b = row >> 11; t = row & 2047; T = 2048; } else { const int r = row - MPR; grp = 1; b = r >> 3; t = r & 7; T = 8; }
}
#define LDS_WAIT() asm volatile("s_waitcnt lgkmcnt(0)" ::: "memory")

__device__ __forceinline__ void transpose_item(const float* __restrict__ W, int K, int N, bf16_t* __restrict__ WT, LAS float* scr, int item, int nblk, int lane) {
    const int kb = item / nblk, nb = item - kb * nblk, k0 = 64 * kb, n0 = 64 * nb;
    const int r4 = lane >> 4, c4 = (lane & 15) * 4, n_in = n0 + c4;
    float4 v[16];
#pragma unroll
    for (int i = 0; i < 16; ++i) { if (n_in < N) { const f32x4v t_ = __builtin_nontemporal_load((const f32x4v*)(W + (size_t)(k0 + 4 * i + r4) * N + n_in)); v[i] = make_float4(t_[0], t_[1], t_[2], t_[3]); } else v[i] = make_float4(0.f, 0.f, 0.f, 0.f); }
#pragma unroll
    for (int i = 0; i < 16; ++i) { const int k = 4 * i + r4; *(LAS f32x4v*)(scr + k * 64 + (c4 ^ (8 * ((k >> 3) & 7)))) = (f32x4v){v[i].x, v[i].y, v[i].z, v[i].w}; }
    LDS_WAIT();
    const int c = lane & 7;
#pragma unroll
    for (int j = 0; j < 8; ++j) { const int n = (lane >> 3) + 8 * j; const LAS float* sp = scr + (8 * c) * 64 + (n ^ (8 * c));
        uint4 o; o.x = pk2(sp[0], sp[64]); o.y = pk2(sp[128], sp[192]); o.z = pk2(sp[256], sp[320]); o.w = pk2(sp[384], sp[448]);
        *(uint4*)(WT + (size_t)(n0 + n) * K + k0 + 8 * c) = o; }
    LDS_WAIT();
}
template <bool NT = false>
__device__ __forceinline__ void rms_row_bf16(const float* __restrict__ xrow, const float* __restrict__ g, bf16_t* __restrict__ orow, int lane) {
    float4 v[8]; float ss = 0.f;
#pragma unroll
    for (int j = 0; j < 8; ++j) { if (NT) { const f32x4v t_ = __builtin_nontemporal_load((const f32x4v*)xrow + lane + 64 * j); v[j] = make_float4(t_[0], t_[1], t_[2], t_[3]); } else v[j] = ((const float4*)xrow)[lane + 64 * j]; ss += (v[j].x * v[j].x + v[j].y * v[j].y) + (v[j].z * v[j].z + v[j].w * v[j].w); }
    const float rs = rsqrtf(wave_sum(ss) * (1.0f / DM) + 1e-6f);
#pragma unroll
    for (int j = 0; j < 8; ++j) { const float4 gg = ((const float4*)g)[lane + 64 * j];
        uint2 o; o.x = pk2(v[j].x * rs * gg.x, v[j].y * rs * gg.y); o.y = pk2(v[j].z * rs * gg.z, v[j].w * rs * gg.w);
        ((uint2*)orow)[lane + 64 * j] = o; }
}
template <bool NT = false>
__device__ __forceinline__ void rms_row_f32_inplace(float* xrow, const float* __restrict__ g, int lane) {
    float4 v[8]; float ss = 0.f;
#pragma unroll
    for (int j = 0; j < 8; ++j) { if (NT) { const f32x4v t_ = __builtin_nontemporal_load((const f32x4v*)xrow + lane + 64 * j); v[j] = make_float4(t_[0], t_[1], t_[2], t_[3]); } else v[j] = ((const float4*)xrow)[lane + 64 * j]; ss += (v[j].x * v[j].x + v[j].y * v[j].y) + (v[j].z * v[j].z + v[j].w * v[j].w); }
    const float rs = rsqrtf(wave_sum(ss) * (1.0f / DM) + 1e-6f);
#pragma unroll
    for (int j = 0; j < 8; ++j) { const float4 gg = ((const float4*)g)[lane + 64 * j];
        float4 o; o.x = v[j].x * rs * gg.x; o.y = v[j].y * rs * gg.y; o.z = v[j].z * rs * gg.z; o.w = v[j].w * rs * gg.w;
        if (NT) __builtin_nontemporal_store((f32x4v){o.x, o.y, o.z, o.w}, (f32x4v*)xrow + lane + 64 * j); else ((float4*)xrow)[lane + 64 * j] = o; }
}

__device__ __forceinline__ void prep_tile(const Args& A, LAS float* lw, int tile, int tid) {
    const bf16_t* PROJ = (const bf16_t*)(A.ws + W_PROJ);
    bf16_t* GQKV = (bf16_t*)(A.ws + W_GQKV); float* GA = (float*)(A.ws + W_GAB); float* GB = GA + MTOK * 8;
    bf16_t* RS = (bf16_t*)(A.ws + W_RS); bf16_t* RV = (bf16_t*)(A.ws + W_RV); float* RW = (float*)(A.ws + W_RW);
    const float* st_gconv = A.in[3]; const float* st_shift = A.in[5];
    const int row_base = tile * TT;
    const int c0 = tid * 2;
    unsigned pw[TT + 1][3];
#pragma unroll
    for (int i = 0; i < TT + 1; ++i) { int r = row_base - 1 + i; r = r < 0 ? 0 : r; const bf16_t* pr = PROJ + (size_t)r * NINP + OFFR + c0;
        pw[i][0] = *(const unsigned*)pr; pw[i][1] = *(const unsigned*)(pr + 1024); pw[i][2] = *(const unsigned*)(pr + 2048); }
    uint4 xr[TT + 3];
    { const int chx = (tid < 384 ? tid : 383) * 8;
#pragma unroll
      for (int i = 0; i < TT + 3; ++i) { int r = row_base - 3 + i; r = r < 0 ? 0 : r; xr[i] = *(const uint4*)(PROJ + (size_t)r * NINP + chx); } }
    {
        if (tid < 4 * 68) ((LAS unsigned*)lw)[TT * 68 + tid] = 0u;
        const float* mu = A.in[13];
#pragma unroll
        for (int i = 0; i < 2; ++i) { const int item = tid + 512 * i; if (item < TT * 64) { const int tk = item >> 6, jp = item & 63, row = row_base + tk; int grp, b, t, T; rowinfo(row, grp, b, t, T);
            const int col = 3072 + 2 * jp; const unsigned pw_ = *(const unsigned*)(PROJ + (size_t)row * NINP + OFFR + col);
            float q0, q1; if (t > 0) { const unsigned qw = *(const unsigned*)(PROJ + (size_t)(row - 1) * NINP + OFFR + col); q0 = bf_lo(qw); q1 = bf_hi(qw); }
            else if (grp) { const float2 sq = *(const float2*)(st_shift + (size_t)b * RPROJ + col); q0 = sq.x; q1 = sq.y; } else { q0 = 0.f; q1 = 0.f; }
            const float2 m2 = *(const float2*)(mu + col); const float p0 = bf_lo(pw_), p1 = bf_hi(pw_);
            float x0 = p0 + (q0 - p0) * m2.x, x1 = p1 + (q1 - p1) * m2.y;
            if (jp < 32) { x0 = tanhf_(x0); x1 = tanhf_(x1); }
            ((LAS unsigned*)lw)[tk * 68 + jp] = pk2_safe(x0, x1); } }
    }
    if (tid < 384) {
        const int ch = tid * 8, stream = tid >> 7;
        const float* cwp = A.in[9];
        float cw[4][8];
#pragma unroll
        for (int i = 0; i < 4; ++i) { const float4 a0 = *(const float4*)(cwp + i * 3072 + ch), a1 = *(const float4*)(cwp + i * 3072 + ch + 4);
            cw[i][0] = a0.x; cw[i][1] = a0.y; cw[i][2] = a0.z; cw[i][3] = a0.w; cw[i][4] = a1.x; cw[i][5] = a1.y; cw[i][6] = a1.z; cw[i][7] = a1.w; }
#pragma unroll
        for (int tk = 0; tk < TT; ++tk) {
            const int row = row_base + tk; int grp, b, t, T; rowinfo(row, grp, b, t, T);
            float y[8], xl[8];
#pragma unroll
            for (int e = 0; e < 8; ++e) y[e] = 0.f;
#pragma unroll
            for (int i = 0; i < 4; ++i) { const int tt = t - 3 + i; float x[8];
                if (tt >= 0) { unpack8(xr[tk + i], x); }
                else if (grp) { const float* sp = st_gconv + ((size_t)b * 3 + (t + i)) * 3072 + ch; const float4 a0 = *(const float4*)sp, a1 = *(const float4*)(sp + 4);
                    x[0] = a0.x; x[1] = a0.y; x[2] = a0.z; x[3] = a0.w; x[4] = a1.x; x[5] = a1.y; x[6] = a1.z; x[7] = a1.w; }
                else {
#pragma unroll
                    for (int e = 0; e < 8; ++e) x[e] = 0.f; }
#pragma unroll
                for (int e = 0; e < 8; ++e) { y[e] += cw[i][e] * x[e]; if (i == 3) xl[e] = x[e]; } }
            float ss = 0.f;
#pragma unroll
            for (int e = 0; e < 8; ++e) { y[e] = siluf_(y[e]); ss += y[e] * y[e]; }
            if (stream < 2) { ss = sum16(ss); const float sc = rsqrtf(ss + 1e-12f) * (stream == 0 ? 0.08838834764831845f : 1.0f);
#pragma unroll
                for (int e = 0; e < 8; ++e) y[e] *= sc; }
            uint4 o; o.x = pk2(y[0], y[1]); o.y = pk2(y[2], y[3]); o.z = pk2(y[4], y[5]); o.w = pk2(y[6], y[7]);
            *(uint4*)(GQKV + (size_t)row * 3072 + ch) = o;
            if (t >= T - 3) { float* gp = A.out + (grp ? O_GCONV_S : O_GCONV_P) + ((size_t)b * 3 + (t - (T - 3))) * 3072 + ch;
                *(float4*)gp = make_float4(xl[0], xl[1], xl[2], xl[3]); *(float4*)(gp + 4) = make_float4(xl[4], xl[5], xl[6], xl[7]); }
        }
    } else if (tid < 384 + TT * 8) {
        const int idx = tid - 384, tk = idx >> 3, h = idx & 7, row = row_base + tk;
        const float pb = bf_lo((unsigned)PROJ[(size_t)row * NINP + 4096 + h]), pa = bf_lo((unsigned)PROJ[(size_t)row * NINP + 4104 + h]);
        const float g = -__expf(A.in[10][h]) * softplusf_(pa + A.in[11][h]);
        GA[(size_t)row * 8 + h] = __expf(g); GB[(size_t)row * 8 + h] = sigmoidf_(pb);
    }
    __syncthreads();
    {
        const int wv_ = __builtin_amdgcn_readfirstlane(tid >> 6), ti = tid & 15, quad = (tid & 63) >> 4;
        LAS float* AWL = lw + 2048; LAS float* AAL = lw + 2048 + 13364;
        const LAS unsigned char* lb = (const LAS unsigned char*)lw + ti * 272 + quad * 16;
        pg8::bf16x8 bop[4];
#pragma unroll
        for (int ks = 0; ks < 4; ++ks) bop[ks] = *(const LAS pg8::bf16x8*)(lb + ks * 64);
#pragma unroll
        for (int which = 0; which < 2; ++which) {
            const bf16_t* WT = (const bf16_t*)((const unsigned char*)A.out + (which == 0 ? OB_WBT : OB_ABT)) + (size_t)(wv_ * 128 + ti) * 64 + quad * 8;
            const float* bias = A.in[which == 0 ? 14 : 16] + wv_ * 128 + quad * 4;
            LAS float* dst = (which == 0 ? AWL : AAL) + (ti < TT ? ti : TT) * 1028 + wv_ * 128 + quad * 4;
            pg8::bf16x8 aop[8][2];
#pragma unroll
            for (int t = 0; t < 8; ++t) { aop[t][0] = *(const pg8::bf16x8*)(WT + (size_t)t * 16 * 64); aop[t][1] = *(const pg8::bf16x8*)(WT + (size_t)t * 16 * 64 + 32); }
#pragma unroll
            for (int t = 0; t < 8; ++t) {
                pg8::f32x4 c = *(const pg8::f32x4*)(bias + t * 16);
                c = __builtin_amdgcn_mfma_f32_16x16x32_bf16(aop[t][0], bop[which * 2], c, 0, 0, 0);
                c = __builtin_amdgcn_mfma_f32_16x16x32_bf16(aop[t][1], bop[which * 2 + 1], c, 0, 0, 0);
                *(LAS f32x4v*)(dst + t * 16) = (f32x4v){c[0], c[1], c[2], c[3]};
            }
        }
    }
    __syncthreads();
    f32x2v aw[TT], aa[TT];
#pragma unroll
    for (int tk = 0; tk < TT; ++tk) { aw[tk] = *(const LAS f32x2v*)(lw + 2048 + tk * 1028 + c0); aa[tk] = *(const LAS f32x2v*)(lw + 2048 + 13364 + tk * 1028 + c0); }
    {
        const float* mu = A.in[13];
        const float2 mur = *(const float2*)(mu + c0), muk = *(const float2*)(mu + 1024 + c0), muv = *(const float2*)(mu + 2048 + c0);
        const float2 kkw = *(const float2*)(A.in[19] + c0), kaw = *(const float2*)(A.in[20] + c0);
#pragma unroll
        for (int tk = 0; tk < TT; ++tk) {
            const int row = row_base + tk; int grp, b, t, T; rowinfo(row, grp, b, t, T);
            const unsigned wr_ = pw[tk + 1][0], wk_ = pw[tk + 1][1], wv_ = pw[tk + 1][2];
            float r0 = bf_lo(wr_), r1 = bf_hi(wr_), k0 = bf_lo(wk_), k1 = bf_hi(wk_), v0 = bf_lo(wv_), v1 = bf_hi(wv_);
            float pr0, pr1, pk0, pk1, pv0, pv1;
            if (t > 0) { const unsigned a_ = pw[tk][0], b_ = pw[tk][1], c_ = pw[tk][2];
                pr0 = bf_lo(a_); pr1 = bf_hi(a_); pk0 = bf_lo(b_); pk1 = bf_hi(b_); pv0 = bf_lo(c_); pv1 = bf_hi(c_); }
            else if (grp) { const float* sp = st_shift + (size_t)b * RPROJ + c0; const float2 a_ = *(const float2*)sp, b_ = *(const float2*)(sp + 1024), c_ = *(const float2*)(sp + 2048);
                pr0 = a_.x; pr1 = a_.y; pk0 = b_.x; pk1 = b_.y; pv0 = c_.x; pv1 = c_.y; }
            else { pr0 = pr1 = pk0 = pk1 = pv0 = pv1 = 0.f; }
            r0 += (pr0 - r0) * mur.x; r1 += (pr1 - r1) * mur.y; k0 += (pk0 - k0) * muk.x; k1 += (pk1 - k1) * muk.y; v0 += (pv0 - v0) * muv.x; v1 += (pv1 - v1) * muv.y;
            const float w0_ = -softplusf_(-aw[tk].x) - 0.5f, w1_ = -softplusf_(-aw[tk].y) - 0.5f;
            const float d0 = __expf(-__expf(w0_)), d1 = __expf(-__expf(w1_));
            const float a0_ = sigmoidf_(aa[tk].x), a1_ = sigmoidf_(aa[tk].y);
            float q0 = k0 * kkw.x, q1 = k1 * kkw.y;
            const float inv = rsqrtf(half_sum32(q0 * q0 + q1 * q1) + 1e-12f);
            q0 *= inv; q1 *= inv;
            const float kp0 = k0 * (1.0f + (a0_ - 1.0f) * kaw.x), kp1 = k1 * (1.0f + (a1_ - 1.0f) * kaw.y);
            bf16_t* rs = RS + (size_t)row * 4096 + c0;
            *(unsigned*)rs = pk2(q0, q1); *(unsigned*)(rs + 1024) = pk2(q0 * a0_, q1 * a1_); *(unsigned*)(rs + 2048) = pk2(kp0, kp1); *(unsigned*)(rs + 3072) = pk2(r0, r1);
            *(unsigned*)(RV + (size_t)row * 1024 + c0) = pk2(v0, v1);
            *(float2*)(RW + (size_t)row * 1024 + c0) = make_float2(d0, d1);
        }
    }
    for (int tk = 0; tk < TT; ++tk) { const int row = row_base + tk; int grp, b, t, T; rowinfo(row, grp, b, t, T);
        if (t == T - 1) { float* sp = A.out + (grp ? O_SHIFT_S : O_SHIFT_P) + (size_t)b * RPROJ;
            for (int j = tid; j < RPROJ; j += 512) sp[j] = bf_lo((unsigned)PROJ[(size_t)row * NINP + OFFR + j]); } }
    __syncthreads();
}

constexpr int SCAN_LDS_PER_WAVE = 10752;
__device__ __forceinline__ void rwkv_sample_loop(LAS float* sl, const bf16_t* __restrict__ RS, const bf16_t* __restrict__ RV, const float* __restrict__ RW, float* __restrict__ yraw,
                                                 const float* __restrict__ st_in, float* __restrict__ st_out, int task0, int stride, int lane) {
    if (task0 >= 16384) return;
    const int part = lane & 7, rr = lane >> 3;
    LAS float* SB = sl; LAS float* WB = sl + 2048; LAS float* VB = sl + 2560;
    float4 nS0, nS1; uint4 nst[4]; float4 nsw[2]; uint4 nsv = make_uint4(0, 0, 0, 0);
#define RWS_LOAD(task_) do { const int bh_ = (task_) >> 3, v0_ = ((task_) & 7) * 8, h_ = bh_ & 15, row0_ = MPR + (bh_ >> 4) * 8; \
        const float* sp_ = st_in + (size_t)bh_ * 4096 + (size_t)(v0_ + rr) * 64 + part * 8; { const f32x4v a_ = __builtin_nontemporal_load((const f32x4v*)sp_), b_ = __builtin_nontemporal_load((const f32x4v*)(sp_ + 4)); nS0 = make_float4(a_[0], a_[1], a_[2], a_[3]); nS1 = make_float4(b_[0], b_[1], b_[2], b_[3]); } \
        _Pragma("unroll") for (int i = 0; i < 4; ++i) { const int id = i * 64 + lane, step = id >> 5, s = (id >> 3) & 3, pc = id & 7; \
            nst[i] = *(const uint4*)(RS + (size_t)(row0_ + step) * 4096 + s * 1024 + h_ * 64 + pc * 8); } \
        _Pragma("unroll") for (int i = 0; i < 2; ++i) { const int id = i * 64 + lane, step = id >> 4, pc = id & 15; \
            nsw[i] = *(const float4*)(RW + (size_t)(row0_ + step) * 1024 + h_ * 64 + pc * 4); } \
        if (lane < 8) nsv = *(const uint4*)(RV + (size_t)(row0_ + lane) * 1024 + h_ * 64 + v0_); } while (0)
    RWS_LOAD(task0);
    for (int task = task0; task < 16384; task += stride) {
        const int bh = task >> 3, v0 = (task & 7) * 8, h = bh & 15, row0 = MPR + (bh >> 4) * 8;
        f32x2v S[4] = {(f32x2v){nS0.x, nS0.y}, (f32x2v){nS0.z, nS0.w}, (f32x2v){nS1.x, nS1.y}, (f32x2v){nS1.z, nS1.w}};
#pragma unroll
        for (int i = 0; i < 4; ++i) { const int id = i * 64 + lane, step = id >> 5, s = (id >> 3) & 3, pc = id & 7; float f[8]; unpack8(nst[i], f);
            LAS float* d = SB + (step * 4 + s) * 64 + pc * 8; *(LAS f32x4v*)d = (f32x4v){f[0], f[1], f[2], f[3]}; *(LAS f32x4v*)(d + 4) = (f32x4v){f[4], f[5], f[6], f[7]}; }
#pragma unroll
        for (int i = 0; i < 2; ++i) { const int id = i * 64 + lane, step = id >> 4, pc = id & 15; *(LAS f32x4v*)(WB + step * 64 + pc * 4) = (f32x4v){nsw[i].x, nsw[i].y, nsw[i].z, nsw[i].w}; }
        if (lane < 8) { float f[8]; unpack8(nsv, f); LAS float* d = VB + lane * 8; *(LAS f32x4v*)d = (f32x4v){f[0], f[1], f[2], f[3]}; *(LAS f32x4v*)(d + 4) = (f32x4v){f[4], f[5], f[6], f[7]}; }
        asm volatile("s_waitcnt lgkmcnt(0)" ::: "memory");
        __builtin_amdgcn_sched_barrier(0);
        if (task + stride < 16384) RWS_LOAD(task + stride);
        __builtin_amdgcn_sched_barrier(0);
        float ys[8];
        f32x4v kk0, kk1, ka0, ka1, kp0, kp1, r0, r1, w0, w1; float vv;
        f32x4v nkk0, nkk1, nka0, nka1, nkp0, nkp1, nr0, nr1, nw0, nw1; float nvv;
#define RW_OPS(s_) do { const LAS float* sb = SB + (s_) * 256 + part * 8; \
            nkk0 = *(const LAS f32x4v*)(sb); nkk1 = *(const LAS f32x4v*)(sb + 4); nka0 = *(const LAS f32x4v*)(sb + 64); nka1 = *(const LAS f32x4v*)(sb + 68); \
            nkp0 = *(const LAS f32x4v*)(sb + 128); nkp1 = *(const LAS f32x4v*)(sb + 132); nr0 = *(const LAS f32x4v*)(sb + 192); nr1 = *(const LAS f32x4v*)(sb + 196); \
            nw0 = *(const LAS f32x4v*)(WB + (s_) * 64 + part * 8); nw1 = *(const LAS f32x4v*)(WB + (s_) * 64 + part * 8 + 4); nvv = VB[(s_) * 8 + rr]; } while (0)
        RW_OPS(0);
#pragma unroll
        for (int s = 0; s < 8; ++s) {
            kk0 = nkk0; kk1 = nkk1; ka0 = nka0; ka1 = nka1; kp0 = nkp0; kp1 = nkp1; r0 = nr0; r1 = nr1; w0 = nw0; w1 = nw1; vv = nvv;
            if (s < 7) RW_OPS(s + 1);
            __builtin_amdgcn_sched_barrier(0);
            f32x2v acc = S[0] * kk0.lo, acc1 = S[1] * kk0.hi; acc = S[2] * kk1.lo + acc; acc1 = S[3] * kk1.hi + acc1; acc += acc1;
            const float sk = reduce8(acc.x + acc.y);
            const f32x2v nsk = (f32x2v){-sk, -sk}, vv2 = (f32x2v){vv, vv};
            S[0] = S[0] * w0.lo + (ka0.lo * nsk + kp0.lo * vv2);
            S[1] = S[1] * w0.hi + (ka0.hi * nsk + kp0.hi * vv2);
            S[2] = S[2] * w1.lo + (ka1.lo * nsk + kp1.lo * vv2);
            S[3] = S[3] * w1.hi + (ka1.hi * nsk + kp1.hi * vv2);
            f32x2v ya = S[0] * r0.lo, ya1 = S[1] * r0.hi; ya = S[2] * r1.lo + ya; ya1 = S[3] * r1.hi + ya1; ya += ya1;
            ys[s] = reduce8(ya.x + ya.y);
            __builtin_amdgcn_sched_barrier(0);
        }
#undef RW_OPS
        { float ysel = ys[0];
#pragma unroll
          for (int i = 1; i < 8; ++i) ysel = (part == i) ? ys[i] : ysel;
          yraw[(size_t)(row0 + part) * 2048 + 1024 + h * 64 + v0 + rr] = ysel; }
        { float* d = st_out + (size_t)bh * 4096 + (size_t)(v0 + rr) * 64 + part * 8; __builtin_nontemporal_store((f32x4v){S[0].x, S[0].y, S[1].x, S[1].y}, (f32x4v*)d); __builtin_nontemporal_store((f32x4v){S[2].x, S[2].y, S[3].x, S[3].y}, (f32x4v*)(d + 4)); }
        asm volatile("" ::: "memory");
    }
#undef RWS_LOAD
}
__device__ __forceinline__ void gdn_sample_loop(LAS float* sl, const bf16_t* __restrict__ GQKV, const float* __restrict__ GA, const float* __restrict__ GB, float* __restrict__ yraw,
                                                const float* __restrict__ st_in, float* __restrict__ st_out, int task0, int stride, int lane) {
    if (task0 >= 16384) return;
    const int part = lane & 7, cc = lane >> 3;
    LAS float* KB = sl; LAS float* QB = sl + 1056; LAS float* VB = sl + 2112; LAS float* AB = sl + 2176;
    const int rdoff = part * 16 + (part >> 2) * 4;
    float nS[16]; uint4 nst[4]; uint4 nsv = make_uint4(0, 0, 0, 0); float nsa = 0.f, nsb = 0.f;
#define GDS_LOAD(task_) do { const int bh_ = (task_) >> 4, j0_ = ((task_) & 15) * 8, h_ = bh_ & 7, row0_ = MPR + (bh_ >> 3) * 8; \
        const float* sp_ = st_in + (size_t)bh_ * 16384 + (size_t)(part * 16) * 128 + j0_ + cc; \
        _Pragma("unroll") for (int e = 0; e < 16; ++e) nS[e] = sp_[(size_t)e * 128]; \
        _Pragma("unroll") for (int i = 0; i < 4; ++i) { const int id = i * 64 + lane, s = id >> 7, step = (id >> 4) & 7, pc = id & 15; \
            nst[i] = *(const uint4*)(GQKV + (size_t)(row0_ + step) * 3072 + (s == 0 ? 1024 : 0) + h_ * 128 + pc * 8); } \
        if (lane < 8) { nsv = *(const uint4*)(GQKV + (size_t)(row0_ + lane) * 3072 + 2048 + h_ * 128 + j0_); \
            nsa = GA[(size_t)(row0_ + lane) * 8 + h_]; nsb = GB[(size_t)(row0_ + lane) * 8 + h_]; } } while (0)
    GDS_LOAD(task0);
    for (int task = task0; task < 16384; task += stride) {
        const int bh = task >> 4, j0 = (task & 15) * 8, h = bh & 7, row0 = MPR + (bh >> 3) * 8;
        f32x2v S[8];
#pragma unroll
        for (int e = 0; e < 8; ++e) S[e] = (f32x2v){nS[2 * e], nS[2 * e + 1]};
#pragma unroll
        for (int i = 0; i < 4; ++i) { const int id = i * 64 + lane, s = id >> 7, step = (id >> 4) & 7, pc = id & 15, pp = pc >> 1; float f[8]; unpack8(nst[i], f);
            LAS float* d = (s == 0 ? KB : QB) + step * 132 + pp * 16 + (pp >> 2) * 4 + (pc & 1) * 8; *(LAS f32x4v*)d = (f32x4v){f[0], f[1], f[2], f[3]}; *(LAS f32x4v*)(d + 4) = (f32x4v){f[4], f[5], f[6], f[7]}; }
        if (lane < 8) { float f[8]; unpack8(nsv, f); LAS float* d = VB + lane * 8; *(LAS f32x4v*)d = (f32x4v){f[0], f[1], f[2], f[3]}; *(LAS f32x4v*)(d + 4) = (f32x4v){f[4], f[5], f[6], f[7]};
            AB[lane * 2] = nsa; AB[lane * 2 + 1] = nsb; }
        asm volatile("s_waitcnt lgkmcnt(0)" ::: "memory");
        __builtin_amdgcn_sched_barrier(0);
        if (task + stride < 16384) GDS_LOAD(task + stride);
        __builtin_amdgcn_sched_barrier(0);
        float os[8];
        f32x4v k[4], q[4], nk[4], nq[4]; float v, a, beta, nv, na, nbeta;
#define GD_OPS(s_) do { const LAS float* kb = KB + (s_) * 132 + rdoff; const LAS float* qb = QB + (s_) * 132 + rdoff; \
            _Pragma("unroll") for (int i = 0; i < 4; ++i) { nk[i] = *(const LAS f32x4v*)(kb + 4 * i); nq[i] = *(const LAS f32x4v*)(qb + 4 * i); } \
            nv = VB[(s_) * 8 + cc]; na = AB[(s_) * 2]; nbeta = AB[(s_) * 2 + 1]; } while (0)
        GD_OPS(0);
#pragma unroll
        for (int s = 0; s < 8; ++s) {
#pragma unroll
            for (int i = 0; i < 4; ++i) { k[i] = nk[i]; q[i] = nq[i]; }
            v = nv; a = na; beta = nbeta;
            if (s < 7) GD_OPS(s + 1);
            __builtin_amdgcn_sched_barrier(0);
            f32x2v acc = S[0] * k[0].lo, acc1 = S[1] * k[0].hi;
#pragma unroll
            for (int i = 1; i < 4; ++i) { acc = S[2 * i] * k[i].lo + acc; acc1 = S[2 * i + 1] * k[i].hi + acc1; }
            acc += acc1;
            const float kS = reduce8(acc.x + acc.y);
            const float cf = beta * (v - a * kS);
            const f32x2v cf2 = (f32x2v){cf, cf}, a2 = (f32x2v){a, a};
#pragma unroll
            for (int i = 0; i < 4; ++i) { S[2 * i] = S[2 * i] * a2 + k[i].lo * cf2; S[2 * i + 1] = S[2 * i + 1] * a2 + k[i].hi * cf2; }
            f32x2v oa = S[0] * q[0].lo, oa1 = S[1] * q[0].hi;
#pragma unroll
            for (int i = 1; i < 4; ++i) { oa = S[2 * i] * q[i].lo + oa; oa1 = S[2 * i + 1] * q[i].hi + oa1; }
            oa += oa1;
            os[s] = reduce8(oa.x + oa.y);
            __builtin_amdgcn_sched_barrier(0);
        }
#undef GD_OPS
        { float osel = os[0];
#pragma unroll
          for (int i = 1; i < 8; ++i) osel = (part == i) ? os[i] : osel;
          yraw[(size_t)(row0 + part) * 2048 + h * 128 + j0 + cc] = osel; }
        { float* d = st_out + (size_t)bh * 16384 + (size_t)(part * 16) * 128 + j0 + cc;
#pragma unroll
          for (int e = 0; e < 8; ++e) { d[(size_t)(2 * e) * 128] = S[e].x; d[(size_t)(2 * e + 1) * 128] = S[e].y; } }
        asm volatile("" ::: "memory");
    }
#undef GDS_LOAD
}

__device__ __forceinline__ void gdn_sample_cols(LAS float* sl, const bf16_t* __restrict__ GQKV, const float* __restrict__ GA, const float* __restrict__ GB, float* __restrict__ yraw,
                                                const float* __restrict__ st_in, float* __restrict__ st_out, int task, int lane) {
    const int bh = task >> 1, j = (task & 1) * 64 + lane, h = bh & 7, row0 = MPR + (bh >> 3) * 8;
    LAS float* KB = sl; LAS float* QB = sl + 1024; LAS float* VB = sl + 2048; LAS float* AB = sl + 2560;
    f32x2v S[64];
    { const float* sp = st_in + (size_t)bh * 16384 + j;
#pragma unroll
      for (int i = 0; i < 64; ++i) { S[i] = (f32x2v){__builtin_nontemporal_load(sp), __builtin_nontemporal_load(sp + 128)}; sp += 256; asm volatile("" : "+v"(sp)); } }
    {
        uint4 st[4];
#pragma unroll
        for (int i = 0; i < 4; ++i) { const int id = i * 64 + lane, s = id >> 7, step = (id >> 4) & 7, pc = id & 15;
            st[i] = *(const uint4*)(GQKV + (size_t)(row0 + step) * 3072 + (s == 0 ? 1024 : 0) + h * 128 + pc * 8); }
        unsigned short vv[8];
#pragma unroll
        for (int s = 0; s < 8; ++s) vv[s] = GQKV[(size_t)(row0 + s) * 3072 + 2048 + h * 128 + j];
        float sa = 0.f, sbt = 0.f;
        if (lane < 8) { sa = GA[(size_t)(row0 + lane) * 8 + h]; sbt = GB[(size_t)(row0 + lane) * 8 + h]; }
#pragma unroll
        for (int i = 0; i < 4; ++i) { const int id = i * 64 + lane, s = id >> 7, step = (id >> 4) & 7, pc = id & 15; float f[8]; unpack8(st[i], f);
            LAS float* d = (s == 0 ? KB : QB) + step * 128 + pc * 8; *(LAS f32x4v*)d = (f32x4v){f[0], f[1], f[2], f[3]}; *(LAS f32x4v*)(d + 4) = (f32x4v){f[4], f[5], f[6], f[7]}; }
#pragma unroll
        for (int s = 0; s < 8; ++s) VB[s * 64 + lane] = bf_lo((unsigned)vv[s]);
        if (lane < 8) { AB[lane * 2] = sa; AB[lane * 2 + 1] = sbt; }
        asm volatile("s_waitcnt lgkmcnt(0)" ::: "memory");
    }
#pragma unroll 1
    for (int s = 0; s < 8; ++s) {
        const LAS float* kb = KB + s * 128; const LAS float* qb = QB + s * 128;
        const float v = VB[s * 64 + lane], a = AB[s * 2], beta = AB[s * 2 + 1];
        f32x2v acc0 = (f32x2v){0.f, 0.f}, acc1 = (f32x2v){0.f, 0.f};
#pragma unroll
        for (int i = 0; i < 32; ++i) { const f32x4v kq = *(const LAS f32x4v*)(kb + 4 * i); acc0 = S[2 * i] * kq.lo + acc0; acc1 = S[2 * i + 1] * kq.hi + acc1; if ((i & 7) == 7) __builtin_amdgcn_sched_barrier(0); }
        acc0 += acc1;
        const float kS = acc0.x + acc0.y;
        const float cf = beta * (v - a * kS);
        const f32x2v cf2 = (f32x2v){cf, cf}, a2 = (f32x2v){a, a};
        f32x2v o0 = (f32x2v){0.f, 0.f}, o1 = (f32x2v){0.f, 0.f};
#pragma unroll
        for (int i = 0; i < 32; ++i) { const f32x4v kq = *(const LAS f32x4v*)(kb + 4 * i), qq = *(const LAS f32x4v*)(qb + 4 * i);
            S[2 * i] = S[2 * i] * a2 + kq.lo * cf2; S[2 * i + 1] = S[2 * i + 1] * a2 + kq.hi * cf2;
            o0 = S[2 * i] * qq.lo + o0; o1 = S[2 * i + 1] * qq.hi + o1; if ((i & 3) == 3) __builtin_amdgcn_sched_barrier(0); }
        o0 += o1;
        yraw[(size_t)(row0 + s) * 2048 + h * 128 + j] = o0.x + o0.y;
    }
    { float* dp = st_out + (size_t)bh * 16384 + j;
#pragma unroll
      for (int i = 0; i < 64; ++i) { __builtin_nontemporal_store(S[i].x, dp); __builtin_nontemporal_store(S[i].y, dp + 128); dp += 256; asm volatile("" : "+v"(dp)); } }
    asm volatile("s_waitcnt lgkmcnt(0)" ::: "memory");
}

__device__ __forceinline__ float reduce16(float v) { v = reduce8(v); v += dppf<0x140>(v); return v; }
__device__ __forceinline__ void gdn_prompt_block(LAS float* L, const bf16_t* __restrict__ GQKV, const float* __restrict__ GA, const float* __restrict__ GB, float* __restrict__ yraw,
                                                 int row0, int T, int h, int jblk, float* __restrict__ s_out, int tid, int wave, int lane) {
    constexpr int BUF = 4768;
    const int part = lane & 15, cc = lane >> 4, j0 = jblk + wave * 4, rdoff = part * 8 + (part >> 3) * 4;
    f32x2v S[4];
#pragma unroll
    for (int e = 0; e < 4; ++e) S[e] = (f32x2v){0.f, 0.f};
    const int ss = tid >> 8, sstep = (tid >> 4) & 15, spc = tid & 15, vstep = (tid >> 2) & 15, vp = tid & 3, astep = tid & 15;
    uint4 st, sv = make_uint4(0, 0, 0, 0); float sa = 0.f, sbt = 0.f;
    const int nch = T >> 4;
#define GB_LOAD(c) do { const int t0_ = (c) * 16; st = *(const uint4*)(GQKV + (size_t)(row0 + t0_ + sstep) * 3072 + (ss == 0 ? 1024 : 0) + h * 128 + spc * 8); \
        if (tid < 64) sv = *(const uint4*)(GQKV + (size_t)(row0 + t0_ + vstep) * 3072 + 2048 + h * 128 + jblk + vp * 8); \
        else if (tid < 80) { sa = GA[(size_t)(row0 + t0_ + astep) * 8 + h]; sbt = GB[(size_t)(row0 + t0_ + astep) * 8 + h]; } } while (0)
#define GB_WRITE(b) do { LAS float* base = L + (b) * BUF; { float f[8]; unpack8(st, f); LAS float* d = base + ss * 2112 + sstep * 132 + spc * 8 + (spc >> 3) * 4; \
            *(LAS f32x4v*)d = (f32x4v){f[0], f[1], f[2], f[3]}; *(LAS f32x4v*)(d + 4) = (f32x4v){f[4], f[5], f[6], f[7]}; } \
        if (tid < 64) { float f[8]; unpack8(sv, f); LAS float* d = base + 4224 + vstep * 32 + vp * 8; *(LAS f32x4v*)d = (f32x4v){f[0], f[1], f[2], f[3]}; *(LAS f32x4v*)(d + 4) = (f32x4v){f[4], f[5], f[6], f[7]}; } \
        else if (tid < 80) { base[4736 + astep * 2] = sa; base[4736 + astep * 2 + 1] = sbt; } } while (0)
    GB_LOAD(0); GB_WRITE(0);
    __syncthreads();
    for (int c = 0; c < nch; ++c) {
        if (c + 1 < nch) GB_LOAD(c + 1);
        __builtin_amdgcn_sched_barrier(0);
        const LAS float* base = L + (c & 1) * BUF;
        float os[16];
        f32x2v k[4], q[4], nk[4], nq[4]; float v, a, beta, nv, na, nbeta;
#define GB_OPS(s_) do { const LAS float* kb = base + (s_) * 132 + rdoff; const LAS float* qb = base + 2112 + (s_) * 132 + rdoff; \
            _Pragma("unroll") for (int i = 0; i < 2; ++i) { const f32x4v t0 = *(const LAS f32x4v*)(kb + 4 * i), t1 = *(const LAS f32x4v*)(qb + 4 * i); \
                nk[2 * i] = t0.lo; nk[2 * i + 1] = t0.hi; nq[2 * i] = t1.lo; nq[2 * i + 1] = t1.hi; } \
            nv = base[4224 + (s_) * 32 + wave * 4 + cc]; na = base[4736 + (s_) * 2]; nbeta = base[4736 + (s_) * 2 + 1]; } while (0)
        GB_OPS(0);
#pragma unroll
        for (int s = 0; s < 16; ++s) {
#pragma unroll
            for (int i = 0; i < 4; ++i) { k[i] = nk[i]; q[i] = nq[i]; }
            v = nv; a = na; beta = nbeta;
            if (s < 15) GB_OPS(s + 1);
            __builtin_amdgcn_sched_barrier(0);
            f32x2v acc = S[0] * k[0], acc1 = S[1] * k[1]; acc = S[2] * k[2] + acc; acc1 = S[3] * k[3] + acc1; acc += acc1;
            const float kS = reduce16(acc.x + acc.y);
            const float cf = beta * (v - a * kS);
            const f32x2v cf2 = (f32x2v){cf, cf}, a2 = (f32x2v){a, a};
#pragma unroll
            for (int i = 0; i < 4; ++i) S[i] = S[i] * a2 + k[i] * cf2;
            f32x2v oa = S[0] * q[0], oa1 = S[1] * q[1]; oa = S[2] * q[2] + oa; oa1 = S[3] * q[3] + oa1; oa += oa1;
            os[s] = reduce16(oa.x + oa.y);
            __builtin_amdgcn_sched_barrier(0);
        }
#undef GB_OPS
        { float osel = os[0];
#pragma unroll
          for (int i = 1; i < 16; ++i) osel = (part == i) ? os[i] : osel;
          yraw[(size_t)(row0 + c * 16 + part) * 2048 + h * 128 + j0 + cc] = osel; }
        if (c + 1 < nch) GB_WRITE((c + 1) & 1);
        __syncthreads();
    }
#undef GB_LOAD
#undef GB_WRITE
#pragma unroll
    for (int e = 0; e < 4; ++e) { s_out[(size_t)(part * 8 + 2 * e) * 128 + j0 + cc] = S[e].x; s_out[(size_t)(part * 8 + 2 * e + 1) * 128 + j0 + cc] = S[e].y; }
}
__device__ __forceinline__ void rwkv_prompt_block(LAS float* L, const bf16_t* __restrict__ RS, const bf16_t* __restrict__ RV, const float* __restrict__ RW, float* __restrict__ yraw,
                                                  int row0, int T, int h, int vblk, float* __restrict__ s_out, int tid, int wave, int lane) {
    constexpr int BUF = 5632;
    const int part = lane & 15, rr = lane >> 4, v0 = vblk + wave * 4;
    f32x2v S[2] = {(f32x2v){0.f, 0.f}, (f32x2v){0.f, 0.f}};
    const int sstep = tid >> 5, ss = (tid >> 3) & 3, spc = tid & 7, wstep = (tid >> 4) & 15, wpc = tid & 15, vstep = (tid >> 2) & 15, vp = tid & 3;
    uint4 st, sv = make_uint4(0, 0, 0, 0); float4 sw = make_float4(0.f, 0.f, 0.f, 0.f);
    const int nch = T >> 4;
#define RB_LOAD(c) do { const int t0_ = (c) * 16; st = *(const uint4*)(RS + (size_t)(row0 + t0_ + sstep) * 4096 + ss * 1024 + h * 64 + spc * 8); \
        if (tid < 256) sw = *(const float4*)(RW + (size_t)(row0 + t0_ + wstep) * 1024 + h * 64 + wpc * 4); \
        else if (tid < 320) sv = *(const uint4*)(RV + (size_t)(row0 + t0_ + vstep) * 1024 + h * 64 + vblk + vp * 8); } while (0)
#define RB_WRITE(b) do { LAS float* base = L + (b) * BUF; { float f[8]; unpack8(st, f); LAS float* d = base + (sstep * 4 + ss) * 64 + spc * 8; \
            *(LAS f32x4v*)d = (f32x4v){f[0], f[1], f[2], f[3]}; *(LAS f32x4v*)(d + 4) = (f32x4v){f[4], f[5], f[6], f[7]}; } \
        if (tid < 256) *(LAS f32x4v*)(base + 4096 + wstep * 64 + wpc * 4) = (f32x4v){sw.x, sw.y, sw.z, sw.w}; \
        else if (tid < 320) { float f[8]; unpack8(sv, f); LAS float* d = base + 5120 + vstep * 32 + vp * 8; *(LAS f32x4v*)d = (f32x4v){f[0], f[1], f[2], f[3]}; *(LAS f32x4v*)(d + 4) = (f32x4v){f[4], f[5], f[6], f[7]}; } } while (0)
    RB_LOAD(0); RB_WRITE(0);
    __syncthreads();
    for (int c = 0; c < nch; ++c) {
        if (c + 1 < nch) RB_LOAD(c + 1);
        __builtin_amdgcn_sched_barrier(0);
        const LAS float* base = L + (c & 1) * BUF;
        float ys[16];
        f32x4v kk, ka, kp, r, w, nkk, nka, nkp, nr, nw; float vv, nvv;
#define RB_OPS(s_) do { const LAS float* sb = base + (s_) * 256 + part * 4; nkk = *(const LAS f32x4v*)(sb); nka = *(const LAS f32x4v*)(sb + 64); nkp = *(const LAS f32x4v*)(sb + 128); nr = *(const LAS f32x4v*)(sb + 192); \
            nw = *(const LAS f32x4v*)(base + 4096 + (s_) * 64 + part * 4); nvv = base[5120 + (s_) * 32 + wave * 4 + rr]; } while (0)
        RB_OPS(0);
#pragma unroll
        for (int s = 0; s < 16; ++s) {
            kk = nkk; ka = nka; kp = nkp; r = nr; w = nw; vv = nvv;
            if (s < 15) RB_OPS(s + 1);
            __builtin_amdgcn_sched_barrier(0);
            f32x2v acc = S[0] * kk.lo + S[1] * kk.hi;
            const float sk = reduce16(acc.x + acc.y);
            const f32x2v nsk = (f32x2v){-sk, -sk}, vv2 = (f32x2v){vv, vv};
            S[0] = S[0] * w.lo + (ka.lo * nsk + kp.lo * vv2);
            S[1] = S[1] * w.hi + (ka.hi * nsk + kp.hi * vv2);
            f32x2v ya = S[0] * r.lo + S[1] * r.hi;
            ys[s] = reduce16(ya.x + ya.y);
            __builtin_amdgcn_sched_barrier(0);
        }
#undef RB_OPS
        { float ysel = ys[0];
#pragma unroll
          for (int i = 1; i < 16; ++i) ysel = (part == i) ? ys[i] : ysel;
          yraw[(size_t)(row0 + c * 16 + part) * 2048 + 1024 + h * 64 + v0 + rr] = ysel; }
        if (c + 1 < nch) RB_WRITE((c + 1) & 1);
        __syncthreads();
    }
#undef RB_LOAD
#undef RB_WRITE
    *(float4*)(s_out + (size_t)(v0 + rr) * 64 + part * 4) = make_float4(S[0].x, S[0].y, S[1].x, S[1].y);
}

__device__ __forceinline__ void post_tile(const Args& A, LAS float* lg, int tile, int tid) {
    const bf16_t* PROJ = (const bf16_t*)(A.ws + W_PROJ);
    const bf16_t* RS = (const bf16_t*)(A.ws + W_RS); const bf16_t* RV = (const bf16_t*)(A.ws + W_RV);
    bf16_t* MIXED = (bf16_t*)(A.ws + W_MIXED);
    const float* yraw = A.out + O_Y; const float* st_shift = A.in[5];
    const int row_base = tile * TT;
    const int c0 = tid * 2;
    float2 yv[TT], ov[TT]; unsigned rwv[TT], kwv[TT], vwv[TT], zwv[TT];
#pragma unroll
    for (int tk = 0; tk < TT; ++tk) { const int row = row_base + tk;
        { const f32x2v y_ = __builtin_nontemporal_load((const f32x2v*)(yraw + (size_t)row * 2048 + 1024 + c0)), o_ = __builtin_nontemporal_load((const f32x2v*)(yraw + (size_t)row * 2048 + c0)); yv[tk] = make_float2(y_.x, y_.y); ov[tk] = make_float2(o_.x, o_.y); }
        rwv[tk] = __builtin_nontemporal_load((const unsigned*)(RS + (size_t)row * 4096 + 3072 + c0)); kwv[tk] = __builtin_nontemporal_load((const unsigned*)(RS + (size_t)row * 4096 + 2048 + c0)); vwv[tk] = __builtin_nontemporal_load((const unsigned*)(RV + (size_t)row * 1024 + c0));
        zwv[tk] = *(const unsigned*)(PROJ + (size_t)row * NINP + 3072 + c0); }
    {
        if (tid < 4 * 68) ((LAS unsigned*)lg)[TT * 68 + tid] = 0u;
        const float* mu = A.in[13];
#pragma unroll
        for (int i = 0; i < 2; ++i) { const int item = tid + 512 * i; if (item < TT * 64) { const int tk = item >> 6, jp = item & 63, row = row_base + tk; int grp, b, t, T; rowinfo(row, grp, b, t, T);
            const int col = 3200 + 2 * jp; const unsigned pw_ = *(const unsigned*)(PROJ + (size_t)row * NINP + OFFR + col);
            float q0, q1; if (t > 0) { const unsigned qw = *(const unsigned*)(PROJ + (size_t)(row - 1) * NINP + OFFR + col); q0 = bf_lo(qw); q1 = bf_hi(qw); }
            else if (grp) { const float2 sq = *(const float2*)(st_shift + (size_t)b * RPROJ + col); q0 = sq.x; q1 = sq.y; } else { q0 = 0.f; q1 = 0.f; }
            const float2 m2 = *(const float2*)(mu + col); const float p0 = bf_lo(pw_), p1 = bf_hi(pw_);
            ((LAS unsigned*)lg)[tk * 68 + jp] = pk2_safe(sigmoidf_(p0 + (q0 - p0) * m2.x), sigmoidf_(p1 + (q1 - p1) * m2.y)); } }
    }
    __syncthreads();
    {
        const int wv_ = __builtin_amdgcn_readfirstlane(tid >> 6), ti = tid & 15, quad = (tid & 63) >> 4;
        const LAS unsigned char* lb = (const LAS unsigned char*)lg + ti * 272 + quad * 16;
        pg8::bf16x8 bop[4];
#pragma unroll
        for (int ks = 0; ks < 4; ++ks) bop[ks] = *(const LAS pg8::bf16x8*)(lb + ks * 64);
        const bf16_t* WT = (const bf16_t*)((const unsigned char*)A.out + OB_GBT) + (size_t)(wv_ * 128 + ti) * 128 + quad * 8;
        LAS float* dst = lg + 2048 + (ti < TT ? ti : TT) * 1028 + wv_ * 128 + quad * 4;
#pragma unroll
        for (int hh = 0; hh < 2; ++hh) {
            pg8::bf16x8 aop[4][4];
#pragma unroll
            for (int t = 0; t < 4; ++t)
#pragma unroll
                for (int ks = 0; ks < 4; ++ks) aop[t][ks] = *(const pg8::bf16x8*)(WT + (size_t)(hh * 4 + t) * 16 * 128 + ks * 32);
#pragma unroll
            for (int t = 0; t < 4; ++t) {
                pg8::f32x4 c = (pg8::f32x4){0.f, 0.f, 0.f, 0.f};
#pragma unroll
                for (int ks = 0; ks < 4; ++ks) c = __builtin_amdgcn_mfma_f32_16x16x32_bf16(aop[t][ks], bop[ks], c, 0, 0, 0);
                *(LAS f32x4v*)(dst + (hh * 4 + t) * 16) = (f32x4v){c[0], c[1], c[2], c[3]};
            }
        }
    }
    __syncthreads();
    f32x2v gate[TT];
#pragma unroll
    for (int tk = 0; tk < TT; ++tk) gate[tk] = *(const LAS f32x2v*)(lg + 2048 + tk * 1028 + c0);
    const float2 gnw = *(const float2*)(A.in[22] + c0), gnb = *(const float2*)(A.in[23] + c0), rk = *(const float2*)(A.in[21] + c0);
    const float2 ng = *(const float2*)(A.in[12] + (c0 & 127));
#pragma unroll
    for (int tk = 0; tk < TT; ++tk) {
        const int row = row_base + tk;
        {
            const float2 y = yv[tk];
            const float mean = half_sum32(y.x + y.y) * (1.0f / 64.0f);
            const float d0 = y.x - mean, d1 = y.y - mean;
            const float var = half_sum32(d0 * d0 + d1 * d1) * (1.0f / 64.0f);
            const float rs = rsqrtf(var + 64e-5f);
            const unsigned rw = rwv[tk], kw = kwv[tk], vw = vwv[tk];
            const float bon = half_sum32(bf_lo(rw) * bf_lo(kw) * rk.x + bf_hi(rw) * bf_hi(kw) * rk.y);
            const float o0 = (d0 * rs * gnw.x + gnb.x + bon * bf_lo(vw)) * gate[tk].x, o1 = (d1 * rs * gnw.y + gnb.y + bon * bf_hi(vw)) * gate[tk].y;
            *(unsigned*)(MIXED + (size_t)row * 2048 + 1024 + c0) = pk2(o0, o1);
        }
        {
            const float2 o = ov[tk];
            const float rs = rsqrtf(wave_sum(o.x * o.x + o.y * o.y) * (1.0f / 128.0f) + 1e-6f);
            const unsigned zw = zwv[tk];
            *(unsigned*)(MIXED + (size_t)row * 2048 + c0) = pk2(o.x * rs * ng.x * siluf_(bf_lo(zw)), o.y * rs * ng.y * siluf_(bf_hi(zw)));
        }
    }
    __syncthreads();
}

__device__ __forceinline__ void act_item(const Args& A, int item, int lane) {
    const bf16_t* H = (const bf16_t*)(A.ws + W_H); bf16_t* ACT = (bf16_t*)(A.ws + W_ACT);
    const float* cwp = A.in[27]; const float* st_ffn = A.in[6];
    const int cgp = item % 11, rg = item / 11, ch = (cgp * 64 + lane) * 8;
    float cg_[3][8], cu_[3][8];
#pragma unroll
    for (int i = 0; i < 3; ++i) { const float4 a0 = *(const float4*)(cwp + (size_t)i * DFF2 + ch), a1 = *(const float4*)(cwp + (size_t)i * DFF2 + ch + 4), b0 = *(const float4*)(cwp + (size_t)i * DFF2 + DFF + ch), b1 = *(const float4*)(cwp + (size_t)i * DFF2 + DFF + ch + 4);
        cg_[i][0] = a0.x; cg_[i][1] = a0.y; cg_[i][2] = a0.z; cg_[i][3] = a0.w; cg_[i][4] = a1.x; cg_[i][5] = a1.y; cg_[i][6] = a1.z; cg_[i][7] = a1.w;
        cu_[i][0] = b0.x; cu_[i][1] = b0.y; cu_[i][2] = b0.z; cu_[i][3] = b0.w; cu_[i][4] = b1.x; cu_[i][5] = b1.y; cu_[i][6] = b1.z; cu_[i][7] = b1.w; }
    uint4 hg[11], hu[11];
#pragma unroll
    for (int i = 0; i < 11; ++i) { int r = rg * 9 - 2 + i; r = r < 0 ? 0 : r; { typedef unsigned u32x4n_ __attribute__((ext_vector_type(4))); const u32x4n_ a_ = __builtin_nontemporal_load((const u32x4n_*)(H + (size_t)r * DFF2 + ch)), b_ = __builtin_nontemporal_load((const u32x4n_*)(H + (size_t)r * DFF2 + DFF + ch)); hg[i] = make_uint4(a_[0], a_[1], a_[2], a_[3]); hu[i] = make_uint4(b_[0], b_[1], b_[2], b_[3]); } }
#pragma unroll
    for (int rI = 0; rI < 9; ++rI) {
        const int row = rg * 9 + rI; int grp, b, t, T; rowinfo(row, grp, b, t, T);
        float g[8], u[8];
#pragma unroll
        for (int e = 0; e < 8; ++e) { g[e] = 0.f; u[e] = 0.f; }
#pragma unroll
        for (int i = 0; i < 3; ++i) { const int tt = t - 2 + i; float xg[8], xu[8];
            if (tt >= 0) { unpack8(hg[rI + i], xg); unpack8(hu[rI + i], xu); }
            else if (grp) { const float* sp = st_ffn + ((size_t)b * 2 + (t + i)) * DFF2 + ch; const float4 a0 = *(const float4*)sp, a1 = *(const float4*)(sp + 4), b0 = *(const float4*)(sp + DFF), b1 = *(const float4*)(sp + DFF + 4);
                xg[0] = a0.x; xg[1] = a0.y; xg[2] = a0.z; xg[3] = a0.w; xg[4] = a1.x; xg[5] = a1.y; xg[6] = a1.z; xg[7] = a1.w;
                xu[0] = b0.x; xu[1] = b0.y; xu[2] = b0.z; xu[3] = b0.w; xu[4] = b1.x; xu[5] = b1.y; xu[6] = b1.z; xu[7] = b1.w; }
            else {
#pragma unroll
                for (int e = 0; e < 8; ++e) { xg[e] = 0.f; xu[e] = 0.f; } }
#pragma unroll
            for (int e = 0; e < 8; ++e) { g[e] += cg_[i][e] * xg[e]; u[e] += cu_[i][e] * xu[e]; } }
        float o[8];
#pragma unroll
        for (int e = 0; e < 8; ++e) o[e] = siluf_(g[e]) * u[e];
        uint4 w; w.x = pk2(o[0], o[1]); w.y = pk2(o[2], o[3]); w.z = pk2(o[4], o[5]); w.w = pk2(o[6], o[7]);
        *(uint4*)(ACT + (size_t)row * DFF + ch) = w;
    }
}

__device__ __forceinline__ void fast_grid_barrier(unsigned* bar, unsigned round, unsigned G) {
    asm volatile("s_waitcnt vmcnt(0)" ::: "memory");
    __syncthreads();
    if (threadIdx.x == 0) {
        __builtin_amdgcn_fence(__ATOMIC_RELEASE, "agent");
        asm volatile("s_waitcnt vmcnt(0)" ::: "memory");
        const unsigned g = blockIdx.x >> 4, ngroups = (G + 15u) >> 4, gsize = (G - g * 16u) < 16u ? (G - g * 16u) : 16u;
        unsigned* cnt = bar + 32u * (1u + g); unsigned* top = bar + 32u * 20u; unsigned* gen = bar + 32u * (24u + g);
        const unsigned old = __hip_atomic_fetch_add(cnt, 1u, __ATOMIC_RELAXED, __HIP_MEMORY_SCOPE_AGENT);
        if (old + 1u == round * gsize) {
            const unsigned t = __hip_atomic_fetch_add(top, 1u, __ATOMIC_RELAXED, __HIP_MEMORY_SCOPE_AGENT);
            if (t + 1u == round * ngroups) { for (unsigned q = 0; q < ngroups; ++q) __hip_atomic_store(bar + 32u * (24u + q), round, __ATOMIC_RELAXED, __HIP_MEMORY_SCOPE_AGENT); }
        }
        unsigned sp = 0u;
        while (__hip_atomic_load(gen, __ATOMIC_RELAXED, __HIP_MEMORY_SCOPE_AGENT) < round) { __builtin_amdgcn_s_sleep(1); if (++sp > (1u << 22)) break; }
        __builtin_amdgcn_fence(__ATOMIC_ACQUIRE, "agent");
        asm volatile("s_waitcnt vmcnt(0)" ::: "memory");
    }
    __syncthreads();
}

__global__ void __launch_bounds__(512, 2) hymba_fwd(Args A) {
    extern __shared__ __attribute__((aligned(16))) unsigned char lds_raw[];
    LAS unsigned char* lds = (LAS unsigned char*)lds_raw;
    cg::grid_group grid = cg::this_grid();
    const int tid = threadIdx.x, lane = tid & 63, wave = __builtin_amdgcn_readfirstlane(tid >> 6);
    const int G = gridDim.x, bx = blockIdx.x, gw = bx * 8 + wave, NGW = G * 8;
    const int lo = A.ph_lo, hi = A.ph_hi;
#define IN(k) (lo <= (k) && (k) < hi)
    unsigned* barcnt = (unsigned*)(A.ws + W_BAR); unsigned nbar = 0u;
#define SEAM(k) do { if (IN(k) && IN((k) + 1)) { ++nbar; fast_grid_barrier(barcnt, nbar, (unsigned)G); } } while (0)
    if (hi < 0) grid.sync();
    unsigned char* ws = A.ws; float* out = A.out;
    bf16_t* XN = (bf16_t*)(out + O_GDN_S);
    bf16_t* WT_IN = (bf16_t*)(out + O_RWKV_S);
    bf16_t* WT_O = (bf16_t*)(ws + W_WTO); bf16_t* WT_UP = (bf16_t*)(ws + W_WTUP); bf16_t* WT_DN = (bf16_t*)(ws + W_WTDN);
    bf16_t* PROJ = (bf16_t*)(ws + W_PROJ); bf16_t* MIXED = (bf16_t*)(ws + W_MIXED); bf16_t* XN2 = (bf16_t*)(ws + W_XN2);
    bf16_t* HB = (bf16_t*)(ws + W_H); bf16_t* ACT = (bf16_t*)(ws + W_ACT);
    float* X1 = out + O_Y; float* PART = (float*)(ws + W_PART);

    if (IN(0)) {
        LAS float* scr = (LAS float*)(lds + wave * 16384);
        constexpr int I_IN = 32 * (NINP / 64);
        for (int it = gw; it < I_IN; it += NGW) transpose_item(A.in[8], DM, NIN, WT_IN, scr, it, NINP / 64, lane);
        for (int i = bx * 512 + tid; i < 4096 * 8; i += G * 512) {
            int r = (i >> 9) * 64 + (i & 63); const int q = (i >> 6) & 7; const float* W; bf16_t* WT; int K, j0;
            if (r < 1024) { W = A.in[15]; WT = (bf16_t*)((unsigned char*)out + OB_WBT); K = 64; j0 = 0; }
            else if (r < 2048) { r -= 1024; W = A.in[17]; WT = (bf16_t*)((unsigned char*)out + OB_ABT); K = 64; j0 = 0; }
            else { r -= 2048; W = A.in[18]; WT = (bf16_t*)((unsigned char*)out + OB_GBT); K = 128; j0 = (r >> 10) * 64; r &= 1023; }
            const int ch = r;
            float f[8];
#pragma unroll
            for (int e = 0; e < 8; ++e) f[e] = W[(size_t)(j0 + q * 8 + e) * 1024 + ch];
            uint4 o; o.x = pk2(f[0], f[1]); o.y = pk2(f[2], f[3]); o.z = pk2(f[4], f[5]); o.w = pk2(f[6], f[7]);
            *(uint4*)(WT + (size_t)ch * K + j0 + q * 8) = o;
        }
        for (int m = gw; m < MTOK; m += NGW) { const float* xr = (m < MPR) ? A.in[0] + (size_t)m * DM : A.in[1] + (size_t)(m - MPR) * DM; rms_row_bf16<true>(xr, A.in[7], XN + (size_t)m * DM, lane); }
        __syncthreads();
    }
    SEAM(0);
    if (IN(1)) {
        pg8::Gemm g{XN, WT_IN, MTOK, NINP, DM}; pg8::StaticOrder S; S.init(MTOK, NINP, DM, G, bx);
        pg8::EpiBf16P E{PROJ, NINP};
        pg8::gemm_phase<pg8::EpiBf16P, pg8::StaticOrder, true, true>(lds, g, S, E);
    }
    SEAM(1);
    if (IN(2)) { for (int tile = bx; tile < NTILES; tile += G) prep_tile(A, (LAS float*)lds, tile, tid); }
    SEAM(2);
    if (IN(3)) {
        LAS float* sl = (LAS float*)(lds + wave * 16384);
        const bf16_t* GQKV = (const bf16_t*)(ws + W_GQKV); const float* GA = (const float*)(ws + W_GAB); const float* GB = GA + MTOK * 8;
        const bf16_t* RS = (const bf16_t*)(ws + W_RS); const bf16_t* RV = (const bf16_t*)(ws + W_RV); const float* RW = (const float*)(ws + W_RW);
        float* yraw = out + O_Y;
        const bool heavy = (G == 256) && (bx >= 128);
        const int nshare = (G == 256) ? 3072 : NGW, share0 = (G == 256) ? (heavy ? 1024 + ((bx - 128) * 8 + wave) * 2 : gw) : gw, nsh = heavy ? 2 : 1;
        for (int task = gw; task < 2048; task += NGW) gdn_sample_cols(sl, GQKV, GA, GB, yraw, A.in[2], out + O_GDN_S, task, lane);
        for (int sh = 0; sh < nsh; ++sh) {
            rwkv_sample_loop(sl, RS, RV, RW, yraw, A.in[4], out + O_RWKV_S, share0 + sh, nshare, lane);
            constexpr int I_O = 32 * (DM / 64), I_UP = 32 * (DFF2 / 64), I_DN = (DFF / 64) * (DM / 64);
            for (int it = share0 + sh; it < I_O + I_UP + I_DN; it += nshare) {
                int r = it;
                if (r < I_O) { transpose_item(A.in[24], DM, DM, WT_O, sl, r, DM / 64, lane); continue; } r -= I_O;
                if (r < I_UP) { transpose_item(A.in[26], DM, DFF2, WT_UP, sl, r, DFF2 / 64, lane); continue; } r -= I_UP;
                transpose_item(A.in[28], DFF, DM, WT_DN, sl, r, DM / 64, lane);
            }
        }
        __syncthreads();
        for (int u = bx; u < 256; u += G) {
            if (u < 128) { const int bh = u >> 2, cq = u & 3;
                gdn_prompt_block((LAS float*)lds, GQKV, GA, GB, yraw, (bh >> 3) * 2048, 2048, bh & 7, cq * 32, out + O_GDN_P + (size_t)bh * 16384, tid, wave, lane); }
            else { const int uu = u - 128, bh = uu >> 1, hf = uu & 1;
                rwkv_prompt_block((LAS float*)lds, RS, RV, RW, yraw, (bh >> 4) * 2048, 2048, bh & 15, hf * 32, out + O_RWKV_P + (size_t)bh * 4096, tid, wave, lane); }
        }
        __syncthreads();
    }
    SEAM(3);
    if (IN(4)) {
        for (int tile = bx; tile < NTILES; tile += G) post_tile(A, (LAS float*)lds, tile, tid);
    }
    SEAM(4);
    if (IN(5)) {
        pg8::Gemm g{MIXED, WT_O, MTOK, DM, DM}; pg8::SplitOrder S; S.init(DM, bx);
        pg8::EpiResSplit E{A.in[0], X1, PART};
        pg8::gemm_phase<pg8::EpiResSplit, pg8::SplitOrder, true, true>(lds, g, S, E);
    }
    SEAM(5);
    if (IN(6)) {
        LAS float* scr = (LAS float*)(lds + wave * 16384);
        for (int m = gw; m < MTOK; m += NGW) {
            if (m >= MPR) { const float4* xs = (const float4*)(A.in[1] + (size_t)(m - MPR) * DM); float4* xo = (float4*)(X1 + (size_t)m * DM);
#pragma unroll
                for (int j = 0; j < 8; ++j) { float4 a = xs[lane + 64 * j];
#pragma unroll
                    for (int sg = 0; sg < 8; ++sg) { const f32x4v b = __builtin_nontemporal_load((const f32x4v*)(PART + ((size_t)sg * 1024 + (m - MPR)) * DM) + lane + 64 * j); a.x += b[0]; a.y += b[1]; a.z += b[2]; a.w += b[3]; }
                    xo[lane + 64 * j] = a; } }
            rms_row_bf16(X1 + (size_t)m * DM, A.in[25], XN2 + (size_t)m * DM, lane);
        }
        __syncthreads();
    }
    SEAM(6);
    if (IN(7)) {
        pg8::Gemm g{XN2, WT_UP, MTOK, DFF2, DM}; pg8::StaticOrder S; S.init(MTOK, DFF2, DM, G, bx);
        pg8::EpiH E{HB, out + O_FFN_P, out + O_FFN_S};
        pg8::gemm_phase<pg8::EpiH, pg8::StaticOrder, true, true>(lds, g, S, E);
    }
    SEAM(7);
    if (IN(8)) { for (int it = gw; it < 11 * (MTOK / 9); it += NGW) act_item(A, it, lane); }
    SEAM(8);
    if (IN(9)) {
        pg8::Gemm g{ACT, WT_DN, MTOK, DM, DFF}; pg8::SplitOrder S; S.init(DFF, bx);
        pg8::EpiResSplit E{X1, X1, PART};
        pg8::gemm_phase<pg8::EpiResSplit, pg8::SplitOrder, true, true>(lds, g, S, E);
    }
    SEAM(9);
    if (IN(10)) { for (int m = gw; m < MTOK; m += NGW) {
            if (m >= MPR) { float4* xo = (float4*)(X1 + (size_t)m * DM);
#pragma unroll
                for (int j = 0; j < 8; ++j) { float4 a = xo[lane + 64 * j];
#pragma unroll
                    for (int sg = 0; sg < 8; ++sg) { const f32x4v b = __builtin_nontemporal_load((const f32x4v*)(PART + ((size_t)sg * 1024 + (m - MPR)) * DM) + lane + 64 * j); a.x += b[0]; a.y += b[1]; a.z += b[2]; a.w += b[3]; }
                    xo[lane + 64 * j] = a; } }
            if (m < MPR) rms_row_f32_inplace<true>(X1 + (size_t)m * DM, A.in[29], lane); else rms_row_f32_inplace<false>(X1 + (size_t)m * DM, A.in[29], lane); } }
#undef IN
#undef SEAM
}

#ifndef N_LAUNCH_SPLIT
#define N_LAUNCH_SPLIT 0
#endif
extern "C" void kernel_launch(void* const* d_in, const int* in_sizes, int n_in, void* d_out, int out_size, void* d_ws, size_t ws_size, hipStream_t stream) {
    static int grid = 0;
    if (grid == 0) {
        int dev = 0, cus = 0, per_cu = 0;
        hipGetDevice(&dev);
        hipDeviceGetAttribute(&cus, hipDeviceAttributeMultiprocessorCount, dev);
        if (hipFuncSetAttribute((const void*)hymba_fwd, hipFuncAttributeMaxDynamicSharedMemorySize, LDS_BYTES) != hipSuccess) fprintf(stderr, "kernel_launch: hipFuncSetAttribute failed\n");
        if (hipOccupancyMaxActiveBlocksPerMultiprocessor(&per_cu, (const void*)hymba_fwd, 512, LDS_BYTES) != hipSuccess || per_cu < 1) { fprintf(stderr, "kernel_launch: occupancy query says %d\n", per_cu); per_cu = 1; }
        (void)hipGetLastError();
        grid = cus * 1;
        if (n_in != 30 || out_size != (int)O_END || ws_size < W_END4) fprintf(stderr, "kernel_launch: unexpected sizes n_in %d out %d ws %zu (need %zu)\n", n_in, out_size, ws_size, (size_t)W_END3);
    }
    if (hipMemsetAsync((char*)d_ws + W_BAR, 0, 8192, stream) != hipSuccess) fprintf(stderr, "kernel_launch: memset of the barrier word failed\n");
    Args a{};
    for (int i = 0; i < 30; ++i) a.in[i] = (const float*)d_in[i];
    a.out = (float*)d_out; a.ws = (unsigned char*)d_ws;
#if N_LAUNCH_SPLIT
    for (int p = 0; p <= 10; ++p) { a.ph_lo = p; a.ph_hi = p + 1; void* args[] = {&a};
        hipError_t e = hipLaunchCooperativeKernel((const void*)hymba_fwd, dim3(grid), dim3(512), args, LDS_BYTES, stream);
        if (e != hipSuccess) { fprintf(stderr, "kernel_launch: launch of phase %d failed: %s\n", p, hipGetErrorString(e)); break; } }
#else
    a.ph_lo = 0; a.ph_hi = 11; void* args[] = {&a};
    hipError_t e = hipLaunchCooperativeKernel((const void*)hymba_fwd, dim3(grid), dim3(512), args, LDS_BYTES, stream);
    if (e != hipSuccess) fprintf(stderr, "kernel_launch: cooperative launch failed: %s (grid %d)\n", hipGetErrorString(e), grid);
#endif
}
```
